# Optimizing an MI355X kernel written in HIP

```python
import math
import jax, jax.numpy as jnp
from jax import lax
import numpy as np

D_MODEL = 4096
BATCH = 2
SEQ = 8192
DEPTH = 2
DEC_BATCH = 4
DEC_SEQ = 4096
PAST_LEN = 128

HEAD_DIM = 128
HYENA_WIDTH = D_MODEL // 4
FNET_WIDTH = D_MODEL // 4
ATTN_WIDTH = D_MODEL // 2
FNET_HEADS = FNET_WIDTH // HEAD_DIM
N_HEADS = ATTN_WIDTH // HEAD_DIM
N_KV_HEADS = 4
KV_GROUP = N_HEADS // N_KV_HEADS
KV_WIDTH = N_KV_HEADS * HEAD_DIM
WINDOW = 128
BLOCK = 128

HYENA_ORDER = 2
HYENA_IN = (HYENA_ORDER + 1) * HYENA_WIDTH
SHORT_CONV = 3
FILTER_EMB = 33
FILTER_HIDDEN = 64
FILTER_OUT = 2 * HYENA_ORDER * HYENA_WIDTH
DECAY_FAST_PCT = 0.3
DECAY_SLOW_PCT = 1.5
DECAY_TARGET = 1e-2

OFF_FNET = HYENA_IN
OFF_Q = OFF_FNET + FNET_WIDTH
OFF_K = OFF_Q + ATTN_WIDTH
OFF_V = OFF_K + KV_WIDTH
IN_WIDTH = OFF_V + KV_WIDTH

D_FF = -(-8 * D_MODEL // (3 * 256)) * 256

ALPHA = (2 * DEPTH) ** 0.25
BETA = (8 * DEPTH) ** -0.25
LN_EPS = 1e-5

kernel_name = "hyena_fnet_swa_hybrid_encoder"

F32 = jnp.float32


def _layer_norm(x, g, b):
    xf = x.astype(F32)
    mu = jnp.mean(xf, axis=-1, keepdims=True)
    var = jnp.mean(jnp.square(xf - mu), axis=-1, keepdims=True)
    return ((xf - mu) * lax.rsqrt(var + LN_EPS) * g.astype(F32) + b.astype(F32)).astype(x.dtype)


def _short_conv(u, w, b):
    L = u.shape[1]
    up = jnp.pad(u, ((0, 0), (1, 1), (0, 0)))
    return up[:, :L] * w[0] + up[:, 1:L + 1] * w[1] + up[:, 2:] * w[2] + b


def _hyena_filters(L, w1, b1, w2, b2, w3, b3, freq, w4):
    t = jnp.linspace(0.0, 1.0, L, dtype=F32)[:, None]
    bands = (FILTER_EMB - 1) // 2
    f = jnp.linspace(1e-4, bands - 1, bands, dtype=F32)
    w = (2.0 * math.pi / L) * jnp.arange(L, dtype=F32)[:, None]
    z = jnp.concatenate([t, jnp.cos(f * w), -jnp.sin(f * w)], axis=-1)
    fr = freq.astype(F32)
    h = jnp.sin(fr[0] * (z @ w1.astype(F32) + b1.astype(F32)))
    h = jnp.sin(fr[1] * (h @ w2.astype(F32) + b2.astype(F32)))
    h = jnp.sin(fr[2] * (h @ w3.astype(F32) + b3.astype(F32)))
    h = h @ w4.astype(F32)
    max_decay = math.log(DECAY_TARGET) / DECAY_FAST_PCT
    min_decay = math.log(DECAY_TARGET) / DECAY_SLOW_PCT
    deltas = jnp.abs(jnp.linspace(min_decay, max_decay, HYENA_WIDTH, dtype=F32))
    decay = jnp.exp(-t * deltas)
    return h.reshape(L, 2, HYENA_ORDER, HYENA_WIDTH) * decay[:, None, None, :]


def _bidir_fftconv(v, h_fwd, h_bwd, skip):
    L = v.shape[1]
    kern = jnp.concatenate([h_fwd, jnp.zeros_like(h_fwd[:1]), h_bwd[:0:-1]], axis=0)
    k_f = jnp.fft.rfft(kern, axis=0)
    v_f = jnp.fft.rfft(v, n=2 * L, axis=1)
    y = jnp.fft.irfft(v_f * k_f, n=2 * L, axis=1)[:, :L]
    return y + v * skip


def _hyena(u, short_w, short_b, filters, skip):
    uc = _short_conv(u, short_w, short_b).astype(F32)
    x1, x2, v = jnp.split(uc, 3, axis=-1)
    skip = skip.astype(F32)
    z = x1 * _bidir_fftconv(v, filters[:, 0, 0], filters[:, 1, 0], skip[0])
    z = x2 * _bidir_fftconv(z, filters[:, 0, 1], filters[:, 1, 1], skip[1])
    return z


def _fourier(u, w, b):
    B, L, _ = u.shape
    uh = u.astype(F32).reshape(B, L, FNET_HEADS, HEAD_DIM)
    y = jnp.fft.fft2(uh, axes=(1, 3), norm="ortho").real.reshape(B, L, FNET_WIDTH)
    return y @ w.astype(F32) + b.astype(F32)


def _window_attention(q, k, v, sink):
    B, L = q.shape[0], q.shape[1]
    nb = L // BLOCK
    qb = q.reshape(B, nb, BLOCK, N_KV_HEADS, KV_GROUP, HEAD_DIM)

    def band(a):
        ap = jnp.pad(a, ((0, 0), (BLOCK, BLOCK), (0, 0), (0, 0)))
        ap = ap.reshape(B, nb + 2, BLOCK, N_KV_HEADS, HEAD_DIM)
        return jnp.concatenate([ap[:, :-2], ap[:, 1:-1], ap[:, 2:]], axis=2)

    kb, vb = band(k), band(v)
    s = jnp.einsum('bnqhgd,bnshd->bnhgqs', qb, kb, preferred_element_type=F32) * (HEAD_DIM ** -0.5)
    qi = jnp.arange(BLOCK)[:, None]
    ki = jnp.arange(3 * BLOCK)[None, :]
    dist = qi + BLOCK - ki
    kpos = jnp.arange(nb)[:, None, None] * BLOCK + ki[None] - BLOCK
    valid = (jnp.abs(dist)[None] <= WINDOW) & (kpos >= 0) & (kpos < L)
    slopes = (2.0 ** (-8.0 * jnp.arange(1, N_HEADS + 1, dtype=F32) / N_HEADS)).reshape(N_KV_HEADS, KV_GROUP)
    s = s - slopes[:, :, None, None] * jnp.abs(dist).astype(F32)
    s = jnp.where(valid[None, :, None, None], s, -jnp.inf)
    sk = sink.astype(F32).reshape(N_KV_HEADS, KV_GROUP)[:, :, None, None]
    m = jnp.maximum(jnp.max(s, axis=-1, keepdims=True), sk)
    p = jnp.exp(s - m)
    denom = jnp.sum(p, axis=-1, keepdims=True) + jnp.exp(sk - m)
    o = jnp.einsum('bnhgqs,bnshd->bnqhgd', p / denom, vb.astype(F32))
    return o.reshape(B, L, ATTN_WIDTH)


def _trunk(x, ln0_g, ln0_b, w_in, short_w, short_b, filt_w1, filt_b1, filt_w2, filt_b2, filt_w3, filt_b3,
           filt_freq, filt_w4, hyena_skip, w_fnet, b_fnet, attn_sink, w_out, ln1_g, ln1_b,
           w_gate, w_up, w_down, ln2_g, ln2_b):
    B, L, _ = x.shape
    x = _layer_norm(x, ln0_g, ln0_b)
    for l in range(DEPTH):
        filters = _hyena_filters(L, filt_w1[l], filt_b1[l], filt_w2[l], filt_b2[l], filt_w3[l], filt_b3[l],
                                 filt_freq[l], filt_w4[l])
        proj = x @ w_in[l]
        u_h, u_f, q, k, v = jnp.split(proj, [OFF_FNET, OFF_Q, OFF_K, OFF_V], axis=-1)
        y_h = _hyena(u_h, short_w[l], short_b[l], filters, hyena_skip[l])
        y_f = _fourier(u_f, w_fnet[l], b_fnet[l])
        y_a = _window_attention(q.reshape(B, L, N_HEADS, HEAD_DIM),
                                k.reshape(B, L, N_KV_HEADS, HEAD_DIM),
                                v.reshape(B, L, N_KV_HEADS, HEAD_DIM), attn_sink[l])
        mix = jnp.concatenate([y_h, y_f, y_a], axis=-1).astype(x.dtype) @ w_out[l]
        x = _layer_norm(ALPHA * x + mix, ln1_g[l], ln1_b[l])
        ff = (jax.nn.silu(x @ w_gate[l]) * (x @ w_up[l])) @ w_down[l]
        x = _layer_norm(ALPHA * x + ff, ln2_g[l], ln2_b[l])
    return x


def setup_inputs(seed: int = 0) -> dict:
    key = jax.random.key(seed)
    ks = jax.random.split(key, 32)
    nrm = lambda k, shape, scale: jax.random.normal(k, shape, F32) * scale
    col_scale = jnp.concatenate([jnp.ones((IN_WIDTH - KV_WIDTH,), F32), jnp.full((KV_WIDTH,), BETA, F32)])
    return {
        "x_prompt": nrm(ks[0], (BATCH, SEQ, D_MODEL), 1.0),
        "x_sample": nrm(ks[1], (DEC_BATCH, DEC_SEQ, D_MODEL), 1.0),
        "ln0_g": 1.0 + nrm(ks[2], (D_MODEL,), 0.02),
        "ln0_b": nrm(ks[3], (D_MODEL,), 0.02),
        "w_in": nrm(ks[4], (DEPTH, D_MODEL, IN_WIDTH), D_MODEL ** -0.5) * col_scale,
        "short_w": nrm(ks[5], (DEPTH, SHORT_CONV, HYENA_IN), SHORT_CONV ** -0.5),
        "short_b": nrm(ks[6], (DEPTH, HYENA_IN), 0.02),
        "filt_w1": nrm(ks[7], (DEPTH, FILTER_EMB, FILTER_HIDDEN), FILTER_EMB ** -0.5),
        "filt_b1": nrm(ks[8], (DEPTH, FILTER_HIDDEN), 0.1),
        "filt_w2": nrm(ks[9], (DEPTH, FILTER_HIDDEN, FILTER_HIDDEN), FILTER_HIDDEN ** -0.5),
        "filt_b2": nrm(ks[10], (DEPTH, FILTER_HIDDEN), 0.1),
        "filt_w3": nrm(ks[11], (DEPTH, FILTER_HIDDEN, FILTER_HIDDEN), FILTER_HIDDEN ** -0.5),
        "filt_b3": nrm(ks[12], (DEPTH, FILTER_HIDDEN), 0.1),
        "filt_freq": 1.0 + nrm(ks[13], (DEPTH, 3, FILTER_HIDDEN), 0.02),
        "filt_w4": nrm(ks[14], (DEPTH, FILTER_HIDDEN, FILTER_OUT), 0.05 * FILTER_HIDDEN ** -0.5),
        "hyena_skip": nrm(ks[15], (DEPTH, HYENA_ORDER, HYENA_WIDTH), 1.0),
        "w_fnet": nrm(ks[16], (DEPTH, FNET_WIDTH, FNET_WIDTH), FNET_WIDTH ** -0.5),
        "b_fnet": nrm(ks[17], (DEPTH, FNET_WIDTH), 0.02),
        "attn_sink": nrm(ks[18], (DEPTH, N_HEADS), 0.5),
        "w_out": nrm(ks[19], (DEPTH, D_MODEL, D_MODEL), BETA * D_MODEL ** -0.5),
        "ln1_g": 1.0 + nrm(ks[20], (DEPTH, D_MODEL), 0.02),
        "ln1_b": nrm(ks[21], (DEPTH, D_MODEL), 0.02),
        "w_gate": nrm(ks[22], (DEPTH, D_MODEL, D_FF), D_MODEL ** -0.5),
        "w_up": nrm(ks[23], (DEPTH, D_MODEL, D_FF), D_MODEL ** -0.5),
        "w_down": nrm(ks[24], (DEPTH, D_FF, D_MODEL), BETA * D_FF ** -0.5),
        "ln2_g": 1.0 + nrm(ks[25], (DEPTH, D_MODEL), 0.02),
        "ln2_b": nrm(ks[26], (DEPTH, D_MODEL), 0.02),
    }


def reference(x_prompt, x_sample, ln0_g, ln0_b, w_in, short_w, short_b, filt_w1, filt_b1, filt_w2, filt_b2,
              filt_w3, filt_b3, filt_freq, filt_w4, hyena_skip, w_fnet, b_fnet, attn_sink, w_out,
              ln1_g, ln1_b, w_gate, w_up, w_down, ln2_g, ln2_b):
    y_prompt = _trunk(x_prompt, ln0_g, ln0_b, w_in, short_w, short_b, filt_w1, filt_b1, filt_w2, filt_b2,
                      filt_w3, filt_b3, filt_freq, filt_w4, hyena_skip, w_fnet, b_fnet, attn_sink, w_out,
                      ln1_g, ln1_b, w_gate, w_up, w_down, ln2_g, ln2_b)
    y_sample = _trunk(x_sample, ln0_g, ln0_b, w_in, short_w, short_b, filt_w1, filt_b1, filt_w2, filt_b2,
                      filt_w3, filt_b3, filt_freq, filt_w4, hyena_skip, w_fnet, b_fnet, attn_sink, w_out,
                      ln1_g, ln1_b, w_gate, w_up, w_down, ln2_g, ln2_b)
    return (y_prompt, y_sample)
```

```cpp
#include <hip/hip_runtime.h>
#include <cstdio>
#include <cmath>
#define MK_MULTI 1
namespace pg8 {
#define PG8_LAS __attribute__((address_space(3)))
typedef unsigned short bf16_t;
typedef short bf16x8 __attribute__((ext_vector_type(8)));
typedef float f32x4 __attribute__((ext_vector_type(4)));
typedef unsigned u32x4 __attribute__((ext_vector_type(4)));
constexpr int BM = 256, BK = 64, HALF = 128, HTB = HALF * BK * 2  , STAGE_BYTES = 8 * HTB, NXCD = 8, WGM = 8;

__host__ __device__ __forceinline__ int lds_byte(int r, int c) { const int st = (r >> 4) * 2 + (c >> 5), rr = r & 15, cc = c & 31, ob = rr * 64 + cc * 2; return st * 1024 + (ob ^ (((ob >> 9) & 1) << 5)); }
__host__ __device__ __forceinline__ void stage_rc(int b, int& R, int& C) { const int st = b / 1024, sb = b % 1024, swz = sb ^ (((sb >> 9) & 1) << 5); R = (st >> 1) * 16 + swz / 64; C = (st & 1) * 32 + (swz % 64) / 2; }
__host__ __device__ __forceinline__ int perm32(int rho) { const int n = rho >> 4, i = rho & 15; return 8 * (i >> 2) + 4 * n + (i & 3); }

struct Unit { int pm, pn; };
struct Gemm { const bf16_t* A; const bf16_t* Bt; int M, N, K; };

struct StaticOrder {
    int nM, nN, nwg, G, c;
    __host__ __device__ void init(int M, int N, int G_, int c_) { nM = M / BM; nN = N / BM; nwg = nM * nN; G = G_; c = c_; }
    __host__ __device__ bool next(int i, Unit& u) const {
        const long L = (long)i * G + c; if (L >= nwg) return false;
        int wgid = (int)L; { const int q = nwg / NXCD, r = nwg % NXCD, xcd = wgid % NXCD, off = wgid / NXCD; wgid = (xcd < r ? xcd * (q + 1) : r * (q + 1) + (xcd - r) * q) + off; }
        const int nig = WGM * nN, gid = wgid / nig, fm = gid * WGM, gsz = (nM - fm) < WGM ? (nM - fm) : WGM;
        u.pm = fm + ((wgid % nig) % gsz); u.pn = (wgid % nig) / gsz; return true;
    }
    __device__ __forceinline__ void a_ready(const Unit&) const {}
    __device__ __forceinline__ void done(const Unit&) const {}
};
struct CountedOrder : StaticOrder {
    const unsigned* ready; unsigned need; unsigned* tmo;
    __device__ __forceinline__ void a_ready(const Unit& u) const {
        if (threadIdx.x < 64) {
            const unsigned long long t0 = __builtin_amdgcn_s_memrealtime(); unsigned polls = 0;
            while ((unsigned)__builtin_amdgcn_readfirstlane(__hip_atomic_load(ready + 64 * u.pm, __ATOMIC_RELAXED, __HIP_MEMORY_SCOPE_AGENT)) < need) {
                if ((++polls & 255u) == 0u && __builtin_amdgcn_readfirstlane(__hip_atomic_load(tmo, __ATOMIC_RELAXED, __HIP_MEMORY_SCOPE_AGENT)) != 0u) break;
                if (__builtin_amdgcn_s_memrealtime() - t0 > 2000000ull) {
                    if (threadIdx.x == 0) { unsigned expect = 0u; __hip_atomic_compare_exchange_strong(tmo + 1, &expect, 0x600u | (unsigned)(u.pm & 0xff), __ATOMIC_RELAXED, __ATOMIC_RELAXED, __HIP_MEMORY_SCOPE_AGENT); __hip_atomic_store(tmo, 1u, __ATOMIC_RELAXED, __HIP_MEMORY_SCOPE_AGENT); }
                    break; }
                __builtin_amdgcn_s_sleep(2); }
            __builtin_amdgcn_fence(__ATOMIC_ACQUIRE, "agent");
            asm volatile("s_waitcnt vmcnt(0)" ::: "memory");
        }
#if !defined(BROKEN_HOOK_NO_BARRIER)
        asm volatile("" ::: "memory"); __builtin_amdgcn_s_barrier(); asm volatile("" ::: "memory");
#endif
    }
};

__device__ __forceinline__ unsigned cvt_pk_bf16(float lo, float hi) { unsigned r; asm volatile("v_cvt_pk_bf16_f32 %0, %1, %2" : "=v"(r) : "v"(lo), "v"(hi)); return r; }
typedef float f32x2 __attribute__((ext_vector_type(2)));
__device__ __forceinline__ f32x2 gelu_pk(f32x2 v) {
    const f32x2 av = __builtin_elementwise_abs(v), d = av * 0.2316418882f + 1.0f;
    f32x2 t; t.x = __builtin_amdgcn_rcpf(d.x); t.y = __builtin_amdgcn_rcpf(d.y);
    f32x2 q = t * 0.5307027145f + (-0.7265760135f); q = q * t + 0.7107068705f; q = q * t + (-0.142248368f); q = q * t + 0.127414796f; q = q * t;
    const f32x2 s = (v * v) * (-0.72134752044f);
    f32x2 e; e.x = __builtin_amdgcn_exp2f(s.x); e.y = __builtin_amdgcn_exp2f(s.y);
    const f32x2 m = v * (q * e), r = v - m;
    f32x2 o; o.x = v.x < 0.f ? m.x : r.x; o.y = v.y < 0.f ? m.y : r.y; return o;
}

struct EpiF32 {
    static constexpr bool PERM = false, AFTER_DRAIN = false;
    float* C; int ldc; const float* bias;
    __device__ __forceinline__ void operator()(const f32x4 (&acc)[2][2][4][2], const Unit& u, int wr, int wc, int fr, int fq) const {
        const int row0 = u.pm * BM + wr * 64 + fr, col0 = u.pn * BM + wc * 32 + 4 * fq;
        f32x4 bv[2][2];
#pragma unroll
        for (int bj = 0; bj < 2; ++bj)
#pragma unroll
            for (int n = 0; n < 2; ++n) bv[bj][n] = bias ? *(const f32x4*)(bias + col0 + bj * HALF + n * 16) : (f32x4){0.f, 0.f, 0.f, 0.f};
#pragma unroll
        for (int ai = 0; ai < 2; ++ai)
#pragma unroll
            for (int m = 0; m < 4; ++m) { float* rowp = C + (size_t)(row0 + ai * HALF + m * 16) * ldc + col0;
#pragma unroll
                for (int bj = 0; bj < 2; ++bj)
#pragma unroll
                    for (int n = 0; n < 2; ++n) *(f32x4*)(rowp + bj * HALF + n * 16) = acc[ai][bj][m][n] + bv[bj][n]; }
    }
};
template <int ACT  > struct EpiBf16 {
    static constexpr bool PERM = true, AFTER_DRAIN = false;
    bf16_t* O; int ldc; const float* bias; int split_cols; size_t split_stride;
    __device__ __forceinline__ void operator()(const f32x4 (&acc)[2][2][4][2], const Unit& u, int wr, int wc, int fr, int fq) const {
        const int row0 = u.pm * BM + wr * 64 + fr; int colt = u.pn * BM; bf16_t* base = O;
        if (split_cols) { const int t = colt / split_cols; base += (size_t)t * split_stride; colt -= t * split_cols; }
        const int col0 = colt + wc * 32 + 8 * fq, bcol0 = u.pn * BM + wc * 32 + 8 * fq;
        f32x4 bv[2][2];
#pragma unroll
        for (int bj = 0; bj < 2; ++bj)
#pragma unroll
            for (int n = 0; n < 2; ++n) bv[bj][n] = bias ? *(const f32x4*)(bias + bcol0 + bj * HALF + 4 * n) : (f32x4){0.f, 0.f, 0.f, 0.f};
#pragma unroll
        for (int ai = 0; ai < 2; ++ai)
#pragma unroll
            for (int m = 0; m < 4; ++m) { bf16_t* rowp = base + (size_t)(row0 + ai * HALF + m * 16) * ldc + col0;
#pragma unroll
                for (int bj = 0; bj < 2; ++bj) { f32x4 v0 = acc[ai][bj][m][0] + bv[bj][0], v1 = acc[ai][bj][m][1] + bv[bj][1];
                    if (ACT == 1) { f32x2 a = gelu_pk((f32x2){v0[0], v0[1]}), b = gelu_pk((f32x2){v0[2], v0[3]}), c = gelu_pk((f32x2){v1[0], v1[1]}), d = gelu_pk((f32x2){v1[2], v1[3]});
                        v0 = (f32x4){a.x, a.y, b.x, b.y}; v1 = (f32x4){c.x, c.y, d.x, d.y}; }
                    if (ACT == 2) {
#pragma unroll
                        for (int j = 0; j < 4; ++j) { v0[j] = 0.5f * v0[j] * (1.0f + erff(v0[j] * 0.70710678f)); v1[j] = 0.5f * v1[j] * (1.0f + erff(v1[j] * 0.70710678f)); } }
                    u32x4 w; w.x = cvt_pk_bf16(v0[0], v0[1]); w.y = cvt_pk_bf16(v0[2], v0[3]); w.z = cvt_pk_bf16(v1[0], v1[1]); w.w = cvt_pk_bf16(v1[2], v1[3]);
                    *(u32x4*)(rowp + bj * HALF) = w; } }
    }
};

struct PanelStats {
    unsigned* xbuf;
    unsigned* cnt;
    unsigned* tmo;
    int ntn; float eps;
    unsigned code;
    __device__ __forceinline__ bool run(const f32x4 (&v)[2][2][4][2], const Unit& u, int wr, int wc, int fr, int fq, PG8_LAS unsigned char* lds, int wid, int lane) const {
        typedef float f32x2v __attribute__((ext_vector_type(2)));
        PG8_LAS f32x2v* P = (PG8_LAS f32x2v*)lds;
        PG8_LAS f32x2v* S = (PG8_LAS f32x2v*)(lds + 8192);
        PG8_LAS unsigned* flag = (PG8_LAS unsigned*)(lds + 8192 + 2048);
#pragma unroll
        for (int ai = 0; ai < 2; ++ai)
#pragma unroll
            for (int m = 0; m < 4; ++m) {
                float s = 0.f;
#pragma unroll
                for (int bj = 0; bj < 2; ++bj)
#pragma unroll
                    for (int n = 0; n < 2; ++n) { const f32x4 x = v[ai][bj][m][n]; s += (x[0] + x[1]) + (x[2] + x[3]); }
                s += __shfl_xor(s, 16); s += __shfl_xor(s, 32);
                const float mw = s * (1.0f / 64.0f); float q = 0.f;
#pragma unroll
                for (int bj = 0; bj < 2; ++bj)
#pragma unroll
                    for (int n = 0; n < 2; ++n) { const f32x4 d = v[ai][bj][m][n] - mw; q += (d[0] * d[0] + d[1] * d[1]) + (d[2] * d[2] + d[3] * d[3]); }
                q += __shfl_xor(q, 16); q += __shfl_xor(q, 32);
                if (fq == 0) P[(ai * HALF + wr * 64 + m * 16 + fr) * 4 + wc] = (f32x2v){mw, q};
            }
        asm volatile("s_waitcnt lgkmcnt(0)" ::: "memory"); __builtin_amdgcn_s_barrier(); asm volatile("" ::: "memory");
#if defined(BROKEN_NO_WAIT)
        if (blockIdx.x >= 64) { const long long t0 = clock64(); while (clock64() - t0 < 60000) __builtin_amdgcn_s_sleep(8); }
#endif
        const int row = wid * 32 + (lane & 31);
        if (lane < 32) {
            const f32x2v a = P[row * 4 + 0], b = P[row * 4 + 1], c = P[row * 4 + 2], d = P[row * 4 + 3];
            const float mt = (a.x + b.x + c.x + d.x) * 0.25f;
            const float da = a.x - mt, db = b.x - mt, dc = c.x - mt, dd = d.x - mt;
            const float m2 = (a.y + b.y) + (c.y + d.y) + 64.0f * ((da * da + db * db) + (dc * dc + dd * dd));
            unsigned long long* slot = (unsigned long long*)xbuf + ((size_t)(u.pm * BM + row) * 4 + u.pn);
            __hip_atomic_store(slot, ((unsigned long long)__float_as_uint(m2) << 32) | __float_as_uint(mt), __ATOMIC_RELAXED, __HIP_MEMORY_SCOPE_AGENT);
        }
        asm volatile("s_waitcnt vmcnt(0)" ::: "memory");
        if (lane == 0) __hip_atomic_fetch_add(cnt + 64 * u.pm, 1u, __ATOMIC_RELAXED, __HIP_MEMORY_SCOPE_AGENT);
        if (wid == 0) {
            bool dead = false; const unsigned long long t0 = __builtin_amdgcn_s_memrealtime(); const unsigned want = 8u * (unsigned)ntn;
            for (;;) {
#if defined(BROKEN_NO_WAIT)
                break;
#endif
                if ((unsigned)__builtin_amdgcn_readfirstlane(__hip_atomic_load(cnt + 64 * u.pm, __ATOMIC_RELAXED, __HIP_MEMORY_SCOPE_AGENT)) >= want) break;
                if (__builtin_amdgcn_s_memrealtime() - t0 > 2000000ull) {
                    if (lane == 0) { unsigned expect = 0u; __hip_atomic_compare_exchange_strong(tmo + 1, &expect, code | (unsigned)(u.pm & 0xff), __ATOMIC_RELAXED, __ATOMIC_RELAXED, __HIP_MEMORY_SCOPE_AGENT);
                                     __hip_atomic_store(tmo, 1u, __ATOMIC_RELAXED, __HIP_MEMORY_SCOPE_AGENT); }
                    dead = true; break; }
                __builtin_amdgcn_s_sleep(2);
            }
            __builtin_amdgcn_fence(__ATOMIC_ACQUIRE, "agent");
            if (lane == 0) flag[0] = dead ? 1u : 0u;
        }
        asm volatile("s_waitcnt vmcnt(0) lgkmcnt(0)" ::: "memory"); __builtin_amdgcn_s_barrier(); asm volatile("" ::: "memory");
        const bool bad = flag[0] != 0u;
        if (lane < 32) {
            const unsigned long long* slot = (const unsigned long long*)xbuf + (size_t)(u.pm * BM + row) * 4; float mt[4], m2[4]; float ms = 0.f;
#pragma unroll
            for (int t = 0; t < 4; ++t) { if (t < ntn) { const unsigned long long w = __hip_atomic_load(slot + t, __ATOMIC_RELAXED, __HIP_MEMORY_SCOPE_AGENT); mt[t] = __uint_as_float((unsigned)w); m2[t] = __uint_as_float((unsigned)(w >> 32)); } else { mt[t] = 0.f; m2[t] = 0.f; } ms += mt[t]; }
            const float mean = ms / (float)ntn; float q = 0.f;
#pragma unroll
            for (int t = 0; t < 4; ++t) if (t < ntn) { const float dm = mt[t] - mean; q += m2[t] + 256.0f * dm * dm; }
            S[row] = (f32x2v){mean, 1.0f / sqrtf(q / (256.0f * (float)ntn) + eps)};
        }
        asm volatile("s_waitcnt lgkmcnt(0)" ::: "memory"); __builtin_amdgcn_s_barrier(); asm volatile("" ::: "memory");
        return bad;
    }
};
struct EpiLnRes {
    static constexpr bool PERM = false, AFTER_DRAIN = true;
    const float* base; float* out; int ldc; const float* bias; PanelStats st; unsigned poison;
    __device__ __forceinline__ void refuse(size_t i0, size_t stride, int M, int N) const { const float q = __builtin_nanf(""); for (size_t i = i0; i < (size_t)M * N; i += stride) out[(i / N) * ldc + i % N] = q;
        if (i0 == 0) { unsigned expect = 0u; __hip_atomic_compare_exchange_strong(st.tmo + 1, &expect, 0x7f0u, __ATOMIC_RELAXED, __ATOMIC_RELAXED, __HIP_MEMORY_SCOPE_AGENT); __hip_atomic_store(st.tmo, 1u, __ATOMIC_RELAXED, __HIP_MEMORY_SCOPE_AGENT); } }
    __device__ __forceinline__ void fused(f32x4 (&acc)[2][2][4][2], const Unit& u, int wr, int wc, int fr, int fq, PG8_LAS unsigned char* lds, int wid, int lane) const {
        typedef float f32x2v __attribute__((ext_vector_type(2)));
        const PG8_LAS f32x2v* S = (const PG8_LAS f32x2v*)(lds + 8192);
        const int col0 = u.pn * BM + wc * 32 + 4 * fq;
#pragma unroll
        for (int bj = 0; bj < 2; ++bj)
#pragma unroll
            for (int n = 0; n < 2; ++n) { const f32x4 bv = bias ? *(const f32x4*)(bias + col0 + bj * HALF + n * 16) : (f32x4){0.f, 0.f, 0.f, 0.f};
#pragma unroll
                for (int ai = 0; ai < 2; ++ai)
#pragma unroll
                    for (int m = 0; m < 4; ++m) acc[ai][bj][m][n] += bv; }
        const bool bad = st.run(acc, u, wr, wc, fr, fq, lds, wid, lane) || poison != 0u;
        const float qnan = __builtin_nanf("");
#pragma unroll
        for (int ai = 0; ai < 2; ++ai)
#pragma unroll
            for (int m = 0; m < 4; ++m) { const int r = ai * HALF + wr * 64 + m * 16 + fr; const f32x2v sr = S[r]; const size_t off = (size_t)(u.pm * BM + r) * ldc + col0;
#pragma unroll
                for (int bj = 0; bj < 2; ++bj)
#pragma unroll
                    for (int n = 0; n < 2; ++n) { const f32x4 bs = *(const f32x4*)(base + off + bj * HALF + n * 16); f32x4 o = bs + (acc[ai][bj][m][n] - sr.x) * sr.y;
                        if (bad) o = (f32x4){qnan, qnan, qnan, qnan}; *(f32x4*)(out + off + bj * HALF + n * 16) = o; }
                asm volatile("" ::: "memory"); }
    }
};
struct EpiLnResLn {
    static constexpr bool PERM = false, AFTER_DRAIN = true;
    const float* base; float* out; bf16_t* xn; int ldc; const float* bias; PanelStats st1, st2; unsigned poison;
    __device__ __forceinline__ void refuse(size_t i0, size_t stride, int M, int N) const { const float q = __builtin_nanf(""); for (size_t i = i0; i < (size_t)M * N; i += stride) { const size_t o = (i / N) * ldc + i % N; out[o] = q; xn[o] = (bf16_t)0x7fc0u; }
        if (i0 == 0) { unsigned expect = 0u; __hip_atomic_compare_exchange_strong(st1.tmo + 1, &expect, 0x7f0u, __ATOMIC_RELAXED, __ATOMIC_RELAXED, __HIP_MEMORY_SCOPE_AGENT); __hip_atomic_store(st1.tmo, 1u, __ATOMIC_RELAXED, __HIP_MEMORY_SCOPE_AGENT); } }
    __device__ __forceinline__ void fused(f32x4 (&acc)[2][2][4][2], const Unit& u, int wr, int wc, int fr, int fq, PG8_LAS unsigned char* lds, int wid, int lane) const {
        typedef float f32x2v __attribute__((ext_vector_type(2))); typedef unsigned u32x2v __attribute__((ext_vector_type(2)));
        const PG8_LAS f32x2v* S = (const PG8_LAS f32x2v*)(lds + 8192);
        const int col0 = u.pn * BM + wc * 32 + 4 * fq;
#pragma unroll
        for (int bj = 0; bj < 2; ++bj)
#pragma unroll
            for (int n = 0; n < 2; ++n) { const f32x4 bv = bias ? *(const f32x4*)(bias + col0 + bj * HALF + n * 16) : (f32x4){0.f, 0.f, 0.f, 0.f};
#pragma unroll
                for (int ai = 0; ai < 2; ++ai)
#pragma unroll
                    for (int m = 0; m < 4; ++m) acc[ai][bj][m][n] += bv; }
        bool bad = st1.run(acc, u, wr, wc, fr, fq, lds, wid, lane) || poison != 0u;
        const float qnan = __builtin_nanf("");
#pragma unroll
        for (int ai = 0; ai < 2; ++ai)
#pragma unroll
            for (int m = 0; m < 4; ++m) { const int r = ai * HALF + wr * 64 + m * 16 + fr; const f32x2v sr = S[r]; const size_t off = (size_t)(u.pm * BM + r) * ldc + col0;
#pragma unroll
                for (int bj = 0; bj < 2; ++bj)
#pragma unroll
                    for (int n = 0; n < 2; ++n) { const f32x4 bs = *(const f32x4*)(base + off + bj * HALF + n * 16); acc[ai][bj][m][n] = bs + (acc[ai][bj][m][n] - sr.x) * sr.y; }
                asm volatile("" : "+v"(acc[ai][0][m][0]), "+v"(acc[ai][0][m][1]), "+v"(acc[ai][1][m][0]), "+v"(acc[ai][1][m][1]));
                if (m & 1) asm volatile("" ::: "memory"); }
        const bool bad1 = bad;
        bad = st2.run(acc, u, wr, wc, fr, fq, lds, wid, lane) || bad;
#pragma unroll
        for (int ai = 0; ai < 2; ++ai)
#pragma unroll
            for (int m = 0; m < 4; ++m) { const int r = ai * HALF + wr * 64 + m * 16 + fr; const f32x2v sr = S[r]; const size_t off = (size_t)(u.pm * BM + r) * ldc + col0;
#pragma unroll
                for (int bj = 0; bj < 2; ++bj)
#pragma unroll
                    for (int n = 0; n < 2; ++n) { const f32x4 x1 = acc[ai][bj][m][n]; *(f32x4*)(out + off + bj * HALF + n * 16) = bad1 ? (f32x4){qnan, qnan, qnan, qnan} : x1;
                        const f32x4 o = (x1 - sr.x) * sr.y; u32x2v w; w.x = cvt_pk_bf16(o[0], o[1]); w.y = cvt_pk_bf16(o[2], o[3]);
                        if (bad) { w.x = 0x7fc07fc0u; w.y = 0x7fc07fc0u; } *(u32x2v*)(xn + off + bj * HALF + n * 16) = w; }
                asm volatile("" ::: "memory"); }
    }
};

template <class Epi, class Sched, bool STAMP = false>
__device__ __forceinline__ void gemm_phase(PG8_LAS unsigned char* lds, const Gemm g, const Sched& S, const Epi& E, unsigned long long* stamps) {
    int tid = threadIdx.x; asm volatile("" : "+v"(tid));
    const int wid = __builtin_amdgcn_readfirstlane(tid >> 6), lane = tid & 63, wr = wid >> 2, wc = wid & 3, fr = lane & 15, fq = lane >> 4;
    const int K = g.K, nt = K / BK;
    int ts_lo = 0, ts_hi = 0, nts = 0; const unsigned long long rt_entry = STAMP ? (unsigned long long)wall_clock64() : 0ull;
#define PG8_STAMP() do { if (STAMP && wid == 0 && nts < 64) { const unsigned long long _c = (unsigned long long)clock64(); \
        ts_lo = (lane == nts) ? (int)(unsigned)_c : ts_lo; ts_hi = (lane == nts) ? (int)(unsigned)(_c >> 32) : ts_hi; ++nts; } } while (0)
    PG8_STAMP();
    unsigned voffA[2], voffB[2];
#pragma unroll
    for (int i = 0; i < 2; ++i) { int R, C; stage_rc(tid * 16 + i * 8192, R, C); const int Rb = Epi::PERM ? ((R & ~31) + perm32(R & 31)) : R;
        voffA[i] = (unsigned)(R * K + C) * 2u; voffB[i] = (unsigned)(Rb * K + C) * 2u; }
    const size_t kstep = (size_t)(BK * 2);
    const size_t hstep = (size_t)HALF * K * 2;
    const size_t tstep = 2 * hstep;
    const unsigned ldsw = (unsigned)wid * 1024u;
    const int aoff = lds_byte(wr * 64 + fr, fq * 8), boff = lds_byte(wc * 32 + fr, fq * 8);
#define PG8_SA(b, h) (((b) * 2 + (h)) * HTB)
#define PG8_SB(b, h) ((4 + (b) * 2 + (h)) * HTB)
#define PG8_STAGE(bufoff, gbase, voff) do { _Pragma("unroll") for (int _i = 0; _i < 2; ++_i) \
        __builtin_amdgcn_global_load_lds((const unsigned*)((const char*)(gbase) + (voff)[_i]), (PG8_LAS unsigned*)(lds + (bufoff) + ldsw + _i * 8192), 16, 0, 0); } while (0)
#define PG8_LDA(dst, b, h) do { _Pragma("unroll") for (int m = 0; m < 4; ++m) _Pragma("unroll") for (int k = 0; k < 2; ++k) dst[m][k] = *(const PG8_LAS bf16x8*)(lds + PG8_SA(b, h) + aoff + m * 2048 + k * 1024); } while (0)
#define PG8_LDB(dst, b, h) do { _Pragma("unroll") for (int n = 0; n < 2; ++n) _Pragma("unroll") for (int k = 0; k < 2; ++k) dst[n][k] = *(const PG8_LAS bf16x8*)(lds + PG8_SB(b, h) + boff + n * 2048 + k * 1024); } while (0)
#define PG8_MMA(ai, bj, At, Bt) do { __builtin_amdgcn_s_setprio(1); _Pragma("unroll") for (int m = 0; m < 4; ++m) _Pragma("unroll") for (int n = 0; n < 2; ++n) _Pragma("unroll") for (int k = 0; k < 2; ++k) \
        acc[ai][bj][m][n] = __builtin_amdgcn_mfma_f32_16x16x32_bf16(Bt[n][k], At[m][k], acc[ai][bj][m][n], 0, 0, 0); __builtin_amdgcn_s_setprio(0); } while (0)
#define PG8_WAIT_V(n) asm volatile("s_waitcnt vmcnt(" #n ")" ::: "memory")
#define PG8_WAIT_L(n) asm volatile("s_waitcnt lgkmcnt(" #n ")" ::: "memory")
#define PG8_BAR __builtin_amdgcn_s_barrier()
#define PG8_SCHED __builtin_amdgcn_sched_barrier(0)
    Unit cur, nxt; int ui = 0;
    if (!S.next(0, cur)) return;
    f32x4 acc[2][2][4][2];
#pragma unroll
    for (int a = 0; a < 2; ++a)
#pragma unroll
        for (int b = 0; b < 2; ++b)
#pragma unroll
            for (int m = 0; m < 4; ++m)
#pragma unroll
                for (int n = 0; n < 2; ++n) acc[a][b][m][n] = (f32x4){0.f, 0.f, 0.f, 0.f};
    bf16x8 At[4][2], B0[2][2], B1[2][2];
    const char* cA = (const char*)g.A + (size_t)cur.pm * tstep; const char* cB = (const char*)g.Bt + (size_t)cur.pn * tstep;
    S.a_ready(cur);
    PG8_STAGE(PG8_SB(0, 0), cB, voffB); PG8_STAGE(PG8_SA(0, 0), cA, voffA); PG8_STAGE(PG8_SB(0, 1), cB + hstep, voffB); PG8_STAGE(PG8_SA(0, 1), cA + hstep, voffA);
    if (wr == 1) PG8_BAR;
    PG8_WAIT_V(4); PG8_BAR;
    PG8_STAGE(PG8_SB(1, 0), cB + kstep, voffB); PG8_STAGE(PG8_SA(1, 0), cA + kstep, voffA); PG8_STAGE(PG8_SB(1, 1), cB + hstep + kstep, voffB);
    PG8_WAIT_V(6); PG8_BAR;
    PG8_STAMP();
    for (;;) {
        const bool has_next = S.next(ui + 1, nxt);
        const char* nA = has_next ? (const char*)g.A + (size_t)nxt.pm * tstep : cA; const char* nB = has_next ? (const char*)g.Bt + (size_t)nxt.pn * tstep : cB;
        for (int t = 0; t < nt; t += 2) {
            const bool last = (t == nt - 2);
            const char* a1 = cA + (size_t)(t + 1) * kstep;
            const char* a2 = last ? nA : cA + (size_t)(t + 2) * kstep; const char* b2 = last ? nB : cB + (size_t)(t + 2) * kstep;
            const char* a3 = a2 + kstep; const char* b3 = b2 + kstep;
            if (last && has_next) S.a_ready(nxt);
            PG8_LDB(B0, 0, 0); PG8_SCHED; PG8_LDA(At, 0, 0); PG8_STAGE(PG8_SA(1, 1), a1 + hstep, voffA);
            PG8_WAIT_L(8); PG8_BAR; PG8_WAIT_L(0); PG8_MMA(0, 0, At, B0); PG8_BAR; PG8_SCHED;
            PG8_LDB(B1, 0, 1); PG8_STAGE(PG8_SB(0, 0), b2, voffB);
            PG8_BAR; PG8_WAIT_L(0); PG8_MMA(0, 1, At, B1); PG8_BAR;
            PG8_LDA(At, 0, 1); PG8_STAGE(PG8_SA(0, 0), a2, voffA);
            PG8_BAR; PG8_WAIT_L(0); PG8_MMA(1, 0, At, B0); PG8_BAR; PG8_SCHED;
            PG8_STAGE(PG8_SB(0, 1), b2 + hstep, voffB);
            PG8_WAIT_V(6); PG8_BAR; PG8_MMA(1, 1, At, B1); PG8_BAR;
            PG8_LDB(B0, 1, 0); PG8_SCHED; PG8_LDA(At, 1, 0); PG8_STAGE(PG8_SA(0, 1), a2 + hstep, voffA);
            PG8_WAIT_L(8); PG8_BAR; PG8_WAIT_L(0); PG8_MMA(0, 0, At, B0); PG8_BAR; PG8_SCHED;
            PG8_LDB(B1, 1, 1); PG8_STAGE(PG8_SB(1, 0), b3, voffB);
            PG8_BAR; PG8_WAIT_L(0); PG8_MMA(0, 1, At, B1); PG8_BAR;
            PG8_LDA(At, 1, 1); PG8_STAGE(PG8_SA(1, 0), a3, voffA);
            PG8_BAR; PG8_WAIT_L(0); PG8_MMA(1, 0, At, B0); PG8_BAR; PG8_SCHED;
            PG8_STAGE(PG8_SB(1, 1), b3 + hstep, voffB);
            PG8_WAIT_V(6); PG8_BAR; PG8_MMA(1, 1, At, B1); PG8_BAR;
        }
        PG8_STAMP();
        if constexpr (!Epi::AFTER_DRAIN) { E(acc, cur, wr, wc, fr, fq); S.done(cur); }
        PG8_STAMP();
        if (!has_next) break;
#pragma unroll
        for (int a = 0; a < 2; ++a)
#pragma unroll
            for (int b = 0; b < 2; ++b)
#pragma unroll
                for (int m = 0; m < 4; ++m)
#pragma unroll
                    for (int n = 0; n < 2; ++n) acc[a][b][m][n] = (f32x4){0.f, 0.f, 0.f, 0.f};
        cur = nxt; cA = nA; cB = nB; ++ui;
    }
    PG8_WAIT_V(0);
    if (wr == 0) PG8_BAR;
    PG8_BAR;
    if constexpr (Epi::AFTER_DRAIN) { E.fused(acc, cur, wr, wc, fr, fq, lds, wid, lane); S.done(cur); }
    PG8_STAMP();
    if (STAMP && wid == 0) { stamps[lane] = lane < nts ? (((unsigned long long)(unsigned)ts_hi << 32) | (unsigned)ts_lo) : 0ull;
        if (lane == 62) stamps[62] = rt_entry; if (lane == 63) stamps[63] = (unsigned long long)wall_clock64(); }
#undef PG8_STAMP
#undef PG8_SA
#undef PG8_SB
#undef PG8_STAGE
#undef PG8_LDA
#undef PG8_LDB
#undef PG8_MMA
#undef PG8_WAIT_V
#undef PG8_WAIT_L
#undef PG8_BAR
#undef PG8_SCHED
}
}
namespace pg8 {
__device__ __forceinline__ float bflo(unsigned w) { return __uint_as_float(w << 16); }
__device__ __forceinline__ float bfhi(unsigned w) { return __uint_as_float(w & 0xffff0000u); }
struct EpiResF32 {
    static constexpr bool PERM = true, AFTER_DRAIN = false;
    float* C; const bf16_t* R; int ldc; float alpha;
    __device__ __forceinline__ void operator()(const f32x4 (&acc)[2][2][4][2], const Unit& u, int wr, int wc, int fr, int fq) const {
        const int row0 = u.pm * BM + wr * 64 + fr, col0 = u.pn * BM + wc * 32 + 8 * fq;
#pragma unroll
        for (int ai = 0; ai < 2; ++ai)
#pragma unroll
            for (int m = 0; m < 4; ++m) { const size_t off = (size_t)(row0 + ai * HALF + m * 16) * ldc + col0;
#pragma unroll
                for (int bj = 0; bj < 2; ++bj) { const u32x4 r = *(const u32x4*)(R + off + bj * HALF);
                    f32x4 v0 = acc[ai][bj][m][0], v1 = acc[ai][bj][m][1];
                    v0[0] += alpha * bflo(r.x); v0[1] += alpha * bfhi(r.x); v0[2] += alpha * bflo(r.y); v0[3] += alpha * bfhi(r.y);
                    v1[0] += alpha * bflo(r.z); v1[1] += alpha * bfhi(r.z); v1[2] += alpha * bflo(r.w); v1[3] += alpha * bfhi(r.w);
                    *(f32x4*)(C + off + bj * HALF) = v0; *(f32x4*)(C + off + bj * HALF + 4) = v1; } }
    }
};
struct EpiSwiGLU {
    static constexpr bool PERM = true, AFTER_DRAIN = false;
    bf16_t* O; int ldc;
    __device__ __forceinline__ static float silu_mul(float g, float u) { return g * u * __builtin_amdgcn_rcpf(1.0f + __builtin_amdgcn_exp2f(-1.4426950408889634f * g)); }
    __device__ __forceinline__ void operator()(const f32x4 (&acc)[2][2][4][2], const Unit& u, int wr, int wc, int fr, int fq) const {
        const int row0 = u.pm * BM + wr * 64 + fr, col0 = u.pn * HALF + wc * 32 + 8 * fq;
#pragma unroll
        for (int ai = 0; ai < 2; ++ai)
#pragma unroll
            for (int m = 0; m < 4; ++m) { bf16_t* rowp = O + (size_t)(row0 + ai * HALF + m * 16) * ldc + col0;
                const f32x4 g0 = acc[ai][0][m][0], g1 = acc[ai][0][m][1], u0 = acc[ai][1][m][0], u1 = acc[ai][1][m][1];
                u32x4 w; w.x = cvt_pk_bf16(silu_mul(g0[0], u0[0]), silu_mul(g0[1], u0[1])); w.y = cvt_pk_bf16(silu_mul(g0[2], u0[2]), silu_mul(g0[3], u0[3]));
                w.z = cvt_pk_bf16(silu_mul(g1[0], u1[0]), silu_mul(g1[1], u1[1])); w.w = cvt_pk_bf16(silu_mul(g1[2], u1[2]), silu_mul(g1[3], u1[3]));
                *(u32x4*)rowp = w; }
    }
};
}
#define XB_TMO      128
#define XB_XCNT(j)  (256  + 64 * (j))
#define XB_XSUB(j)  (1280 + 64 * (j))
#define XB_XGEN(j)  (2304 + 64 * (j))
#define XB_TOP      3328
#define XB_TOPGEN   3392
#define XCD_BAR_WORDS 3456
#define XB_SPIN_CAP (1u << 18)
#define LAS __attribute__((address_space(3)))

__device__ __forceinline__ unsigned xb_ld(unsigned* p)              { return __hip_atomic_load(p, __ATOMIC_RELAXED, __HIP_MEMORY_SCOPE_AGENT); }
__device__ __forceinline__ unsigned xb_add(unsigned* p, unsigned v) { return __hip_atomic_fetch_add(p, v, __ATOMIC_RELAXED, __HIP_MEMORY_SCOPE_AGENT); }
__device__ __forceinline__ unsigned xb_xcc_id() { return (unsigned)__builtin_amdgcn_s_getreg((3 << 11) | 20) & 0xFu; }
#define XB_SPIN(cond, bar) do { unsigned _sp = 0; while (cond) { __builtin_amdgcn_s_sleep(1); \
    if ((++_sp & 255u) == 0u) { if (xb_ld(&(bar)[XB_TMO])) break; if (_sp > XB_SPIN_CAP) { atomicAdd(&(bar)[XB_TMO], 1u); break; } } } } while (0)

struct XcdBarrier {
    unsigned* bar; unsigned x;
    volatile LAS unsigned* st;
};

__device__ __forceinline__ XcdBarrier xcd_barrier_post(unsigned* bar, volatile LAS unsigned* st) {
    XcdBarrier b; b.bar = bar; b.x = xb_xcc_id(); b.st = st;
    if (threadIdx.x == 0) (void)xb_add(&bar[XB_XCNT(b.x)], 1u);
    return b;
}
__device__ __forceinline__ void xcd_barrier_complete(unsigned* bar, unsigned x, unsigned& nloc, unsigned& nx) {
    const unsigned G = gridDim.x * gridDim.y * gridDim.z;
    unsigned sum, cnt, mine, sp = 0u;
    for (;;) {
        sum = 0u; cnt = 0u; mine = 0u;
#pragma unroll
        for (unsigned j = 0; j < 16; ++j) { const unsigned c = xb_ld(&bar[XB_XCNT(j)]); sum += c; cnt += (c > 0u) ? 1u : 0u; mine = (j == x) ? c : mine; }
        if (sum == G) break;
        __builtin_amdgcn_s_sleep(1);
        if ((++sp & 255u) == 0u) { if (xb_ld(&bar[XB_TMO])) break; if (sp > XB_SPIN_CAP) { atomicAdd(&bar[XB_TMO], 1u); break; } }
    }
    nloc = mine > 0u ? mine : 1u; nx = cnt > 0u ? cnt : 1u;
}

__device__ __forceinline__ void xcd_barrier(const XcdBarrier& b) {
    asm volatile("s_waitcnt vmcnt(0)" ::: "memory");
    __syncthreads();
    if (threadIdx.x == 0) {
        unsigned* bar = b.bar;
        __builtin_amdgcn_s_waitcnt(0);
        unsigned nloc = b.st[0], nx = b.st[1];
        if (nloc == 0u) { xcd_barrier_complete(bar, b.x, nloc, nx); b.st[0] = nloc; b.st[1] = nx; }
        const unsigned old = xb_add(&bar[XB_XSUB(b.x)], 1u);
        const unsigned gen = old / nloc;
        if (old + 1u == (gen + 1u) * nloc) {
            __builtin_amdgcn_fence(__ATOMIC_RELEASE, "agent");
            asm volatile("s_waitcnt vmcnt(0)" ::: "memory");
            const unsigned og = xb_add(&bar[XB_TOP], 1u);
            const unsigned tg = og / nx;
            if (og + 1u == (tg + 1u) * nx) xb_add(&bar[XB_TOPGEN], 1u);
            else XB_SPIN(xb_ld(&bar[XB_TOPGEN]) == tg, bar);
            __builtin_amdgcn_fence(__ATOMIC_ACQUIRE, "agent");
            xb_add(&bar[XB_XGEN(b.x)], 1u);
            asm volatile("s_waitcnt vmcnt(0)" ::: "memory");
        } else {
            XB_SPIN(xb_ld(&bar[XB_XGEN(b.x)]) == gen, bar);
            __builtin_amdgcn_fence(__ATOMIC_ACQUIRE, "agent");
            asm volatile("s_waitcnt vmcnt(0)" ::: "memory");
        }
    }
    __syncthreads();
}

#ifndef HOST_TEST
#define FHD __device__ __forceinline__
#define SIN2PI(x) __builtin_amdgcn_sinf(x)
#define COS2PI(x) __builtin_amdgcn_cosf(x)
#define LP LAS
#else
#define FHD inline
#define SIN2PI(x) ((float)sin(6.283185307179586 * (double)(x)))
#define COS2PI(x) ((float)cos(6.283185307179586 * (double)(x)))
#define LP
#endif
typedef float cf __attribute__((ext_vector_type(2)));
FHD cf cmk(float a, float b) { cf r = {a, b}; return r; }
FHD cf cadd(cf a, cf b) { return cmk(a.x + b.x, a.y + b.y); }
FHD cf csub(cf a, cf b) { return cmk(a.x - b.x, a.y - b.y); }
FHD cf cmul(cf a, cf b) { return cmk(a.x * b.x - a.y * b.y, a.x * b.y + a.y * b.x); }
FHD int PADI(int a) { return a + (a >> 4); }
constexpr int FFT_BUF_CF = 16384 + 1024;

template <bool INV> FHD void dft2(cf& a, cf& b) { const cf s = cadd(a, b), d = csub(a, b); a = s; b = d; }
template <bool INV> FHD void dft4(cf& a, cf& b, cf& c, cf& d) {
    const cf s0 = cadd(a, c), s1 = csub(a, c), s2 = cadd(b, d), s3 = csub(b, d);
    a = cadd(s0, s2); c = csub(s0, s2);
    if (!INV) { b = cmk(s1.x + s3.y, s1.y - s3.x); d = cmk(s1.x - s3.y, s1.y + s3.x); }
    else      { b = cmk(s1.x - s3.y, s1.y + s3.x); d = cmk(s1.x + s3.y, s1.y - s3.x); }
}
#define DR16(r) (4 * ((r) & 3) + ((r) >> 2))
template <bool INV> FHD void dft16(cf (&x)[16]) {
    constexpr float C1 = 0.92387953251128674f, S1 = 0.38268343236508977f, H = 0.70710678118654752f;
#pragma unroll
    for (int k0 = 0; k0 < 4; ++k0) dft4<INV>(x[k0], x[4 + k0], x[8 + k0], x[12 + k0]);
    const float sg = INV ? 1.f : -1.f;
    const cf w1 = cmk(C1, sg * S1), w2 = cmk(H, sg * H), w3 = cmk(S1, sg * C1), w4 = cmk(0.f, sg * 1.f), w6 = cmk(-H, sg * H), w9 = cmk(-C1, -sg * S1);
    x[4 * 1 + 1] = cmul(x[4 * 1 + 1], w1); x[4 * 1 + 2] = cmul(x[4 * 1 + 2], w2); x[4 * 1 + 3] = cmul(x[4 * 1 + 3], w3);
    x[4 * 2 + 1] = cmul(x[4 * 2 + 1], w2); x[4 * 2 + 2] = cmul(x[4 * 2 + 2], w4); x[4 * 2 + 3] = cmul(x[4 * 2 + 3], w6);
    x[4 * 3 + 1] = cmul(x[4 * 3 + 1], w3); x[4 * 3 + 2] = cmul(x[4 * 3 + 2], w6); x[4 * 3 + 3] = cmul(x[4 * 3 + 3], w9);
#pragma unroll
    for (int r0 = 0; r0 < 4; ++r0) dft4<INV>(x[4 * r0], x[4 * r0 + 1], x[4 * r0 + 2], x[4 * r0 + 3]);
}
template <bool INV> FHD void twid16(cf (&w)[16], float frac) {
    const float c = COS2PI(frac), s = SIN2PI(frac);
    w[1] = cmk(c, INV ? s : -s);
    w[2] = cmul(w[1], w[1]); w[3] = cmul(w[2], w[1]); w[4] = cmul(w[2], w[2]); w[5] = cmul(w[4], w[1]); w[6] = cmul(w[3], w[3]); w[7] = cmul(w[4], w[3]);
    w[8] = cmul(w[4], w[4]); w[9] = cmul(w[8], w[1]); w[10] = cmul(w[5], w[5]); w[11] = cmul(w[8], w[3]); w[12] = cmul(w[6], w[6]); w[13] = cmul(w[8], w[5]);
    w[14] = cmul(w[7], w[7]); w[15] = cmul(w[8], w[7]);
}
#define STG_OFF(k, lgst) (((k) << (lgst)) + ((((k) << (lgst))) >> 4))
template <bool INV, bool NOTW, int LGS> FHD void fft_stage16(LP cf* buf, int id) {
    constexpr int lgst = LGS - 4, st = 1 << lgst; const int blk = id >> lgst, j = id & (st - 1), base = (blk << LGS) + j;
    LP cf* pb = buf + PADI(base);
    cf x[16];
#pragma unroll
    for (int k = 0; k < 16; ++k) x[k] = pb[STG_OFF(k, lgst)];
    if (!INV) {
        dft16<false>(x);
        if (!NOTW) { cf w[16]; twid16<false>(w, (float)j * (1.0f / (float)(1 << LGS)));
#pragma unroll
            for (int r = 1; r < 16; ++r) x[DR16(r)] = cmul(x[DR16(r)], w[r]); }
#pragma unroll
        for (int r = 0; r < 16; ++r) pb[STG_OFF(r, lgst)] = x[DR16(r)];
    } else {
        if (!NOTW) { cf w[16]; twid16<true>(w, (float)j * (1.0f / (float)(1 << LGS)));
#pragma unroll
            for (int r = 1; r < 16; ++r) x[r] = cmul(x[r], w[r]); }
        dft16<true>(x);
#pragma unroll
        for (int r = 0; r < 16; ++r) pb[STG_OFF(r, lgst)] = x[DR16(r)];
    }
}
template <int RL> FHD void fft_mid(LP cf* buf, const cf* K, int id) {
    LP cf* pb = buf + PADI(RL * id);
    cf x[RL];
#pragma unroll
    for (int k = 0; k < RL; ++k) x[k] = pb[k];
    cf kk[RL];
#pragma unroll
    for (int k = 0; k < RL; ++k) kk[k] = K[RL * id + k];
    if constexpr (RL == 4) { dft4<false>(x[0], x[1], x[2], x[3]); } else { dft2<false>(x[0], x[1]); }
#pragma unroll
    for (int k = 0; k < RL; ++k) x[k] = cmul(x[k], kk[k]);
    if constexpr (RL == 4) { dft4<true>(x[0], x[1], x[2], x[3]); } else { dft2<true>(x[0], x[1]); }
#pragma unroll
    for (int k = 0; k < RL; ++k) pb[k] = x[k];
}
FHD int pos_to_freq(int p, int lgN) {
    const int lgRL = lgN - 12;
    const int r1 = p >> (lgN - 4), r2 = (p >> (lgN - 8)) & 15, r3 = (p >> lgRL) & 15, r4 = p & ((1 << lgRL) - 1);
    return r1 + 16 * r2 + 256 * r3 + 4096 * r4;
}
constexpr int NT = 512;
typedef unsigned short bf16raw;
FHD float bf2f(bf16raw b) { unsigned u = ((unsigned)b) << 16; float f; __builtin_memcpy(&f, &u, 4); return f; }
FHD bf16raw f2bf(float f) { unsigned u; __builtin_memcpy(&u, &f, 4); u += 0x7fffu + ((u >> 16) & 1u); return (bf16raw)(u >> 16); }

typedef float f32v8 __attribute__((ext_vector_type(8)));
typedef float f32v16 __attribute__((ext_vector_type(16)));
template <int E> struct VecT;
template <> struct VecT<8> { typedef f32v8 type; };
template <> struct VecT<16> { typedef f32v16 type; };
FHD float bflo_(unsigned w) { unsigned u = w << 16; float f; __builtin_memcpy(&f, &u, 4); return f; }
FHD float bfhi_(unsigned w) { unsigned u = w & 0xffff0000u; float f; __builtin_memcpy(&f, &u, 4); return f; }
template <int E> FHD void load_conv(const bf16raw* row, int L, int t0, float w0, float w1, float w2, float bias, typename VecT<E>::type& out) {
    static_assert(E == 8 || E == 16, "E");
    const float um = (t0 > 0) ? bf2f(row[t0 - 1]) : 0.f;
    const float up = (t0 + E < L) ? bf2f(row[t0 + E]) : 0.f;
    const uint4 q0 = *(const uint4*)(row + t0);
    const float x0 = bflo_(q0.x), x1 = bfhi_(q0.x), x2 = bflo_(q0.y), x3 = bfhi_(q0.y), x4 = bflo_(q0.z), x5 = bfhi_(q0.z), x6 = bflo_(q0.w), x7 = bfhi_(q0.w);
    out[0] = w0 * um + w1 * x0 + w2 * x1 + bias; out[1] = w0 * x0 + w1 * x1 + w2 * x2 + bias; out[2] = w0 * x1 + w1 * x2 + w2 * x3 + bias; out[3] = w0 * x2 + w1 * x3 + w2 * x4 + bias;
    out[4] = w0 * x3 + w1 * x4 + w2 * x5 + bias; out[5] = w0 * x4 + w1 * x5 + w2 * x6 + bias; out[6] = w0 * x5 + w1 * x6 + w2 * x7 + bias;
    if constexpr (E == 8) { out[7] = w0 * x6 + w1 * x7 + w2 * up + bias; }
    else {
        const uint4 q1 = *(const uint4*)(row + t0 + 8);
        const float y0 = bflo_(q1.x), y1 = bfhi_(q1.x), y2 = bflo_(q1.y), y3 = bfhi_(q1.y), y4 = bflo_(q1.z), y5 = bfhi_(q1.z), y6 = bflo_(q1.w), y7 = bfhi_(q1.w);
        out[7] = w0 * x6 + w1 * x7 + w2 * y0 + bias;
        out[8] = w0 * x7 + w1 * y0 + w2 * y1 + bias; out[9] = w0 * y0 + w1 * y1 + w2 * y2 + bias; out[10] = w0 * y1 + w1 * y2 + w2 * y3 + bias; out[11] = w0 * y2 + w1 * y3 + w2 * y4 + bias;
        out[12] = w0 * y3 + w1 * y4 + w2 * y5 + bias; out[13] = w0 * y4 + w1 * y5 + w2 * y6 + bias; out[14] = w0 * y5 + w1 * y6 + w2 * y7 + bias; out[15] = w0 * y6 + w1 * y7 + w2 * up + bias;
    }
}
template <int E> FHD void store_bf16_run(bf16raw* dst, const typename VecT<E>::type& v) {
#pragma unroll
    for (int q = 0; q < E / 8; ++q) {
        uint4 o;
        o.x = (unsigned)f2bf(v[8 * q + 0]) | ((unsigned)f2bf(v[8 * q + 1]) << 16); o.y = (unsigned)f2bf(v[8 * q + 2]) | ((unsigned)f2bf(v[8 * q + 3]) << 16);
        o.z = (unsigned)f2bf(v[8 * q + 4]) | ((unsigned)f2bf(v[8 * q + 5]) << 16); o.w = (unsigned)f2bf(v[8 * q + 6]) | ((unsigned)f2bf(v[8 * q + 7]) << 16);
        *(uint4*)(dst + 8 * q) = o;
    }
}
#ifndef HOST_TEST
#define UNIT_SYNC() __syncthreads()
#define TID_LOOP
#define TID_DECL const int tid = threadIdx.x
#else
#define UNIT_SYNC()
#endif

template <int E> struct HyState { typename VecT<E>::type a, b; };

struct HyArgs {
    const bf16raw* rowX1A; const bf16raw* rowX2A; const bf16raw* rowVA;
    bf16raw* outA;
    const cf* K1; const cf* K2;
    float sw[3][3]; float sb[3];
    float skip0, skip1;
};
template <int LOGL> FHD void hy_sec_load_v(LP cf* buf, const HyArgs& A, int tid, HyState<(1 << LOGL) / NT>& st) {
    constexpr int L = 1 << LOGL, E = L / NT; const int t0 = tid * E;
    load_conv<E>(A.rowVA, L, t0, A.sw[2][0], A.sw[2][1], A.sw[2][2], A.sb[2], st.a);
    load_conv<E>(A.rowVA + L, L, t0, A.sw[2][0], A.sw[2][1], A.sw[2][2], A.sb[2], st.b);
    LP cf* pb = buf + PADI(t0);
#pragma unroll
    for (int e = 0; e < E; ++e) { pb[e] = cmk(st.a[e], st.b[e]); pb[PADI(L) + e] = cmk(0.f, 0.f); }
}
template <int LOGL> FHD void hy_sec_gate1(LP cf* buf, const HyArgs& A, int tid, HyState<(1 << LOGL) / NT>& st) {
    constexpr int L = 1 << LOGL, E = L / NT; const int t0 = tid * E;
    typename VecT<E>::type xa, xb;
    load_conv<E>(A.rowX1A, L, t0, A.sw[0][0], A.sw[0][1], A.sw[0][2], A.sb[0], xa);
    load_conv<E>(A.rowX1A + L, L, t0, A.sw[0][0], A.sw[0][1], A.sw[0][2], A.sb[0], xb);
    LP cf* pb = buf + PADI(t0);
#pragma unroll
    for (int e = 0; e < E; ++e) { const cf y = pb[e];
        st.a[e] = xa[e] * (y.x + st.a[e] * A.skip0); st.b[e] = xb[e] * (y.y + st.b[e] * A.skip0);
        pb[e] = cmk(st.a[e], st.b[e]); pb[PADI(L) + e] = cmk(0.f, 0.f); }
}
template <int LOGL> FHD void hy_sec_gate2(LP cf* buf, const HyArgs& A, int tid, HyState<(1 << LOGL) / NT>& st) {
    constexpr int L = 1 << LOGL, E = L / NT; const int t0 = tid * E;
    typename VecT<E>::type xa, xb;
    load_conv<E>(A.rowX2A, L, t0, A.sw[1][0], A.sw[1][1], A.sw[1][2], A.sb[1], xa);
    load_conv<E>(A.rowX2A + L, L, t0, A.sw[1][0], A.sw[1][1], A.sw[1][2], A.sb[1], xb);
    LP cf* pb = buf + PADI(t0);
#pragma unroll
    for (int e = 0; e < E; ++e) { const cf y = pb[e];
        xa[e] = xa[e] * (y.x + st.a[e] * A.skip1); xb[e] = xb[e] * (y.y + st.b[e] * A.skip1); }
    store_bf16_run<E>(A.outA + t0, xa); store_bf16_run<E>(A.outA + L + t0, xb);
}

template <int LOGL> FHD void kf_sec_load(LP cf* buf, const float* hf, const float* hb, int tid) {
    constexpr int L = 1 << LOGL;
    LP cf* pb = buf + PADI(tid);
#pragma unroll
    for (int i = 0; i < L / NT; ++i) { const int n = tid + NT * i;
        pb[544 * i] = cmk(hf[n], 0.f);
        pb[PADI(L) + 544 * i] = cmk(n == 0 ? 0.f : hb[L - n], 0.f);
    }
}
template <int LOGN> FHD void kf_sec_tail(LP cf* buf, cf* K, int id) {
    constexpr int RL = 1 << (LOGN - 12); constexpr float sc = 1.0f / (float)(1 << LOGN);
    cf x[RL];
#pragma unroll
    for (int k = 0; k < RL; ++k) x[k] = buf[PADI(RL * id) + k];
    if constexpr (RL == 4) { dft4<false>(x[0], x[1], x[2], x[3]); } else { dft2<false>(x[0], x[1]); }
#pragma unroll
    for (int k = 0; k < RL; ++k) K[RL * id + k] = cmk(x[k].x * sc, x[k].y * sc);
}

template <int LOGN> FHD int PADF(int k) { return LOGN == 13 ? (k + (k >> 8)) : (k + 4 * (k >> 6)); }
template <int LOGN> FHD void fn_sec_load(LP cf* buf, const bf16raw* rowC, const bf16raw* rowS, int tid) {
    constexpr int N = 1 << LOGN, E = N / NT; const int t0 = tid * E;
    LP cf* pb = buf + PADI(t0);
#pragma unroll
    for (int v = 0; v < E / 8; ++v) {
        const uint4 qc = *(const uint4*)(rowC + t0 + 8 * v), qs = *(const uint4*)(rowS + t0 + 8 * v);
        pb[8 * v + 0] = cmk(bflo_(qc.x), bflo_(qs.x)); pb[8 * v + 1] = cmk(bfhi_(qc.x), bfhi_(qs.x));
        pb[8 * v + 2] = cmk(bflo_(qc.y), bflo_(qs.y)); pb[8 * v + 3] = cmk(bfhi_(qc.y), bfhi_(qs.y));
        pb[8 * v + 4] = cmk(bflo_(qc.z), bflo_(qs.z)); pb[8 * v + 5] = cmk(bfhi_(qc.z), bfhi_(qs.z));
        pb[8 * v + 6] = cmk(bflo_(qc.w), bflo_(qs.w)); pb[8 * v + 7] = cmk(bfhi_(qc.w), bfhi_(qs.w));
    }
}
template <int LOGN> FHD void fn_sec_tail_read(LP cf* buf, int id, float (&re)[16]) {
    if (LOGN == 13) {
        cf a = buf[PADI(2 * id)], b = buf[PADI(2 * id) + 1]; dft2<false>(a, b); re[0] = a.x; re[1] = b.x;
    } else {
        cf x[16];
#pragma unroll
        for (int k = 0; k < 16; ++k) x[k] = buf[PADI(16 * id) + k];
        dft16<false>(x);
#pragma unroll
        for (int r = 0; r < 16; ++r) re[r] = x[DR16(r)].x;
    }
}
template <int LOGN> FHD void fn_sec_tail_write(LP float* fbuf, int id, const float (&re)[16]) {
    if (LOGN == 13) { fbuf[PADF<LOGN>(pos_to_freq(2 * id, LOGN))] = re[0]; fbuf[PADF<LOGN>(pos_to_freq(2 * id + 1, LOGN))] = re[1]; }
    else {
#pragma unroll
        for (int r = 0; r < 16; ++r) fbuf[PADF<LOGN>(pos_to_freq(16 * id + r, LOGN))] = re[r];
    }
}
template <int LOGN> FHD void fn_sec_store(LP const float* fbuf, bf16raw* out, float scale, int tid) {
    constexpr int N = 1 << LOGN;
    for (int k = tid; k < N; k += NT) out[k] = f2bf(fbuf[PADF<LOGN>(k)] * scale);
}

#ifndef HOST_TEST
#define LAUNDER_TID(t) int t = threadIdx.x; asm volatile("" : "+v"(t))
template <int LOGN, bool INV, int LGS> __device__ __forceinline__ void dev_stage(LAS cf* buf) {
    LAUNDER_TID(tid);
    for (int id = tid; id < (1 << (LOGN - 4)); id += NT) fft_stage16<INV, false, LGS>(buf, id);
    __syncthreads();
}
template <int LOGN, bool INV> __device__ __forceinline__ void dev_stages16(LAS cf* buf) {
    if constexpr (!INV) { dev_stage<LOGN, false, LOGN>(buf); dev_stage<LOGN, false, LOGN - 4>(buf); if constexpr (LOGN - 8 > 4) dev_stage<LOGN, false, LOGN - 8>(buf); }
    else { if constexpr (LOGN - 8 > 4) dev_stage<LOGN, true, LOGN - 8>(buf); dev_stage<LOGN, true, LOGN - 4>(buf); dev_stage<LOGN, true, LOGN>(buf); }
}
template <int LOGN> __device__ __forceinline__ void dev_fftconv(LAS cf* buf, const cf* K) {
    constexpr int RL = 1 << (LOGN - 12);
    dev_stages16<LOGN, false>(buf);
    { LAUNDER_TID(tid); for (int id = tid; id < (1 << LOGN) / RL; id += NT) fft_mid<RL>(buf, K, id); }
    __syncthreads();
    dev_stages16<LOGN, true>(buf);
}
template <int LOGL> __device__ __forceinline__ void dev_hyena_unit(LAS cf* buf, const HyArgs& A) {
    HyState<(1 << LOGL) / NT> st;
    { LAUNDER_TID(tid); hy_sec_load_v<LOGL>(buf, A, tid, st); } __syncthreads();
    dev_fftconv<LOGL + 1>(buf, A.K1);
    { LAUNDER_TID(tid); hy_sec_gate1<LOGL>(buf, A, tid, st); } __syncthreads();
    dev_fftconv<LOGL + 1>(buf, A.K2);
    { LAUNDER_TID(tid); hy_sec_gate2<LOGL>(buf, A, tid, st); } __syncthreads();
}
template <int LOGL> __device__ __forceinline__ void dev_kf_unit(LAS cf* buf, const float* hf, const float* hb, cf* K) {
    constexpr int LOGN = LOGL + 1, RL = 1 << (LOGN - 12);
    { LAUNDER_TID(tid); kf_sec_load<LOGL>(buf, hf, hb, tid); } __syncthreads();
    dev_stages16<LOGN, false>(buf);
    { LAUNDER_TID(tid); for (int id = tid; id < (1 << LOGN) / RL; id += NT) kf_sec_tail<LOGN>(buf, K, id); }
    __syncthreads();
}
template <int LOGN> __device__ __forceinline__ void dev_fnet_unit(LAS cf* buf, const bf16raw* rowC, const bf16raw* rowS, bf16raw* out, float scale) {
    { LAUNDER_TID(tid); fn_sec_load<LOGN>(buf, rowC, rowS, tid); } __syncthreads();
    dev_stages16<LOGN, false>(buf);
    LAUNDER_TID(tid);
    if constexpr (LOGN == 13) {
        float re[16];
#pragma unroll
        for (int h = 0; h < 8; ++h) { const int id = tid + NT * h; const cf a = buf[PADI(2 * id)], b = buf[PADI(2 * id) + 1]; re[2 * h] = a.x + b.x; re[2 * h + 1] = a.x - b.x; }
        __syncthreads();
        LAS float* fbuf = (LAS float*)buf;
#pragma unroll
        for (int h = 0; h < 8; ++h) { const int id = tid + NT * h; fbuf[PADF<LOGN>(pos_to_freq(2 * id, LOGN))] = re[2 * h]; fbuf[PADF<LOGN>(pos_to_freq(2 * id + 1, LOGN))] = re[2 * h + 1]; }
    } else {
        float re[16];
        if (tid < 256) fn_sec_tail_read<LOGN>(buf, tid, re);
        __syncthreads();
        if (tid < 256) fn_sec_tail_write<LOGN>((LAS float*)buf, tid, re);
    }
    __syncthreads();
    fn_sec_store<LOGN>((LAS const float*)buf, out, scale, tid); __syncthreads();
}
#endif
constexpr int DM = 4096, NTOK = 32768, TOK_S0 = 16384, LP_ = 8192, LS_ = 4096, DFF = 11008, INW = 7168;
constexpr int LPOS = LP_ + LS_;
constexpr float ALPHA = 1.4142135623730951f;
constexpr float LN_EPS = 1e-5f;
constexpr int NPH = 20;
constexpr size_t MiB = 1u << 20;
constexpr size_t WS_CTL = 0, CTL_ZERO_BYTES = 1 * MiB;
constexpr size_t WS_WIN = 1 * MiB, WS_WFN = 65 * MiB, WS_WOUT = 67 * MiB, WS_WGU = 99 * MiB, WS_WDN = 271 * MiB;
constexpr size_t WS_X = 357 * MiB, WS_UT = 613 * MiB, WS_QK = 965 * MiB, WS_TO = 1125 * MiB, WS_YF = 1253 * MiB, WS_MIX = 1317 * MiB, WS_H3 = 1573 * MiB, WS_END = 1579 * MiB;
constexpr size_t WS_H = WS_UT;
static_assert(WS_H + (size_t)NTOK * DFF * 2 <= WS_MIX, "H overlay");
constexpr size_t WS_HC = WS_MIX;
constexpr size_t OUT_KF0 = 0, OUT_KF1 = 256 * MiB;
constexpr int CW_BAR = 4096;
constexpr int LDS_BYTES = 147456, LDS_MISC = 147456 - 256, LDS_AUX = 139264;

typedef short bf16x8 __attribute__((ext_vector_type(8)));
typedef float f32x4 __attribute__((ext_vector_type(4)));
typedef unsigned short bf16;
typedef unsigned u32x4v __attribute__((ext_vector_type(4)));
typedef unsigned u32x2v __attribute__((ext_vector_type(2)));

struct Params { const float* in[27]; float* out; unsigned char* ws; int ph_lo, ph_hi; };

__device__ __forceinline__ float wave_sum(float v) {
#pragma unroll
    for (int o = 1; o < 64; o <<= 1) v += __shfl_xor(v, o);
    return v;
}
__device__ __forceinline__ unsigned pk2(float lo, float hi) { return (unsigned)f2bf(lo) | ((unsigned)f2bf(hi) << 16); }

template <bool OUT_BF16> __device__ __forceinline__ void ln_row(const float* src, const float* g, const float* b, void* dst, int lane) {
    const f32x4* xr = (const f32x4*)src + lane;
    f32x4 v[16]; float s = 0.f;
#pragma unroll
    for (int j = 0; j < 16; ++j) { v[j] = xr[64 * j]; s += (v[j][0] + v[j][1]) + (v[j][2] + v[j][3]); }
    const float mean = wave_sum(s) * (1.f / DM); float s2 = 0.f;
#pragma unroll
    for (int j = 0; j < 16; ++j) { v[j] = v[j] - mean; s2 += (v[j][0] * v[j][0] + v[j][1] * v[j][1]) + (v[j][2] * v[j][2] + v[j][3] * v[j][3]); }
    const float rstd = 1.f / sqrtf(wave_sum(s2) * (1.f / DM) + LN_EPS);
#pragma unroll
    for (int j = 0; j < 16; ++j) {
        const f32x4 gg = ((const f32x4*)g)[lane + 64 * j], bb = ((const f32x4*)b)[lane + 64 * j];
        const f32x4 o = v[j] * rstd * gg + bb;
        if (OUT_BF16) { uint2 w; w.x = pk2(o[0], o[1]); w.y = pk2(o[2], o[3]); ((uint2*)dst)[lane + 64 * j] = w; }
        else ((f32x4*)dst)[lane + 64 * j] = o;
    }
}
__device__ __forceinline__ void tr_item(const float* W, int ldn, int k0, int n0, bf16* WT, int ldk, int drow0, LAS float* scr, int lane) {
#pragma unroll 8
    for (int i = 0; i < 32; ++i) { const int kk = 2 * i + (lane >> 5); scr[kk * 33 + (lane & 31)] = W[(size_t)(k0 + kk) * ldn + n0 + (lane & 31)]; }
    asm volatile("s_waitcnt lgkmcnt(0)" ::: "memory");
    const int c = lane & 7;
#pragma unroll
    for (int j = 0; j < 4; ++j) { const int n = (lane >> 3) + 8 * j; const LAS float* s = scr + (8 * c) * 33 + n;
        uint4 o; o.x = pk2(s[0 * 33], s[1 * 33]); o.y = pk2(s[2 * 33], s[3 * 33]); o.z = pk2(s[4 * 33], s[5 * 33]); o.w = pk2(s[6 * 33], s[7 * 33]);
        *(uint4*)(WT + (size_t)(drow0 + n) * ldk + k0 + 8 * c) = o; }
    asm volatile("s_waitcnt lgkmcnt(0)" ::: "memory");
}
__device__ __forceinline__ void convert_weights(const Params& p, int l, LAS unsigned char* lds, int gw, int ngw, int wave, int lane) {
    LAS float* scr = (LAS float*)(lds + wave * 16384);
    unsigned char* ws = p.ws;
    const float* w_in = p.in[4] + (size_t)l * DM * INW; const float* w_fn = p.in[16] + (size_t)l * 1024 * 1024; const float* w_out = p.in[19] + (size_t)l * DM * DM;
    const float* w_g = p.in[22] + (size_t)l * DM * DFF; const float* w_u = p.in[23] + (size_t)l * DM * DFF; const float* w_d = p.in[24] + (size_t)l * DFF * DM;
    constexpr int I_IN = 64 * 224, I_FN = 16 * 32, I_OUT = 64 * 128, I_G = 64 * 344, I_D = 172 * 128;
    constexpr int NITEMS = I_IN + I_FN + I_OUT + 2 * I_G + I_D;
    for (int it = gw; it < NITEMS; it += ngw) {
        int r = it;
        if (r < I_IN) { const int kb = r / 224, nb = r % 224, n0 = 32 * nb; int d0;
            if (n0 < 3072) d0 = n0; else if (n0 < 4096) continue; else if (n0 < 6144) d0 = 5632 + (n0 - 4096); else if (n0 < 6656) d0 = 7680 + (n0 - 6144); else d0 = 5120 + (n0 - 6656);
            tr_item(w_in, INW, 64 * kb, n0, (bf16*)(ws + WS_WIN), DM, d0 - 0, scr, lane); continue; }
        r -= I_IN;
        if (r < I_FN) { const int kb = r / 32, nb = r % 32; tr_item(w_fn, 1024, 64 * kb, 32 * nb, (bf16*)(ws + WS_WFN), 1024, 32 * nb, scr, lane); continue; }
        r -= I_FN;
        if (r < I_OUT) { const int kb = r / 128, nb = r % 128; tr_item(w_out, DM, 64 * kb, 32 * nb, (bf16*)(ws + WS_WOUT), DM, 32 * nb, scr, lane); continue; }
        r -= I_OUT;
        if (r < I_G) { const int kb = r / 344, nb = r % 344, n0 = 32 * nb; tr_item(w_g, DFF, 64 * kb, n0, (bf16*)(ws + WS_WGU), DM, 256 * (n0 >> 7) + (n0 & 127), scr, lane); continue; }
        r -= I_G;
        if (r < I_G) { const int kb = r / 344, nb = r % 344, n0 = 32 * nb; tr_item(w_u, DFF, 64 * kb, n0, (bf16*)(ws + WS_WGU), DM, 256 * (n0 >> 7) + 128 + (n0 & 127), scr, lane); continue; }
        r -= I_G;
        { const int kb = r / 128, nb = r % 128; tr_item(w_d, DM, 64 * kb, 32 * nb, (bf16*)(ws + WS_WDN), DFF, 32 * nb, scr, lane); }
    }
}
__device__ __forceinline__ void fold_fnet(const Params& p, int l, LAS unsigned char* lds, int bid, int nb) {
    LAUNDER_TID(tid); LAS float* wt = (LAS float*)lds;
    LAS float* ct = (LAS float*)(lds + 64 * 129 * 4);
    const float* w_in = p.in[4] + (size_t)l * DM * INW; bf16* WT = (bf16*)(p.ws + WS_WIN);
    if (tid < 128) { ct[tid] = cosf(6.283185307179586f * (float)tid / 128.f); ct[128 + tid] = sinf(6.283185307179586f * (float)tid / 128.f); }
    for (int it = bid; it < 512; it += nb) {
        const int kb = it >> 3, h = it & 7, k0 = 64 * kb;
        __syncthreads();
        for (int e = tid; e < 64 * 128; e += NT) { const int kk = e >> 7, d = e & 127; wt[kk * 129 + d] = w_in[(size_t)(k0 + kk) * INW + 3072 + h * 128 + d]; }
        __syncthreads();
        const int kk = tid & 63, rg = tid >> 6;
        for (int i = 0; i < 32; ++i) { const int r = rg + 8 * i, k2 = r & 127; const bool is_s = r >= 128; float a = 0.f;
            const LAS float* tb = ct + (is_s ? 128 : 0);
#pragma unroll 8
            for (int d = 0; d < 128; ++d) a += wt[kk * 129 + d] * tb[(k2 * d) & 127];
            WT[(size_t)((is_s ? 4096 : 3072) + h * 128 + k2) * DM + k0 + kk] = f2bf(is_s ? -a : a); }
    }
    __syncthreads();
}
__device__ __forceinline__ void h3_items(const Params& p, LAS unsigned char* lds, int bid, int nb) {
    LAUNDER_TID(tid); const int pp = tid >> 6, j = tid & 63;
    LAS float* z = (LAS float*)lds; LAS float* hA = z + 8 * 36; LAS float* hB = hA + 8 * 64;
    float* h3 = (float*)(p.ws + WS_H3);
    for (int it = bid; it < 2 * (LPOS / 8); it += nb) {
        const int l = it / (LPOS / 8), g = (it % (LPOS / 8)) * 8 + pp; const int Lt = g < LP_ ? LP_ : LS_, t = g < LP_ ? g : g - LP_;
        const float* w1 = p.in[7] + l * 33 * 64; const float* b1 = p.in[8] + l * 64; const float* w2 = p.in[9] + l * 4096; const float* b2 = p.in[10] + l * 64;
        const float* w3 = p.in[11] + l * 4096; const float* b3 = p.in[12] + l * 64; const float* fq = p.in[13] + l * 192;
        __syncthreads();
        if (j < 33) { const float wv = (6.283185307179586f / (float)Lt) * (float)t; float val;
            if (j == 0) val = (float)t / (float)(Lt - 1);
            else if (j <= 16) { const float f = 1e-4f + (float)(j - 1) * ((15.0f - 1e-4f) / 15.0f); val = cosf(f * wv); }
            else { const float f = 1e-4f + (float)(j - 17) * ((15.0f - 1e-4f) / 15.0f); val = -sinf(f * wv); }
            z[pp * 36 + j] = val; }
        __syncthreads();
        float a = b1[j];
        for (int i = 0; i < 33; ++i) a += z[pp * 36 + i] * w1[i * 64 + j];
        hA[pp * 64 + j] = sinf(fq[j] * a);
        __syncthreads();
        a = b2[j];
        for (int m = 0; m < 64; ++m) a += hA[pp * 64 + m] * w2[m * 64 + j];
        hB[pp * 64 + j] = sinf(fq[64 + j] * a);
        __syncthreads();
        a = b3[j];
        for (int m = 0; m < 64; ++m) a += hB[pp * 64 + m] * w3[m * 64 + j];
        h3[((size_t)l * LPOS + g) * 64 + j] = sinf(fq[128 + j] * a);
    }
    __syncthreads();
}
__device__ __forceinline__ void hc_items(const Params& p, int l, LAS unsigned char* lds, int bid, int nb) {
    LAUNDER_TID(tid); LAS float* lw = (LAS float*)lds;
    const float* h3 = (const float*)(p.ws + WS_H3) + (size_t)l * LPOS * 64; const float* w4 = p.in[14] + (size_t)l * 64 * 4096; float* Hc = (float*)(p.ws + WS_HC);
    const float dmin = -3.0701134573253946f, dmax = -15.350567286626973f, dstep = (dmax - dmin) / 1023.0f;
    for (int it = bid; it < 24 * 32; it += nb) {
        const int tb = it >> 5, jg = it & 31, g = tb * 512 + tid; const int Lt = g < LP_ ? LP_ : LS_, t = g < LP_ ? g : g - LP_;
        const float tl = (float)t / (float)(Lt - 1);
        const f32x4* hrow = (const f32x4*)(h3 + (size_t)g * 64);
        for (int jb = 0; jb < 8; ++jb) { const int j0 = (jg * 8 + jb) * 16;
            __syncthreads();
            if (tid < 256) ((LAS f32x4*)lw)[tid] = *(const f32x4*)(w4 + (size_t)(tid >> 2) * 4096 + j0 + 4 * (tid & 3));
            __syncthreads();
            f32x4 acc0 = {0.f, 0.f, 0.f, 0.f}, acc1 = acc0, acc2 = acc0, acc3 = acc0;
#pragma unroll 4
            for (int mq = 0; mq < 16; ++mq) { const f32x4 hv = hrow[mq];
#pragma unroll
                for (int e = 0; e < 4; ++e) { const int m = 4 * mq + e; const float hs = hv[e];
                    acc0 += hs * ((const LAS f32x4*)lw)[m * 4 + 0]; acc1 += hs * ((const LAS f32x4*)lw)[m * 4 + 1]; acc2 += hs * ((const LAS f32x4*)lw)[m * 4 + 2]; acc3 += hs * ((const LAS f32x4*)lw)[m * 4 + 3]; } }
            const f32x4 acc[4] = {acc0, acc1, acc2, acc3};
#pragma unroll
            for (int q = 0; q < 4; ++q)
#pragma unroll
                for (int e = 0; e < 4; ++e) { const int j = j0 + 4 * q + e, c = j & 1023; const float delta = fabsf(dmin + (float)c * dstep);
                    Hc[(size_t)j * LPOS + g] = acc[q][e] * expf(-tl * delta); }
        }
    }
    __syncthreads();
}
__device__ __forceinline__ void kf_units(const Params& p, LAS unsigned char* lds, int bid, int nb) {
    const float* Hc = (const float*)(p.ws + WS_HC); LAS cf* buf = (LAS cf*)lds;
    for (int u = bid; u < 4096; u += nb) {
        const int lt = u >> 11, o = (u >> 10) & 1, c = u & 1023;
        const float* hf = Hc + (size_t)(o * 1024 + c) * LPOS + (lt ? LP_ : 0); const float* hb = Hc + (size_t)(2048 + o * 1024 + c) * LPOS + (lt ? LP_ : 0);
        if (lt == 0) dev_kf_unit<13>(buf, hf, hb, (cf*)((unsigned char*)p.out + OUT_KF0) + (size_t)(o * 1024 + c) * 16384);
        else dev_kf_unit<12>(buf, hf, hb, (cf*)((unsigned char*)p.out + OUT_KF1) + (size_t)(o * 1024 + c) * 8192);
    }
}
__device__ __forceinline__ void attn_unit(LAS unsigned char* lds, const bf16* QK, const bf16* UT, bf16* MIX, const float* sink, int tok0, int nblk, int n, int h) {
    LAUNDER_TID(tid); const int lane = tid & 63, w = tid >> 6, fr = lane & 15, g = lane >> 4, kh = h >> 2;
    LAS bf16* Ks = (LAS bf16*)lds; LAS bf16* Vs = Ks + 128 * 136;
    const bf16* qrow = QK + (size_t)(tok0 + 128 * n + 16 * w + fr) * 2560 + 128 * h;
    bf16x8 qf[4];
#pragma unroll
    for (int kk = 0; kk < 4; ++kk) qf[kk] = *(const bf16x8*)(qrow + 32 * kk + 8 * g);
    const float LOG2E = 1.4426950408889634f;
    float m_run = sink[h] * LOG2E, l_run = 1.f;
    f32x4 o[8];
#pragma unroll
    for (int dt = 0; dt < 8; ++dt) o[dt] = (f32x4){0.f, 0.f, 0.f, 0.f};
    const float slope = exp2f(-0.5f * (float)(h + 1)) * LOG2E, sc = 0.08838834764831845f * LOG2E;
    const int qi = 16 * w + fr;
    for (int jc = -1; jc <= 1; ++jc) {
        const int kb = n + jc; if (kb < 0 || kb >= nblk) continue;
        __syncthreads();
        { const int r = tid >> 2, q4 = tid & 3;
          const bf16* srcK = QK + (size_t)(tok0 + 128 * kb + r) * 2560 + 2048 + 128 * kh + 32 * q4;
          const bf16* srcV = UT + (size_t)(5120 + 128 * kh + r) * NTOK + tok0 + 128 * kb + 32 * q4;
          u32x4v kv[4], vv[4];
#pragma unroll
          for (int i = 0; i < 4; ++i) { kv[i] = *(const u32x4v*)(srcK + 8 * i); vv[i] = *(const u32x4v*)(srcV + 8 * i); }
#pragma unroll
          for (int i = 0; i < 4; ++i) { *(LAS u32x4v*)(Ks + r * 136 + 32 * q4 + 8 * i) = kv[i]; *(LAS u32x4v*)(Vs + r * 136 + 32 * q4 + 8 * i) = vv[i]; } }
        __syncthreads();
        f32x4 s[8];
#pragma unroll
        for (int kt = 0; kt < 8; ++kt) { f32x4 acc = (f32x4){0.f, 0.f, 0.f, 0.f};
#pragma unroll
            for (int kk = 0; kk < 4; ++kk) { const bf16x8 a = *(const LAS bf16x8*)(Ks + (16 * kt + fr) * 136 + 32 * kk + 8 * g); acc = __builtin_amdgcn_mfma_f32_16x16x32_bf16(a, qf[kk], acc, 0, 0, 0); }
            s[kt] = acc; }
        float mx = -3.0e38f;
#pragma unroll
        for (int kt = 0; kt < 8; ++kt)
#pragma unroll
            for (int i = 0; i < 4; ++i) { const int ki = 16 * kt + 4 * g + i; int dist = qi - ki - 128 * jc; dist = dist < 0 ? -dist : dist;
                float v = s[kt][i] * sc - slope * (float)dist; v = (dist <= 128) ? v : -__builtin_inff(); s[kt][i] = v; mx = fmaxf(mx, v); }
        mx = fmaxf(mx, __shfl_xor(mx, 16)); mx = fmaxf(mx, __shfl_xor(mx, 32));
        const float m_new = fmaxf(m_run, mx), alpha = __builtin_amdgcn_exp2f(m_run - m_new);
        float ps = 0.f;
#pragma unroll
        for (int kt = 0; kt < 8; ++kt)
#pragma unroll
            for (int i = 0; i < 4; ++i) { const float pv = __builtin_amdgcn_exp2f(s[kt][i] - m_new); ps += pv; s[kt][i] = pv; }
        ps += __shfl_xor(ps, 16); ps += __shfl_xor(ps, 32);
        l_run = l_run * alpha + ps; m_run = m_new;
#pragma unroll
        for (int dt = 0; dt < 8; ++dt) o[dt] *= alpha;
#pragma unroll
        for (int ks = 0; ks < 4; ++ks) {
            union { bf16x8 v; unsigned u[4]; } pb;
            pb.u[0] = pk2(s[2 * ks][0], s[2 * ks][1]); pb.u[1] = pk2(s[2 * ks][2], s[2 * ks][3]); pb.u[2] = pk2(s[2 * ks + 1][0], s[2 * ks + 1][1]); pb.u[3] = pk2(s[2 * ks + 1][2], s[2 * ks + 1][3]);
#pragma unroll
            for (int dt = 0; dt < 8; ++dt) { const LAS bf16* vp = Vs + (16 * dt + fr) * 136 + 32 * ks + 4 * g;
                union { bf16x8 v; u32x2v h[2]; } a; a.h[0] = *(const LAS u32x2v*)vp; a.h[1] = *(const LAS u32x2v*)(vp + 16);
                o[dt] = __builtin_amdgcn_mfma_f32_16x16x32_bf16(a.v, pb.v, o[dt], 0, 0, 0); }
        }
    }
    const float inv = 1.0f / l_run;
    bf16* orow = MIX + (size_t)(tok0 + 128 * n + 16 * w + fr) * DM + 2048 + 128 * h + 4 * g;
#pragma unroll
    for (int dt = 0; dt < 8; ++dt) { uint2 wv; wv.x = pk2(o[dt][0] * inv, o[dt][1] * inv); wv.y = pk2(o[dt][2] * inv, o[dt][3] * inv); *(uint2*)(orow + 16 * dt) = wv; }
}
__device__ __forceinline__ void mixer_phase(const Params& p, int l, LAS unsigned char* lds, int bid, int nb) {
    const bf16* UT = (const bf16*)(p.ws + WS_UT); bf16* TO = (bf16*)(p.ws + WS_TO); LAS cf* buf = (LAS cf*)lds;
    const cf* KF0 = (const cf*)((const unsigned char*)p.out + OUT_KF0); const cf* KF1 = (const cf*)((const unsigned char*)p.out + OUT_KF1);
    const float* sw = p.in[5] + (size_t)l * 3 * 3072; const float* sb = p.in[6] + (size_t)l * 3072; const float* skip = p.in[15] + (size_t)l * 2048;
#ifndef SK_HY
    for (int u = bid; u < 1024 + 2048; u += nb) {
        const bool pr = u < 1024; const int c = pr ? u : ((u - 1024) & 1023), tokA = pr ? 0 : TOK_S0 + ((u - 1024) >> 10) * 2 * LS_;
        HyArgs A; A.rowX1A = UT + (size_t)c * NTOK + tokA; A.rowX2A = UT + (size_t)(1024 + c) * NTOK + tokA; A.rowVA = UT + (size_t)(2048 + c) * NTOK + tokA; A.outA = TO + (size_t)c * NTOK + tokA;
        A.K1 = pr ? KF0 + (size_t)c * 16384 : KF1 + (size_t)c * 8192; A.K2 = pr ? KF0 + (size_t)(1024 + c) * 16384 : KF1 + (size_t)(1024 + c) * 8192;
#pragma unroll
        for (int i = 0; i < 3; ++i) {
#pragma unroll
            for (int k = 0; k < 3; ++k) A.sw[i][k] = sw[k * 3072 + i * 1024 + c];
            A.sb[i] = sb[i * 1024 + c]; }
        A.skip0 = skip[c]; A.skip1 = skip[1024 + c];
        if (pr) dev_hyena_unit<13>(buf, A); else dev_hyena_unit<12>(buf, A);
    }
#endif
#ifndef SK_FN
    for (int u = bid; u < 2048 + 4096; u += nb) {
        const bool pr = u < 2048; const int v = pr ? u : u - 2048, c = v & 1023, b = v >> 10, tok0 = pr ? b * LP_ : TOK_S0 + b * LS_;
        const bf16* rc = UT + (size_t)(3072 + c) * NTOK + tok0; const bf16* rs = UT + (size_t)(4096 + c) * NTOK + tok0; bf16* out = TO + (size_t)(1024 + c) * NTOK + tok0;
        if (pr) dev_fnet_unit<13>(buf, rc, rs, out, 9.765625e-4f  ); else dev_fnet_unit<12>(buf, rc, rs, out, 1.3810679320049757e-3f  );
    }
#endif
#ifndef SK_AT
    const bf16* QK = (const bf16*)(p.ws + WS_QK); bf16* MIX = (bf16*)(p.ws + WS_MIX); const float* sink = p.in[18] + l * 16;
    for (int u = bid; u < 4096; u += nb) {
        const bool pr = u < 2048; const int v = pr ? u : u - 2048, h = v & 15, r = v >> 4;
        const int nblk = pr ? 64 : 32, sq = r / nblk, n = r % nblk, tok0 = pr ? sq * LP_ : TOK_S0 + sq * LS_;
        attn_unit(lds, QK, UT, MIX, sink, tok0, nblk, n, h);
    }
#endif
    __syncthreads();
}
__device__ __forceinline__ void transpose_out(const Params& p, int gw, int ngw, int lane) {
    const bf16* TO = (const bf16*)(p.ws + WS_TO); bf16* MIX = (bf16*)(p.ws + WS_MIX); bf16* YF = (bf16*)(p.ws + WS_YF);
    for (int it = gw; it < 64 * 512; it += ngw) {
        const int cb = it & 63, tb = it >> 6, ch0 = 32 * cb, tok = 64 * tb + lane;
        unsigned w[16];
#pragma unroll
        for (int i = 0; i < 16; ++i) { const unsigned lo = TO[(size_t)(ch0 + 2 * i) * NTOK + tok], hi = TO[(size_t)(ch0 + 2 * i + 1) * NTOK + tok]; w[i] = lo | (hi << 16); }
        bf16* dst = ch0 < 1024 ? MIX + (size_t)tok * DM + ch0 : YF + (size_t)tok * 1024 + (ch0 - 1024);
#pragma unroll
        for (int q = 0; q < 4; ++q) { uint4 o; o.x = w[4 * q]; o.y = w[4 * q + 1]; o.z = w[4 * q + 2]; o.w = w[4 * q + 3]; *(uint4*)(dst + 8 * q) = o; }
    }
}

__global__ void __launch_bounds__(512, 2) mega_fwd(Params p) {
    extern __shared__ __attribute__((aligned(16))) unsigned char lds_raw[];
    LAS unsigned char* lds = (LAS unsigned char*)lds_raw;
    const int tid = threadIdx.x;
    const int bid = blockIdx.x, nb = gridDim.x, ngw = nb * 8;
#define PH_IDS LAUNDER_TID(tid_); const int lane = tid_ & 63, wave = __builtin_amdgcn_readfirstlane(tid_ >> 6), gw = bid * 8 + wave; (void)lane; (void)gw
    volatile LAS unsigned* misc = (volatile LAS unsigned*)(lds + LDS_MISC);
    if (tid < 64) misc[tid] = 0u;
    __syncthreads();
    const int lo = p.ph_lo, hi = p.ph_hi;
    const bool multi = (hi - lo) > 1;
    XcdBarrier bar; bar.bar = (unsigned*)(p.ws + WS_CTL) + CW_BAR; bar.x = 0; bar.st = nullptr;
    if (multi) bar = xcd_barrier_post((unsigned*)(p.ws + WS_CTL) + CW_BAR, misc + 8);
#ifndef PH_EN
#define PH_EN 0x7FF
#endif
#define IN(k) (((PH_EN >> ((k) < 2 ? (k) : 2 + ((k) - 2) % 9)) & 1) && lo <= (k) && (k) < hi)
#define SEAM(k) do { if (IN(k) && IN((k) + 1)) xcd_barrier(bar); } while (0)
    unsigned char* ws = p.ws;
    bf16* X = (bf16*)(ws + WS_X); bf16* MIX = (bf16*)(ws + WS_MIX);

    if (IN(0)) { PH_IDS;
        h3_items(p, lds, bid, nb);
        convert_weights(p, 0, lds, gw, ngw, wave, lane);
        __syncthreads();
        fold_fnet(p, 0, lds, bid, nb);
        for (int m = gw; m < NTOK; m += ngw) ln_row<true>(m < TOK_S0 ? p.in[0] + (size_t)m * DM : p.in[1] + (size_t)(m - TOK_S0) * DM, p.in[2], p.in[3], X + (size_t)m * DM, lane);
    }
    SEAM(0);
    if (IN(1)) hc_items(p, 0, lds, bid, nb);
    SEAM(1);
    for (int l = 0; l < 2; ++l) {
        const int pb = 2 + 9 * l;
        if (IN(pb + 0)) {
#ifndef SK_GA
            for (int gi = 0; gi < 2; ++gi) {
                const bf16* Wt = (const bf16*)(ws + WS_WIN);
                pg8::Gemm g{gi == 0 ? Wt : X, gi == 0 ? X : Wt + (size_t)5632 * DM, gi == 0 ? 5632 : NTOK, gi == 0 ? NTOK : 2560, DM};
                pg8::StaticOrder S; S.init(g.M, g.N, nb, bid);
                pg8::EpiBf16<0> E{gi == 0 ? (bf16*)(ws + WS_UT) : (bf16*)(ws + WS_QK), gi == 0 ? NTOK : 2560, nullptr, 0, 0};
                pg8::gemm_phase<pg8::EpiBf16<0>, pg8::StaticOrder>(lds, g, S, E, nullptr);
            }
#endif
#ifndef SK_KF
            kf_units(p, lds, bid, nb);
#endif
        }
        SEAM(pb + 0);
        if (IN(pb + 1)) mixer_phase(p, l, lds, bid, nb);
        SEAM(pb + 1);
        if (IN(pb + 2)) { PH_IDS; transpose_out(p, gw, ngw, lane); }
        SEAM(pb + 2);
        if (IN(pb + 3)) {
            pg8::Gemm g{(const bf16*)(ws + WS_YF), (const bf16*)(ws + WS_WFN), NTOK, 1024, 1024}; pg8::StaticOrder S; S.init(NTOK, 1024, nb, bid);
            pg8::EpiBf16<0> E{MIX + 1024, DM, p.in[17] + l * 1024, 0, 0};
            pg8::gemm_phase<pg8::EpiBf16<0>, pg8::StaticOrder>(lds, g, S, E, nullptr);
        }
        SEAM(pb + 3);
        if (IN(pb + 4)) {
            pg8::Gemm g{MIX, (const bf16*)(ws + WS_WOUT), NTOK, DM, DM}; pg8::StaticOrder S; S.init(NTOK, DM, nb, bid);
            pg8::EpiResF32 E{p.out, X, DM, ALPHA};
            pg8::gemm_phase<pg8::EpiResF32, pg8::StaticOrder>(lds, g, S, E, nullptr);
        }
        SEAM(pb + 4);
        if (IN(pb + 5)) { PH_IDS; for (int m = gw; m < NTOK; m += ngw) ln_row<true>(p.out + (size_t)m * DM, p.in[20] + l * DM, p.in[21] + l * DM, MIX + (size_t)m * DM, lane); }
        SEAM(pb + 5);
        if (IN(pb + 6)) {
            pg8::Gemm g{MIX, (const bf16*)(ws + WS_WGU), NTOK, 2 * DFF, DM}; pg8::StaticOrder S; S.init(NTOK, 2 * DFF, nb, bid);
            pg8::EpiSwiGLU E{(bf16*)(ws + WS_H), DFF};
            pg8::gemm_phase<pg8::EpiSwiGLU, pg8::StaticOrder>(lds, g, S, E, nullptr);
        }
        SEAM(pb + 6);
        if (IN(pb + 7)) {
            pg8::Gemm g{(const bf16*)(ws + WS_H), (const bf16*)(ws + WS_WDN), NTOK, DM, DFF}; pg8::StaticOrder S; S.init(NTOK, DM, nb, bid);
            pg8::EpiResF32 E{p.out, MIX, DM, ALPHA};
            pg8::gemm_phase<pg8::EpiResF32, pg8::StaticOrder>(lds, g, S, E, nullptr);
        }
        SEAM(pb + 7);
        if (IN(pb + 8)) { PH_IDS;
            if (l == 0) {
                for (int m = gw; m < NTOK; m += ngw) ln_row<true>(p.out + (size_t)m * DM, p.in[25] + l * DM, p.in[26] + l * DM, X + (size_t)m * DM, lane);
                __syncthreads();
                convert_weights(p, 1, lds, gw, ngw, wave, lane);
                __syncthreads();
                fold_fnet(p, 1, lds, bid, nb);
                hc_items(p, 1, lds, bid, nb);
            } else {
                for (int m = gw; m < NTOK; m += ngw) ln_row<false>(p.out + (size_t)m * DM, p.in[25] + l * DM, p.in[26] + l * DM, p.out + (size_t)m * DM, lane);
            }
        }
        if (l == 0) SEAM(pb + 8);
    }
#undef IN
#undef SEAM
}

extern "C" void kernel_launch(void* const* d_in, const int* in_sizes, int n_in, void* d_out, int out_size, void* d_ws, size_t ws_size, hipStream_t stream) {
    static int grid = 0;
    if (grid == 0) {
        if (n_in != 27 || out_size != 2 * TOK_S0 * DM || ws_size < WS_END) { fprintf(stderr, "kernel_launch: unexpected shapes (n_in %d, out %d, ws %zu)\n", n_in, out_size, ws_size); grid = -1; return; }
        int dev = 0, cus = 0, per_cu = 0;
        if (hipGetDevice(&dev) != hipSuccess || hipDeviceGetAttribute(&cus, hipDeviceAttributeMultiprocessorCount, dev) != hipSuccess) { grid = -1; return; }
        if (hipFuncSetAttribute((const void*)mega_fwd, hipFuncAttributeMaxDynamicSharedMemorySize, LDS_BYTES) != hipSuccess) { fprintf(stderr, "kernel_launch: hipFuncSetAttribute failed\n"); grid = -1; return; }
        if (hipOccupancyMaxActiveBlocksPerMultiprocessor(&per_cu, (const void*)mega_fwd, 512, LDS_BYTES) != hipSuccess || per_cu < 1) fprintf(stderr, "kernel_launch: occupancy query reports %d\n", per_cu);
        (void)hipGetLastError();
        grid = cus;
    }
    if (grid < 0) return;
    (void)in_sizes;
    if (hipMemsetAsync((char*)d_ws + WS_CTL, 0, CTL_ZERO_BYTES, stream) != hipSuccess) return;
    Params p{};
    for (int i = 0; i < 27; ++i) p.in[i] = (const float*)d_in[i];
    p.out = (float*)d_out; p.ws = (unsigned char*)d_ws;
#if MK_MULTI
    for (int k = 0; k < NPH; ++k) { p.ph_lo = k; p.ph_hi = k + 1; hipLaunchKernelGGL(mega_fwd, dim3(grid), dim3(512), LDS_BYTES, stream, p); }
#else
    p.ph_lo = 0; p.ph_hi = NPH;
    hipLaunchKernelGGL(mega_fwd, dim3(grid), dim3(512), LDS_BYTES, stream, p);
#endif
}
```

```cpp
#include <hip/hip_runtime.h>
#include <cstdio>
#include <cmath>
#define MK_MULTI 0
namespace pg8 {
#define PG8_LAS __attribute__((address_space(3)))
typedef unsigned short bf16_t;
typedef short bf16x8 __attribute__((ext_vector_type(8)));
typedef float f32x4 __attribute__((ext_vector_type(4)));
typedef unsigned u32x4 __attribute__((ext_vector_type(4)));
constexpr int BM = 256, BK = 64, HALF = 128, HTB = HALF * BK * 2  , STAGE_BYTES = 8 * HTB, NXCD = 8, WGM = 8;

__host__ __device__ __forceinline__ int lds_byte(int r, int c) { const int st = (r >> 4) * 2 + (c >> 5), rr = r & 15, cc = c & 31, ob = rr * 64 + cc * 2; return st * 1024 + (ob ^ (((ob >> 9) & 1) << 5)); }
__host__ __device__ __forceinline__ void stage_rc(int b, int& R, int& C) { const int st = b / 1024, sb = b % 1024, swz = sb ^ (((sb >> 9) & 1) << 5); R = (st >> 1) * 16 + swz / 64; C = (st & 1) * 32 + (swz % 64) / 2; }
__host__ __device__ __forceinline__ int perm32(int rho) { const int n = rho >> 4, i = rho & 15; return 8 * (i >> 2) + 4 * n + (i & 3); }

struct Unit { int pm, pn; };
struct Gemm { const bf16_t* A; const bf16_t* Bt; int M, N, K; };

struct StaticOrder {
    int nM, nN, nwg, G, c, wgm;
    __host__ __device__ void init(int M, int N, int G_, int c_, int wgm_ = WGM) { nM = M / BM; nN = N / BM; nwg = nM * nN; G = G_; c = c_; wgm = wgm_; }
    __host__ __device__ bool next(int i, Unit& u) const {
        const long L = (long)i * G + c; if (L >= nwg) return false;
        int wgid = (int)L; { const int q = nwg / NXCD, r = nwg % NXCD, xcd = wgid % NXCD, off = wgid / NXCD; wgid = (xcd < r ? xcd * (q + 1) : r * (q + 1) + (xcd - r) * q) + off; }
        const int nig = wgm * nN, gid = wgid / nig, fm = gid * wgm, gsz = (nM - fm) < wgm ? (nM - fm) : wgm;
        u.pm = fm + ((wgid % nig) % gsz); u.pn = (wgid % nig) / gsz; return true;
    }
    __device__ __forceinline__ void a_ready(const Unit&) const {}
    __device__ __forceinline__ void done(const Unit&) const {}
};
struct CountedOrder : StaticOrder {
    const unsigned* ready; unsigned need; unsigned* tmo;
    __device__ __forceinline__ void a_ready(const Unit& u) const {
        if (threadIdx.x < 64) {
            const unsigned long long t0 = __builtin_amdgcn_s_memrealtime(); unsigned polls = 0;
            while ((unsigned)__builtin_amdgcn_readfirstlane(__hip_atomic_load(ready + 64 * u.pm, __ATOMIC_RELAXED, __HIP_MEMORY_SCOPE_AGENT)) < need) {
                if ((++polls & 255u) == 0u && __builtin_amdgcn_readfirstlane(__hip_atomic_load(tmo, __ATOMIC_RELAXED, __HIP_MEMORY_SCOPE_AGENT)) != 0u) break;
                if (__builtin_amdgcn_s_memrealtime() - t0 > 2000000ull) {
                    if (threadIdx.x == 0) { unsigned expect = 0u; __hip_atomic_compare_exchange_strong(tmo + 1, &expect, 0x600u | (unsigned)(u.pm & 0xff), __ATOMIC_RELAXED, __ATOMIC_RELAXED, __HIP_MEMORY_SCOPE_AGENT); __hip_atomic_store(tmo, 1u, __ATOMIC_RELAXED, __HIP_MEMORY_SCOPE_AGENT); }
                    break; }
                __builtin_amdgcn_s_sleep(2); }
            __builtin_amdgcn_fence(__ATOMIC_ACQUIRE, "agent");
            asm volatile("s_waitcnt vmcnt(0)" ::: "memory");
        }
#if !defined(BROKEN_HOOK_NO_BARRIER)
        asm volatile("" ::: "memory"); __builtin_amdgcn_s_barrier(); asm volatile("" ::: "memory");
#endif
    }
};

__device__ __forceinline__ unsigned cvt_pk_bf16(float lo, float hi) { unsigned r; asm volatile("v_cvt_pk_bf16_f32 %0, %1, %2" : "=v"(r) : "v"(lo), "v"(hi)); return r; }
typedef float f32x2 __attribute__((ext_vector_type(2)));
__device__ __forceinline__ f32x2 gelu_pk(f32x2 v) {
    const f32x2 av = __builtin_elementwise_abs(v), d = av * 0.2316418882f + 1.0f;
    f32x2 t; t.x = __builtin_amdgcn_rcpf(d.x); t.y = __builtin_amdgcn_rcpf(d.y);
    f32x2 q = t * 0.5307027145f + (-0.7265760135f); q = q * t + 0.7107068705f; q = q * t + (-0.142248368f); q = q * t + 0.127414796f; q = q * t;
    const f32x2 s = (v * v) * (-0.72134752044f);
    f32x2 e; e.x = __builtin_amdgcn_exp2f(s.x); e.y = __builtin_amdgcn_exp2f(s.y);
    const f32x2 m = v * (q * e), r = v - m;
    f32x2 o; o.x = v.x < 0.f ? m.x : r.x; o.y = v.y < 0.f ? m.y : r.y; return o;
}

struct EpiF32 {
    static constexpr bool PERM = false, AFTER_DRAIN = false;
    float* C; int ldc; const float* bias;
    __device__ __forceinline__ void operator()(const f32x4 (&acc)[2][2][4][2], const Unit& u, int wr, int wc, int fr, int fq) const {
        const int row0 = u.pm * BM + wr * 64 + fr, col0 = u.pn * BM + wc * 32 + 4 * fq;
        f32x4 bv[2][2];
#pragma unroll
        for (int bj = 0; bj < 2; ++bj)
#pragma unroll
            for (int n = 0; n < 2; ++n) bv[bj][n] = bias ? *(const f32x4*)(bias + col0 + bj * HALF + n * 16) : (f32x4){0.f, 0.f, 0.f, 0.f};
#pragma unroll
        for (int ai = 0; ai < 2; ++ai)
#pragma unroll
            for (int m = 0; m < 4; ++m) { float* rowp = C + (size_t)(row0 + ai * HALF + m * 16) * ldc + col0;
#pragma unroll
                for (int bj = 0; bj < 2; ++bj)
#pragma unroll
                    for (int n = 0; n < 2; ++n) *(f32x4*)(rowp + bj * HALF + n * 16) = acc[ai][bj][m][n] + bv[bj][n]; }
    }
};
template <int ACT  > struct EpiBf16 {
    static constexpr bool PERM = true, AFTER_DRAIN = false;
    bf16_t* O; int ldc; const float* bias; int split_cols; size_t split_stride;
    __device__ __forceinline__ void operator()(const f32x4 (&acc)[2][2][4][2], const Unit& u, int wr, int wc, int fr, int fq) const {
        const int row0 = u.pm * BM + wr * 64 + fr; int colt = u.pn * BM; bf16_t* base = O;
        if (split_cols) { const int t = colt / split_cols; base += (size_t)t * split_stride; colt -= t * split_cols; }
        const int col0 = colt + wc * 32 + 8 * fq, bcol0 = u.pn * BM + wc * 32 + 8 * fq;
        f32x4 bv[2][2];
#pragma unroll
        for (int bj = 0; bj < 2; ++bj)
#pragma unroll
            for (int n = 0; n < 2; ++n) bv[bj][n] = bias ? *(const f32x4*)(bias + bcol0 + bj * HALF + 4 * n) : (f32x4){0.f, 0.f, 0.f, 0.f};
#pragma unroll
        for (int ai = 0; ai < 2; ++ai)
#pragma unroll
            for (int m = 0; m < 4; ++m) { bf16_t* rowp = base + (size_t)(row0 + ai * HALF + m * 16) * ldc + col0;
#pragma unroll
                for (int bj = 0; bj < 2; ++bj) { f32x4 v0 = acc[ai][bj][m][0] + bv[bj][0], v1 = acc[ai][bj][m][1] + bv[bj][1];
                    if (ACT == 1) { f32x2 a = gelu_pk((f32x2){v0[0], v0[1]}), b = gelu_pk((f32x2){v0[2], v0[3]}), c = gelu_pk((f32x2){v1[0], v1[1]}), d = gelu_pk((f32x2){v1[2], v1[3]});
                        v0 = (f32x4){a.x, a.y, b.x, b.y}; v1 = (f32x4){c.x, c.y, d.x, d.y}; }
                    if (ACT == 2) {
#pragma unroll
                        for (int j = 0; j < 4; ++j) { v0[j] = 0.5f * v0[j] * (1.0f + erff(v0[j] * 0.70710678f)); v1[j] = 0.5f * v1[j] * (1.0f + erff(v1[j] * 0.70710678f)); } }
                    u32x4 w; w.x = cvt_pk_bf16(v0[0], v0[1]); w.y = cvt_pk_bf16(v0[2], v0[3]); w.z = cvt_pk_bf16(v1[0], v1[1]); w.w = cvt_pk_bf16(v1[2], v1[3]);
                    *(u32x4*)(rowp + bj * HALF) = w; } }
    }
};

struct PanelStats {
    unsigned* xbuf;
    unsigned* cnt;
    unsigned* tmo;
    int ntn; float eps;
    unsigned code;
    __device__ __forceinline__ bool run(const f32x4 (&v)[2][2][4][2], const Unit& u, int wr, int wc, int fr, int fq, PG8_LAS unsigned char* lds, int wid, int lane) const {
        typedef float f32x2v __attribute__((ext_vector_type(2)));
        PG8_LAS f32x2v* P = (PG8_LAS f32x2v*)lds;
        PG8_LAS f32x2v* S = (PG8_LAS f32x2v*)(lds + 8192);
        PG8_LAS unsigned* flag = (PG8_LAS unsigned*)(lds + 8192 + 2048);
#pragma unroll
        for (int ai = 0; ai < 2; ++ai)
#pragma unroll
            for (int m = 0; m < 4; ++m) {
                float s = 0.f;
#pragma unroll
                for (int bj = 0; bj < 2; ++bj)
#pragma unroll
                    for (int n = 0; n < 2; ++n) { const f32x4 x = v[ai][bj][m][n]; s += (x[0] + x[1]) + (x[2] + x[3]); }
                s += __shfl_xor(s, 16); s += __shfl_xor(s, 32);
                const float mw = s * (1.0f / 64.0f); float q = 0.f;
#pragma unroll
                for (int bj = 0; bj < 2; ++bj)
#pragma unroll
                    for (int n = 0; n < 2; ++n) { const f32x4 d = v[ai][bj][m][n] - mw; q += (d[0] * d[0] + d[1] * d[1]) + (d[2] * d[2] + d[3] * d[3]); }
                q += __shfl_xor(q, 16); q += __shfl_xor(q, 32);
                if (fq == 0) P[(ai * HALF + wr * 64 + m * 16 + fr) * 4 + wc] = (f32x2v){mw, q};
            }
        asm volatile("s_waitcnt lgkmcnt(0)" ::: "memory"); __builtin_amdgcn_s_barrier(); asm volatile("" ::: "memory");
#if defined(BROKEN_NO_WAIT)
        if (blockIdx.x >= 64) { const long long t0 = clock64(); while (clock64() - t0 < 60000) __builtin_amdgcn_s_sleep(8); }
#endif
        const int row = wid * 32 + (lane & 31);
        if (lane < 32) {
            const f32x2v a = P[row * 4 + 0], b = P[row * 4 + 1], c = P[row * 4 + 2], d = P[row * 4 + 3];
            const float mt = (a.x + b.x + c.x + d.x) * 0.25f;
            const float da = a.x - mt, db = b.x - mt, dc = c.x - mt, dd = d.x - mt;
            const float m2 = (a.y + b.y) + (c.y + d.y) + 64.0f * ((da * da + db * db) + (dc * dc + dd * dd));
            unsigned long long* slot = (unsigned long long*)xbuf + ((size_t)(u.pm * BM + row) * 4 + u.pn);
            __hip_atomic_store(slot, ((unsigned long long)__float_as_uint(m2) << 32) | __float_as_uint(mt), __ATOMIC_RELAXED, __HIP_MEMORY_SCOPE_AGENT);
        }
        asm volatile("s_waitcnt vmcnt(0)" ::: "memory");
        if (lane == 0) __hip_atomic_fetch_add(cnt + 64 * u.pm, 1u, __ATOMIC_RELAXED, __HIP_MEMORY_SCOPE_AGENT);
        if (wid == 0) {
            bool dead = false; const unsigned long long t0 = __builtin_amdgcn_s_memrealtime(); const unsigned want = 8u * (unsigned)ntn;
            for (;;) {
#if defined(BROKEN_NO_WAIT)
                break;
#endif
                if ((unsigned)__builtin_amdgcn_readfirstlane(__hip_atomic_load(cnt + 64 * u.pm, __ATOMIC_RELAXED, __HIP_MEMORY_SCOPE_AGENT)) >= want) break;
                if (__builtin_amdgcn_s_memrealtime() - t0 > 2000000ull) {
                    if (lane == 0) { unsigned expect = 0u; __hip_atomic_compare_exchange_strong(tmo + 1, &expect, code | (unsigned)(u.pm & 0xff), __ATOMIC_RELAXED, __ATOMIC_RELAXED, __HIP_MEMORY_SCOPE_AGENT);
                                     __hip_atomic_store(tmo, 1u, __ATOMIC_RELAXED, __HIP_MEMORY_SCOPE_AGENT); }
                    dead = true; break; }
                __builtin_amdgcn_s_sleep(2);
            }
            __builtin_amdgcn_fence(__ATOMIC_ACQUIRE, "agent");
            if (lane == 0) flag[0] = dead ? 1u : 0u;
        }
        asm volatile("s_waitcnt vmcnt(0) lgkmcnt(0)" ::: "memory"); __builtin_amdgcn_s_barrier(); asm volatile("" ::: "memory");
        const bool bad = flag[0] != 0u;
        if (lane < 32) {
            const unsigned long long* slot = (const unsigned long long*)xbuf + (size_t)(u.pm * BM + row) * 4; float mt[4], m2[4]; float ms = 0.f;
#pragma unroll
            for (int t = 0; t < 4; ++t) { if (t < ntn) { const unsigned long long w = __hip_atomic_load(slot + t, __ATOMIC_RELAXED, __HIP_MEMORY_SCOPE_AGENT); mt[t] = __uint_as_float((unsigned)w); m2[t] = __uint_as_float((unsigned)(w >> 32)); } else { mt[t] = 0.f; m2[t] = 0.f; } ms += mt[t]; }
            const float mean = ms / (float)ntn; float q = 0.f;
#pragma unroll
            for (int t = 0; t < 4; ++t) if (t < ntn) { const float dm = mt[t] - mean; q += m2[t] + 256.0f * dm * dm; }
            S[row] = (f32x2v){mean, 1.0f / sqrtf(q / (256.0f * (float)ntn) + eps)};
        }
        asm volatile("s_waitcnt lgkmcnt(0)" ::: "memory"); __builtin_amdgcn_s_barrier(); asm volatile("" ::: "memory");
        return bad;
    }
};
struct EpiLnRes {
    static constexpr bool PERM = false, AFTER_DRAIN = true;
    const float* base; float* out; int ldc; const float* bias; PanelStats st; unsigned poison;
    __device__ __forceinline__ void refuse(size_t i0, size_t stride, int M, int N) const { const float q = __builtin_nanf(""); for (size_t i = i0; i < (size_t)M * N; i += stride) out[(i / N) * ldc + i % N] = q;
        if (i0 == 0) { unsigned expect = 0u; __hip_atomic_compare_exchange_strong(st.tmo + 1, &expect, 0x7f0u, __ATOMIC_RELAXED, __ATOMIC_RELAXED, __HIP_MEMORY_SCOPE_AGENT); __hip_atomic_store(st.tmo, 1u, __ATOMIC_RELAXED, __HIP_MEMORY_SCOPE_AGENT); } }
    __device__ __forceinline__ void fused(f32x4 (&acc)[2][2][4][2], const Unit& u, int wr, int wc, int fr, int fq, PG8_LAS unsigned char* lds, int wid, int lane) const {
        typedef float f32x2v __attribute__((ext_vector_type(2)));
        const PG8_LAS f32x2v* S = (const PG8_LAS f32x2v*)(lds + 8192);
        const int col0 = u.pn * BM + wc * 32 + 4 * fq;
#pragma unroll
        for (int bj = 0; bj < 2; ++bj)
#pragma unroll
            for (int n = 0; n < 2; ++n) { const f32x4 bv = bias ? *(const f32x4*)(bias + col0 + bj * HALF + n * 16) : (f32x4){0.f, 0.f, 0.f, 0.f};
#pragma unroll
                for (int ai = 0; ai < 2; ++ai)
#pragma unroll
                    for (int m = 0; m < 4; ++m) acc[ai][bj][m][n] += bv; }
        const bool bad = st.run(acc, u, wr, wc, fr, fq, lds, wid, lane) || poison != 0u;
        const float qnan = __builtin_nanf("");
#pragma unroll
        for (int ai = 0; ai < 2; ++ai)
#pragma unroll
            for (int m = 0; m < 4; ++m) { const int r = ai * HALF + wr * 64 + m * 16 + fr; const f32x2v sr = S[r]; const size_t off = (size_t)(u.pm * BM + r) * ldc + col0;
#pragma unroll
                for (int bj = 0; bj < 2; ++bj)
#pragma unroll
                    for (int n = 0; n < 2; ++n) { const f32x4 bs = *(const f32x4*)(base + off + bj * HALF + n * 16); f32x4 o = bs + (acc[ai][bj][m][n] - sr.x) * sr.y;
                        if (bad) o = (f32x4){qnan, qnan, qnan, qnan}; *(f32x4*)(out + off + bj * HALF + n * 16) = o; }
                asm volatile("" ::: "memory"); }
    }
};
struct EpiLnResLn {
    static constexpr bool PERM = false, AFTER_DRAIN = true;
    const float* base; float* out; bf16_t* xn; int ldc; const float* bias; PanelStats st1, st2; unsigned poison;
    __device__ __forceinline__ void refuse(size_t i0, size_t stride, int M, int N) const { const float q = __builtin_nanf(""); for (size_t i = i0; i < (size_t)M * N; i += stride) { const size_t o = (i / N) * ldc + i % N; out[o] = q; xn[o] = (bf16_t)0x7fc0u; }
        if (i0 == 0) { unsigned expect = 0u; __hip_atomic_compare_exchange_strong(st1.tmo + 1, &expect, 0x7f0u, __ATOMIC_RELAXED, __ATOMIC_RELAXED, __HIP_MEMORY_SCOPE_AGENT); __hip_atomic_store(st1.tmo, 1u, __ATOMIC_RELAXED, __HIP_MEMORY_SCOPE_AGENT); } }
    __device__ __forceinline__ void fused(f32x4 (&acc)[2][2][4][2], const Unit& u, int wr, int wc, int fr, int fq, PG8_LAS unsigned char* lds, int wid, int lane) const {
        typedef float f32x2v __attribute__((ext_vector_type(2))); typedef unsigned u32x2v __attribute__((ext_vector_type(2)));
        const PG8_LAS f32x2v* S = (const PG8_LAS f32x2v*)(lds + 8192);
        const int col0 = u.pn * BM + wc * 32 + 4 * fq;
#pragma unroll
        for (int bj = 0; bj < 2; ++bj)
#pragma unroll
            for (int n = 0; n < 2; ++n) { const f32x4 bv = bias ? *(const f32x4*)(bias + col0 + bj * HALF + n * 16) : (f32x4){0.f, 0.f, 0.f, 0.f};
#pragma unroll
                for (int ai = 0; ai < 2; ++ai)
#pragma unroll
                    for (int m = 0; m < 4; ++m) acc[ai][bj][m][n] += bv; }
        bool bad = st1.run(acc, u, wr, wc, fr, fq, lds, wid, lane) || poison != 0u;
        const float qnan = __builtin_nanf("");
#pragma unroll
        for (int ai = 0; ai < 2; ++ai)
#pragma unroll
            for (int m = 0; m < 4; ++m) { const int r = ai * HALF + wr * 64 + m * 16 + fr; const f32x2v sr = S[r]; const size_t off = (size_t)(u.pm * BM + r) * ldc + col0;
#pragma unroll
                for (int bj = 0; bj < 2; ++bj)
#pragma unroll
                    for (int n = 0; n < 2; ++n) { const f32x4 bs = *(const f32x4*)(base + off + bj * HALF + n * 16); acc[ai][bj][m][n] = bs + (acc[ai][bj][m][n] - sr.x) * sr.y; }
                asm volatile("" : "+v"(acc[ai][0][m][0]), "+v"(acc[ai][0][m][1]), "+v"(acc[ai][1][m][0]), "+v"(acc[ai][1][m][1]));
                if (m & 1) asm volatile("" ::: "memory"); }
        const bool bad1 = bad;
        bad = st2.run(acc, u, wr, wc, fr, fq, lds, wid, lane) || bad;
#pragma unroll
        for (int ai = 0; ai < 2; ++ai)
#pragma unroll
            for (int m = 0; m < 4; ++m) { const int r = ai * HALF + wr * 64 + m * 16 + fr; const f32x2v sr = S[r]; const size_t off = (size_t)(u.pm * BM + r) * ldc + col0;
#pragma unroll
                for (int bj = 0; bj < 2; ++bj)
#pragma unroll
                    for (int n = 0; n < 2; ++n) { const f32x4 x1 = acc[ai][bj][m][n]; *(f32x4*)(out + off + bj * HALF + n * 16) = bad1 ? (f32x4){qnan, qnan, qnan, qnan} : x1;
                        const f32x4 o = (x1 - sr.x) * sr.y; u32x2v w; w.x = cvt_pk_bf16(o[0], o[1]); w.y = cvt_pk_bf16(o[2], o[3]);
                        if (bad) { w.x = 0x7fc07fc0u; w.y = 0x7fc07fc0u; } *(u32x2v*)(xn + off + bj * HALF + n * 16) = w; }
                asm volatile("" ::: "memory"); }
    }
};

template <class Epi, class Sched, bool ALIGN_EPI = false, bool SP2 = false>
__device__ __forceinline__ void gemm_phase(PG8_LAS unsigned char* lds, const Gemm g, const Sched& S, const Epi& E) {
    int tid = threadIdx.x; asm volatile("" : "+v"(tid));
    const int wid = __builtin_amdgcn_readfirstlane(tid >> 6), lane = tid & 63, wr = wid >> 2, wc = wid & 3, fr = lane & 15, fq = lane >> 4;
    const int K = g.K, nt = K / BK;
    unsigned voffA[2], voffB[2];
#pragma unroll
    for (int i = 0; i < 2; ++i) { int R, C; stage_rc(tid * 16 + i * 8192, R, C); const int Rb = Epi::PERM ? ((R & ~31) + perm32(R & 31)) : R;
        voffA[i] = (unsigned)(R * K + C) * 2u; voffB[i] = (unsigned)(Rb * K + C) * 2u; }
    const size_t kstep = (size_t)(BK * 2);
    const size_t hstep = (size_t)HALF * K * 2;
    const size_t tstep = 2 * hstep;
    const unsigned ldsw = (unsigned)wid * 1024u;
    const int aoff = lds_byte(wr * 64 + fr, fq * 8), boff = lds_byte(wc * 32 + fr, fq * 8);
#define PG8_SA(b, h) (((b) * 2 + (h)) * HTB)
#define PG8_SB(b, h) ((4 + (b) * 2 + (h)) * HTB)
#define PG8_STAGE(bufoff, gbase, voff) do { _Pragma("unroll") for (int _i = 0; _i < 2; ++_i) \
        __builtin_amdgcn_global_load_lds((const unsigned*)((const char*)(gbase) + (voff)[_i]), (PG8_LAS unsigned*)(lds + (bufoff) + ldsw + _i * 8192), 16, 0, 0); } while (0)
#define PG8_LDA(dst, b, h) do { _Pragma("unroll") for (int m = 0; m < 4; ++m) _Pragma("unroll") for (int k = 0; k < 2; ++k) dst[m][k] = *(const PG8_LAS bf16x8*)(lds + PG8_SA(b, h) + aoff + m * 2048 + k * 1024); } while (0)
#define PG8_LDB(dst, b, h) do { _Pragma("unroll") for (int n = 0; n < 2; ++n) _Pragma("unroll") for (int k = 0; k < 2; ++k) dst[n][k] = *(const PG8_LAS bf16x8*)(lds + PG8_SB(b, h) + boff + n * 2048 + k * 1024); } while (0)
#define PG8_MMA(ai, bj, At, Bt) do { __builtin_amdgcn_s_setprio(1); _Pragma("unroll") for (int m = 0; m < 4; ++m) _Pragma("unroll") for (int n = 0; n < 2; ++n) _Pragma("unroll") for (int k = 0; k < 2; ++k) \
        acc[ai][bj][m][n] = __builtin_amdgcn_mfma_f32_16x16x32_bf16(Bt[n][k], At[m][k], acc[ai][bj][m][n], 0, 0, 0); __builtin_amdgcn_s_setprio(0); } while (0)
#define PG8_WAIT_V(n) asm volatile("s_waitcnt vmcnt(" #n ")" ::: "memory")
#define PG8_WAIT_L(n) asm volatile("s_waitcnt lgkmcnt(" #n ")" ::: "memory")
#define PG8_BAR __builtin_amdgcn_s_barrier()
#define PG8_SCHED __builtin_amdgcn_sched_barrier(0)
    Unit cur, nxt; int ui = 0;
    if (!S.next(0, cur)) return;
    f32x4 acc[2][2][4][2];
#pragma unroll
    for (int a = 0; a < 2; ++a)
#pragma unroll
        for (int b = 0; b < 2; ++b)
#pragma unroll
            for (int m = 0; m < 4; ++m)
#pragma unroll
                for (int n = 0; n < 2; ++n) acc[a][b][m][n] = (f32x4){0.f, 0.f, 0.f, 0.f};
    bf16x8 At[4][2], B0[2][2], B1[2][2];
    const char* cA = (const char*)g.A + (size_t)cur.pm * tstep; const char* cB = (const char*)g.Bt + (size_t)cur.pn * tstep;
    S.a_ready(cur);
    if constexpr (SP2) {
        PG8_STAGE(PG8_SB(0, 0), cB, voffB); PG8_STAGE(PG8_SB(0, 1), cB + hstep, voffB); PG8_STAGE(PG8_SA(0, 0), cA, voffA); PG8_STAGE(PG8_SA(0, 1), cA + hstep, voffA);
        if (wr == 1) PG8_BAR;
        PG8_WAIT_V(2); PG8_BAR;
        PG8_STAGE(PG8_SB(1, 0), cB + kstep, voffB); PG8_STAGE(PG8_SA(1, 0), cA + kstep, voffA); PG8_STAGE(PG8_SB(1, 1), cB + hstep + kstep, voffB);
        PG8_WAIT_V(6); PG8_BAR;
    } else {
        PG8_STAGE(PG8_SB(0, 0), cB, voffB); PG8_STAGE(PG8_SA(0, 0), cA, voffA); PG8_STAGE(PG8_SB(0, 1), cB + hstep, voffB); PG8_STAGE(PG8_SA(0, 1), cA + hstep, voffA);
        if (wr == 1) PG8_BAR;
        PG8_WAIT_V(4); PG8_BAR;
        PG8_STAGE(PG8_SB(1, 0), cB + kstep, voffB); PG8_STAGE(PG8_SA(1, 0), cA + kstep, voffA); PG8_STAGE(PG8_SB(1, 1), cB + hstep + kstep, voffB);
        PG8_WAIT_V(6); PG8_BAR;
    }
    for (;;) {
        const bool has_next = S.next(ui + 1, nxt);
        const char* nA = has_next ? (const char*)g.A + (size_t)nxt.pm * tstep : cA; const char* nB = has_next ? (const char*)g.Bt + (size_t)nxt.pn * tstep : cB;
        for (int t = 0; t < nt; t += 2) {
            const bool last = (t == nt - 2);
            const char* a1 = cA + (size_t)(t + 1) * kstep;
            const char* a2 = last ? nA : cA + (size_t)(t + 2) * kstep; const char* b2 = last ? nB : cB + (size_t)(t + 2) * kstep;
            const char* a3 = a2 + kstep; const char* b3 = b2 + kstep;
            if (last && has_next) S.a_ready(nxt);
            if constexpr (SP2) {
            PG8_LDB(B0, 0, 0); PG8_LDB(B1, 0, 1); PG8_SCHED; PG8_LDA(At, 0, 0); PG8_STAGE(PG8_SA(1, 1), a1 + hstep, voffA);
            PG8_WAIT_V(8); PG8_WAIT_L(0); PG8_BAR; PG8_MMA(0, 0, At, B0); PG8_MMA(0, 1, At, B1); PG8_BAR; PG8_SCHED;
            PG8_LDA(At, 0, 1); PG8_STAGE(PG8_SB(0, 0), b2, voffB); PG8_STAGE(PG8_SB(0, 1), b2 + hstep, voffB); PG8_STAGE(PG8_SA(0, 0), a2, voffA);
            PG8_WAIT_V(8); PG8_WAIT_L(0); PG8_BAR; PG8_MMA(1, 0, At, B0); PG8_MMA(1, 1, At, B1); PG8_BAR; PG8_SCHED;
            PG8_LDB(B0, 1, 0); PG8_LDB(B1, 1, 1); PG8_SCHED; PG8_LDA(At, 1, 0); PG8_STAGE(PG8_SA(0, 1), a2 + hstep, voffA);
            PG8_WAIT_V(8); PG8_WAIT_L(0); PG8_BAR; PG8_MMA(0, 0, At, B0); PG8_MMA(0, 1, At, B1); PG8_BAR; PG8_SCHED;
            PG8_LDA(At, 1, 1); PG8_STAGE(PG8_SB(1, 0), b3, voffB); PG8_STAGE(PG8_SB(1, 1), b3 + hstep, voffB); PG8_STAGE(PG8_SA(1, 0), a3, voffA);
            PG8_WAIT_V(8); PG8_WAIT_L(0); PG8_BAR; PG8_MMA(1, 0, At, B0); PG8_MMA(1, 1, At, B1); PG8_BAR; PG8_SCHED;
            } else {
            PG8_LDB(B0, 0, 0); PG8_SCHED; PG8_LDA(At, 0, 0); PG8_STAGE(PG8_SA(1, 1), a1 + hstep, voffA);
            PG8_WAIT_L(8); PG8_BAR; PG8_WAIT_L(0); PG8_MMA(0, 0, At, B0); PG8_BAR; PG8_SCHED;
            PG8_LDB(B1, 0, 1); PG8_STAGE(PG8_SB(0, 0), b2, voffB);
            PG8_BAR; PG8_WAIT_L(0); PG8_MMA(0, 1, At, B1); PG8_BAR;
            PG8_LDA(At, 0, 1); PG8_STAGE(PG8_SA(0, 0), a2, voffA);
            PG8_BAR; PG8_WAIT_L(0); PG8_MMA(1, 0, At, B0); PG8_BAR; PG8_SCHED;
            PG8_STAGE(PG8_SB(0, 1), b2 + hstep, voffB);
            PG8_WAIT_V(6); PG8_BAR; PG8_MMA(1, 1, At, B1); PG8_BAR;
            PG8_LDB(B0, 1, 0); PG8_SCHED; PG8_LDA(At, 1, 0); PG8_STAGE(PG8_SA(0, 1), a2 + hstep, voffA);
            PG8_WAIT_L(8); PG8_BAR; PG8_WAIT_L(0); PG8_MMA(0, 0, At, B0); PG8_BAR; PG8_SCHED;
            PG8_LDB(B1, 1, 1); PG8_STAGE(PG8_SB(1, 0), b3, voffB);
            PG8_BAR; PG8_WAIT_L(0); PG8_MMA(0, 1, At, B1); PG8_BAR;
            PG8_LDA(At, 1, 1); PG8_STAGE(PG8_SA(1, 0), a3, voffA);
            PG8_BAR; PG8_WAIT_L(0); PG8_MMA(1, 0, At, B0); PG8_BAR; PG8_SCHED;
            PG8_STAGE(PG8_SB(1, 1), b3 + hstep, voffB);
            PG8_WAIT_V(6); PG8_BAR; PG8_MMA(1, 1, At, B1); PG8_BAR;
            }
        }
        if constexpr (ALIGN_EPI) { if (wr == 0) PG8_BAR; }
        if constexpr (!Epi::AFTER_DRAIN) { E(acc, cur, wr, wc, fr, fq); S.done(cur); }
        if (!has_next) break;
#pragma unroll
        for (int a = 0; a < 2; ++a)
#pragma unroll
            for (int b = 0; b < 2; ++b)
#pragma unroll
                for (int m = 0; m < 4; ++m)
#pragma unroll
                    for (int n = 0; n < 2; ++n) acc[a][b][m][n] = (f32x4){0.f, 0.f, 0.f, 0.f};
        cur = nxt; cA = nA; cB = nB; ++ui;
        if constexpr (ALIGN_EPI) { if (wr == 1) PG8_BAR; }
    }
    PG8_WAIT_V(0);
    if constexpr (!ALIGN_EPI) { if (wr == 0) PG8_BAR; }
    PG8_BAR;
    if constexpr (Epi::AFTER_DRAIN) { E.fused(acc, cur, wr, wc, fr, fq, lds, wid, lane); S.done(cur); }
#undef PG8_SA
#undef PG8_SB
#undef PG8_STAGE
#undef PG8_LDA
#undef PG8_LDB
#undef PG8_MMA
#undef PG8_WAIT_V
#undef PG8_WAIT_L
#undef PG8_BAR
#undef PG8_SCHED
}
}
namespace pg8 {
__device__ __forceinline__ float bflo(unsigned w) { return __uint_as_float(w << 16); }
__device__ __forceinline__ float bfhi(unsigned w) { return __uint_as_float(w & 0xffff0000u); }
struct EpiResF32 {
    static constexpr bool PERM = true, AFTER_DRAIN = false;
    float* C; const bf16_t* R; int ldc; float alpha;
    __device__ __forceinline__ void operator()(const f32x4 (&acc)[2][2][4][2], const Unit& u, int wr, int wc, int fr, int fq) const {
        const int row0 = u.pm * BM + wr * 64 + fr, col0 = u.pn * BM + wc * 32 + 8 * fq;
        u32x4 r[2][4][2];
#pragma unroll
        for (int ai = 0; ai < 2; ++ai)
#pragma unroll
            for (int m = 0; m < 4; ++m)
#pragma unroll
                for (int bj = 0; bj < 2; ++bj) r[ai][m][bj] = *(const u32x4*)(R + (size_t)(row0 + ai * HALF + m * 16) * ldc + col0 + bj * HALF);
#pragma unroll
        for (int ai = 0; ai < 2; ++ai)
#pragma unroll
            for (int m = 0; m < 4; ++m) { const size_t off = (size_t)(row0 + ai * HALF + m * 16) * ldc + col0;
#pragma unroll
                for (int bj = 0; bj < 2; ++bj) { const u32x4 rr = r[ai][m][bj];
                    f32x4 v0 = acc[ai][bj][m][0], v1 = acc[ai][bj][m][1];
                    v0[0] += alpha * bflo(rr.x); v0[1] += alpha * bfhi(rr.x); v0[2] += alpha * bflo(rr.y); v0[3] += alpha * bfhi(rr.y);
                    v1[0] += alpha * bflo(rr.z); v1[1] += alpha * bfhi(rr.z); v1[2] += alpha * bflo(rr.w); v1[3] += alpha * bfhi(rr.w);
                    *(f32x4*)(C + off + bj * HALF) = v0; *(f32x4*)(C + off + bj * HALF + 4) = v1; } }
    }
};
struct EpiResBf16 {
    static constexpr bool PERM = true, AFTER_DRAIN = false;
    bf16_t* C; const bf16_t* R; int ldc; float alpha;
    __device__ __forceinline__ void operator()(const f32x4 (&acc)[2][2][4][2], const Unit& u, int wr, int wc, int fr, int fq) const {
        const int row0 = u.pm * BM + wr * 64 + fr, col0 = u.pn * BM + wc * 32 + 8 * fq;
        u32x4 r[2][4][2];
#pragma unroll
        for (int ai = 0; ai < 2; ++ai)
#pragma unroll
            for (int m = 0; m < 4; ++m)
#pragma unroll
                for (int bj = 0; bj < 2; ++bj) r[ai][m][bj] = *(const u32x4*)(R + (size_t)(row0 + ai * HALF + m * 16) * ldc + col0 + bj * HALF);
#pragma unroll
        for (int ai = 0; ai < 2; ++ai)
#pragma unroll
            for (int m = 0; m < 4; ++m) { const size_t off = (size_t)(row0 + ai * HALF + m * 16) * ldc + col0;
#pragma unroll
                for (int bj = 0; bj < 2; ++bj) { const u32x4 rr = r[ai][m][bj];
                    const f32x4 v0 = acc[ai][bj][m][0], v1 = acc[ai][bj][m][1];
                    u32x4 w; w.x = cvt_pk_bf16(v0[0] + alpha * bflo(rr.x), v0[1] + alpha * bfhi(rr.x)); w.y = cvt_pk_bf16(v0[2] + alpha * bflo(rr.y), v0[3] + alpha * bfhi(rr.y));
                    w.z = cvt_pk_bf16(v1[0] + alpha * bflo(rr.z), v1[1] + alpha * bfhi(rr.z)); w.w = cvt_pk_bf16(v1[2] + alpha * bflo(rr.w), v1[3] + alpha * bfhi(rr.w));
                    *(u32x4*)(C + off + bj * HALF) = w; } }
    }
};
struct EpiHc {
    static constexpr bool PERM = false, AFTER_DRAIN = false;
    float* C; int ldc;
    __device__ __forceinline__ void operator()(const f32x4 (&acc)[2][2][4][2], const Unit& u, int wr, int wc, int fr, int fq) const {
        const int row0 = u.pm * BM + wr * 64 + fr, col0 = u.pn * BM + wc * 32 + 4 * fq;
        const float dmin = -3.0701134573253946f, dmax = -15.350567286626973f, dstep = (dmax - dmin) / 1023.0f;
#pragma unroll
        for (int bj = 0; bj < 2; ++bj)
#pragma unroll
            for (int n = 0; n < 2; ++n) {
                f32x4 tl;
#pragma unroll
                for (int e = 0; e < 4; ++e) { const int g = col0 + bj * HALF + n * 16 + e; const bool lp = g < 8192; const int t = lp ? g : g - 8192;
                    tl[e] = -1.4426950408889634f * (float)t * (lp ? (1.0f / 8191.0f) : (1.0f / 4095.0f)); }
#pragma unroll
                for (int ai = 0; ai < 2; ++ai)
#pragma unroll
                    for (int m = 0; m < 4; ++m) { const int j = row0 + ai * HALF + m * 16; const float delta = __builtin_fabsf(dmin + (float)(j & 1023) * dstep);
                        f32x4 o;
#pragma unroll
                        for (int e = 0; e < 4; ++e) o[e] = acc[ai][bj][m][n][e] * __builtin_amdgcn_exp2f(tl[e] * delta);
                        *(f32x4*)(C + (size_t)j * ldc + col0 + bj * HALF + n * 16) = o; }
            }
    }
};
struct EpiSwiGLU {
    static constexpr bool PERM = true, AFTER_DRAIN = false;
    bf16_t* O; int ldc;
    __device__ __forceinline__ static float silu_mul(float g, float u) { return g * u * __builtin_amdgcn_rcpf(1.0f + __builtin_amdgcn_exp2f(-1.4426950408889634f * g)); }
    __device__ __forceinline__ void operator()(const f32x4 (&acc)[2][2][4][2], const Unit& u, int wr, int wc, int fr, int fq) const {
        const int row0 = u.pm * BM + wr * 64 + fr, col0 = u.pn * HALF + wc * 32 + 8 * fq;
#pragma unroll
        for (int ai = 0; ai < 2; ++ai)
#pragma unroll
            for (int m = 0; m < 4; ++m) { bf16_t* rowp = O + (size_t)(row0 + ai * HALF + m * 16) * ldc + col0;
                const f32x4 g0 = acc[ai][0][m][0], g1 = acc[ai][0][m][1], u0 = acc[ai][1][m][0], u1 = acc[ai][1][m][1];
                u32x4 w; w.x = cvt_pk_bf16(silu_mul(g0[0], u0[0]), silu_mul(g0[1], u0[1])); w.y = cvt_pk_bf16(silu_mul(g0[2], u0[2]), silu_mul(g0[3], u0[3]));
                w.z = cvt_pk_bf16(silu_mul(g1[0], u1[0]), silu_mul(g1[1], u1[1])); w.w = cvt_pk_bf16(silu_mul(g1[2], u1[2]), silu_mul(g1[3], u1[3]));
                __builtin_nontemporal_store(w, (u32x4*)rowp); }
    }
};
}
#define XB_TMO      128
#define XB_XCNT(j)  (256  + 64 * (j))
#define XB_XSUB(j)  (1280 + 64 * (j))
#define XB_XGEN(j)  (2304 + 64 * (j))
#define XB_TOP      3328
#define XB_TOPGEN   3392
#define XCD_BAR_WORDS 3456
#define XB_SPIN_CAP (1u << 18)
#define LAS __attribute__((address_space(3)))

__device__ __forceinline__ unsigned xb_ld(unsigned* p)              { return __hip_atomic_load(p, __ATOMIC_RELAXED, __HIP_MEMORY_SCOPE_AGENT); }
__device__ __forceinline__ unsigned xb_add(unsigned* p, unsigned v) { return __hip_atomic_fetch_add(p, v, __ATOMIC_RELAXED, __HIP_MEMORY_SCOPE_AGENT); }
__device__ __forceinline__ unsigned xb_xcc_id() { return (unsigned)__builtin_amdgcn_s_getreg((3 << 11) | 20) & 0xFu; }
#define XB_SPIN(cond, bar) do { unsigned _sp = 0; while (cond) { __builtin_amdgcn_s_sleep(1); \
    if ((++_sp & 255u) == 0u) { if (xb_ld(&(bar)[XB_TMO])) break; if (_sp > XB_SPIN_CAP) { atomicAdd(&(bar)[XB_TMO], 1u); break; } } } } while (0)

struct XcdBarrier {
    unsigned* bar; unsigned x;
    volatile LAS unsigned* st;
};

__device__ __forceinline__ XcdBarrier xcd_barrier_post(unsigned* bar, volatile LAS unsigned* st) {
    XcdBarrier b; b.bar = bar; b.x = xb_xcc_id(); b.st = st;
    if (threadIdx.x == 0) (void)xb_add(&bar[XB_XCNT(b.x)], 1u);
    return b;
}
__device__ __forceinline__ void xcd_barrier_complete(unsigned* bar, unsigned x, unsigned& nloc, unsigned& nx) {
    const unsigned G = gridDim.x * gridDim.y * gridDim.z;
    unsigned sum, cnt, mine, sp = 0u;
    for (;;) {
        sum = 0u; cnt = 0u; mine = 0u;
#pragma unroll
        for (unsigned j = 0; j < 16; ++j) { const unsigned c = xb_ld(&bar[XB_XCNT(j)]); sum += c; cnt += (c > 0u) ? 1u : 0u; mine = (j == x) ? c : mine; }
        if (sum == G) break;
        __builtin_amdgcn_s_sleep(1);
        if ((++sp & 255u) == 0u) { if (xb_ld(&bar[XB_TMO])) break; if (sp > XB_SPIN_CAP) { atomicAdd(&bar[XB_TMO], 1u); break; } }
    }
    nloc = mine > 0u ? mine : 1u; nx = cnt > 0u ? cnt : 1u;
}

__device__ __forceinline__ void xcd_barrier(const XcdBarrier& b) {
    asm volatile("s_waitcnt vmcnt(0)" ::: "memory");
    __syncthreads();
    if (threadIdx.x == 0) {
        unsigned* bar = b.bar;
        __builtin_amdgcn_s_waitcnt(0);
        unsigned nloc = b.st[0], nx = b.st[1];
        if (nloc == 0u) { xcd_barrier_complete(bar, b.x, nloc, nx); b.st[0] = nloc; b.st[1] = nx; }
        const unsigned old = xb_add(&bar[XB_XSUB(b.x)], 1u);
        const unsigned gen = old / nloc;
        if (old + 1u == (gen + 1u) * nloc) {
            __builtin_amdgcn_fence(__ATOMIC_RELEASE, "agent");
            asm volatile("s_waitcnt vmcnt(0)" ::: "memory");
            const unsigned og = xb_add(&bar[XB_TOP], 1u);
            const unsigned tg = og / nx;
            if (og + 1u == (tg + 1u) * nx) xb_add(&bar[XB_TOPGEN], 1u);
            else XB_SPIN(xb_ld(&bar[XB_TOPGEN]) == tg, bar);
            __builtin_amdgcn_fence(__ATOMIC_ACQUIRE, "agent");
            xb_add(&bar[XB_XGEN(b.x)], 1u);
            asm volatile("s_waitcnt vmcnt(0)" ::: "memory");
        } else {
            XB_SPIN(xb_ld(&bar[XB_XGEN(b.x)]) == gen, bar);
            __builtin_amdgcn_fence(__ATOMIC_ACQUIRE, "agent");
            asm volatile("s_waitcnt vmcnt(0)" ::: "memory");
        }
    }
    __syncthreads();
}

#ifndef HOST_TEST
#define FHD __device__ __forceinline__
#define SIN2PI(x) __builtin_amdgcn_sinf(x)
#define COS2PI(x) __builtin_amdgcn_cosf(x)
#define LP LAS
#else
#define FHD inline
#define SIN2PI(x) ((float)sin(6.283185307179586 * (double)(x)))
#define COS2PI(x) ((float)cos(6.283185307179586 * (double)(x)))
#define LP
#endif
typedef float cf __attribute__((ext_vector_type(2)));
FHD cf cmk(float a, float b) { cf r = {a, b}; return r; }
FHD cf cadd(cf a, cf b) { return cmk(a.x + b.x, a.y + b.y); }
FHD cf csub(cf a, cf b) { return cmk(a.x - b.x, a.y - b.y); }
#ifndef HOST_TEST
FHD cf cmul(cf a, cf b) {
    cf t, r;
    asm("v_pk_mul_f32 %0, %1, %2 op_sel:[0,0] op_sel_hi:[0,1]" : "=v"(t) : "v"(a), "v"(b));
    asm("v_pk_fma_f32 %0, %1, %2, %3 op_sel:[1,1,0] op_sel_hi:[1,0,1] neg_lo:[1,0,0]" : "=v"(r) : "v"(a), "v"(b), "v"(t));
    return r;
}
#else
FHD cf cmul(cf a, cf b) { return cmk(a.x * b.x - a.y * b.y, a.x * b.y + a.y * b.x); }
#endif
FHD int PADI(int a) { return a + (a >> 4); }
constexpr int FFT_BUF_CF = 16384 + 1024;

template <bool INV> FHD void dft2(cf& a, cf& b) { const cf s = cadd(a, b), d = csub(a, b); a = s; b = d; }
template <bool INV> FHD void dft4(cf& a, cf& b, cf& c, cf& d) {
    const cf s0 = cadd(a, c), s1 = csub(a, c), s2 = cadd(b, d), s3 = csub(b, d);
    a = cadd(s0, s2); c = csub(s0, s2);
    if (!INV) { b = cmk(s1.x + s3.y, s1.y - s3.x); d = cmk(s1.x - s3.y, s1.y + s3.x); }
    else      { b = cmk(s1.x - s3.y, s1.y + s3.x); d = cmk(s1.x + s3.y, s1.y - s3.x); }
}
#define DR16(r) (4 * ((r) & 3) + ((r) >> 2))
template <bool INV> FHD void dft16(cf (&x)[16]) {
    constexpr float C1 = 0.92387953251128674f, S1 = 0.38268343236508977f, H = 0.70710678118654752f;
#pragma unroll
    for (int k0 = 0; k0 < 4; ++k0) dft4<INV>(x[k0], x[4 + k0], x[8 + k0], x[12 + k0]);
    const float sg = INV ? 1.f : -1.f;
    const cf w1 = cmk(C1, sg * S1), w2 = cmk(H, sg * H), w3 = cmk(S1, sg * C1), w4 = cmk(0.f, sg * 1.f), w6 = cmk(-H, sg * H), w9 = cmk(-C1, -sg * S1);
    x[4 * 1 + 1] = cmul(x[4 * 1 + 1], w1); x[4 * 1 + 2] = cmul(x[4 * 1 + 2], w2); x[4 * 1 + 3] = cmul(x[4 * 1 + 3], w3);
    x[4 * 2 + 1] = cmul(x[4 * 2 + 1], w2); x[4 * 2 + 2] = cmul(x[4 * 2 + 2], w4); x[4 * 2 + 3] = cmul(x[4 * 2 + 3], w6);
    x[4 * 3 + 1] = cmul(x[4 * 3 + 1], w3); x[4 * 3 + 2] = cmul(x[4 * 3 + 2], w6); x[4 * 3 + 3] = cmul(x[4 * 3 + 3], w9);
#pragma unroll
    for (int r0 = 0; r0 < 4; ++r0) dft4<INV>(x[4 * r0], x[4 * r0 + 1], x[4 * r0 + 2], x[4 * r0 + 3]);
}
template <bool INV> FHD void twid16(cf (&w)[16], float frac) {
    float c = COS2PI(frac), s = SIN2PI(frac);
#ifndef HOST_TEST
    asm volatile("s_nop 1" : "+v"(c), "+v"(s));
#endif
    w[1] = cmk(c, INV ? s : -s);
    w[2] = cmul(w[1], w[1]); w[3] = cmul(w[2], w[1]); w[4] = cmul(w[2], w[2]); w[5] = cmul(w[4], w[1]); w[6] = cmul(w[3], w[3]); w[7] = cmul(w[4], w[3]);
    w[8] = cmul(w[4], w[4]); w[9] = cmul(w[8], w[1]); w[10] = cmul(w[5], w[5]); w[11] = cmul(w[8], w[3]); w[12] = cmul(w[6], w[6]); w[13] = cmul(w[8], w[5]);
    w[14] = cmul(w[7], w[7]); w[15] = cmul(w[8], w[7]);
}
#define STG_OFF(k, lgst) (((k) << (lgst)) + ((((k) << (lgst))) >> 4))
template <bool INV, bool NOTW, int LGS> FHD void fft_stage16(LP cf* buf, int id) {
    constexpr int lgst = LGS - 4, st = 1 << lgst; const int blk = id >> lgst, j = id & (st - 1), base = (blk << LGS) + j;
    LP cf* pb = buf + PADI(base);
    cf x[16];
#pragma unroll
    for (int k = 0; k < 16; ++k) x[k] = pb[STG_OFF(k, lgst)];
    if (!INV) {
        dft16<false>(x);
        if (!NOTW) { cf w[16]; twid16<false>(w, (float)j * (1.0f / (float)(1 << LGS)));
#pragma unroll
            for (int r = 1; r < 16; ++r) x[DR16(r)] = cmul(x[DR16(r)], w[r]); }
#pragma unroll
        for (int r = 0; r < 16; ++r) pb[STG_OFF(r, lgst)] = x[DR16(r)];
    } else {
        if (!NOTW) { cf w[16]; twid16<true>(w, (float)j * (1.0f / (float)(1 << LGS)));
#pragma unroll
            for (int r = 1; r < 16; ++r) x[r] = cmul(x[r], w[r]); }
        dft16<true>(x);
#pragma unroll
        for (int r = 0; r < 16; ++r) pb[STG_OFF(r, lgst)] = x[DR16(r)];
    }
}
template <bool INV, int LGS> FHD void fft_stage16_dual(LP cf* bufA, LP cf* bufB, int id) {
    constexpr int lgst = LGS - 4, st = 1 << lgst; const int blk = id >> lgst, j = id & (st - 1), base = (blk << LGS) + j, po = PADI(base);
    LP cf* pa = bufA + po; LP cf* pb = bufB + po;
    cf x[16], y[16];
#pragma unroll
    for (int k = 0; k < 16; ++k) { x[k] = pa[STG_OFF(k, lgst)]; y[k] = pb[STG_OFF(k, lgst)]; }
    cf w[16]; twid16<INV>(w, (float)j * (1.0f / (float)(1 << LGS)));
    if (!INV) {
        dft16<false>(x); dft16<false>(y);
#pragma unroll
        for (int r = 1; r < 16; ++r) { x[DR16(r)] = cmul(x[DR16(r)], w[r]); y[DR16(r)] = cmul(y[DR16(r)], w[r]); }
    } else {
#pragma unroll
        for (int r = 1; r < 16; ++r) { x[r] = cmul(x[r], w[r]); y[r] = cmul(y[r], w[r]); }
        dft16<true>(x); dft16<true>(y);
    }
#pragma unroll
    for (int r = 0; r < 16; ++r) { pa[STG_OFF(r, lgst)] = x[DR16(r)]; pb[STG_OFF(r, lgst)] = y[DR16(r)]; }
}
template <int RL> FHD void fft_mid(LP cf* buf, const cf* K, int id) {
    LP cf* pb = buf + PADI(RL * id);
    cf x[RL];
#pragma unroll
    for (int k = 0; k < RL; ++k) x[k] = pb[k];
    cf kk[RL];
#pragma unroll
    for (int k = 0; k < RL; ++k) kk[k] = K[RL * id + k];
    if constexpr (RL == 4) { dft4<false>(x[0], x[1], x[2], x[3]); } else { dft2<false>(x[0], x[1]); }
#pragma unroll
    for (int k = 0; k < RL; ++k) x[k] = cmul(x[k], kk[k]);
    if constexpr (RL == 4) { dft4<true>(x[0], x[1], x[2], x[3]); } else { dft2<true>(x[0], x[1]); }
#pragma unroll
    for (int k = 0; k < RL; ++k) pb[k] = x[k];
}
template <int RL> FHD void fft_mid_pre(LP cf* buf, const cf (&kk)[RL], int id) {
    LP cf* pb = buf + PADI(RL * id);
    cf x[RL];
#pragma unroll
    for (int k = 0; k < RL; ++k) x[k] = pb[k];
    if constexpr (RL == 4) { dft4<false>(x[0], x[1], x[2], x[3]); } else { dft2<false>(x[0], x[1]); }
#pragma unroll
    for (int k = 0; k < RL; ++k) x[k] = cmul(x[k], kk[k]);
    if constexpr (RL == 4) { dft4<true>(x[0], x[1], x[2], x[3]); } else { dft2<true>(x[0], x[1]); }
#pragma unroll
    for (int k = 0; k < RL; ++k) pb[k] = x[k];
}
FHD int pos_to_freq(int p, int lgN) {
    const int lgRL = lgN - 12;
    const int r1 = p >> (lgN - 4), r2 = (p >> (lgN - 8)) & 15, r3 = (p >> lgRL) & 15, r4 = p & ((1 << lgRL) - 1);
    return r1 + 16 * r2 + 256 * r3 + 4096 * r4;
}
FHD int freq_to_pos(int k, int lgN) {
    const int lgRL = lgN - 12;
    const int r1 = k & 15, r2 = (k >> 4) & 15, r3 = (k >> 8) & 15, r4 = k >> 12;
    return (r1 << (lgN - 4)) + (r2 << (lgN - 8)) + (r3 << lgRL) + r4;
}
constexpr int NT = 512;
typedef unsigned short bf16raw;
FHD float bf2f(bf16raw b) { unsigned u = ((unsigned)b) << 16; float f; __builtin_memcpy(&f, &u, 4); return f; }
FHD bf16raw f2bf(float f) { unsigned u; __builtin_memcpy(&u, &f, 4); u += 0x7fffu + ((u >> 16) & 1u); return (bf16raw)(u >> 16); }
#ifndef HOST_TEST
typedef float f32x2_t __attribute__((ext_vector_type(2)));
typedef __bf16 bf16x2_t __attribute__((ext_vector_type(2)));
__device__ __forceinline__ unsigned PK2(float lo, float hi) { const f32x2_t v = {lo, hi}; return __builtin_bit_cast(unsigned, __builtin_convertvector(v, bf16x2_t)); }
#else
inline unsigned PK2(float lo, float hi) { return (unsigned)f2bf(lo) | ((unsigned)f2bf(hi) << 16); }
#endif

typedef float f32v8 __attribute__((ext_vector_type(8)));
typedef float f32v16 __attribute__((ext_vector_type(16)));
template <int E> struct VecT;
template <> struct VecT<8> { typedef f32v8 type; };
template <> struct VecT<16> { typedef f32v16 type; };
FHD float bflo_(unsigned w) { unsigned u = w << 16; float f; __builtin_memcpy(&f, &u, 4); return f; }
FHD float bfhi_(unsigned w) { unsigned u = w & 0xffff0000u; float f; __builtin_memcpy(&f, &u, 4); return f; }
struct RawRow { uint4 q0, q1; unsigned um, up; };
template <int E> FHD RawRow raw_load(const bf16raw* row, int L, int t0) {
    static_assert(E == 8 || E == 16, "E");
    RawRow r;
    r.q0 = *(const uint4*)(row + t0);
    if constexpr (E == 16) r.q1 = *(const uint4*)(row + t0 + 8); else r.q1 = r.q0;
    r.um = (t0 > 0) ? ((unsigned)row[t0 - 1] << 16) : 0u;
    r.up = (t0 + E < L) ? ((unsigned)row[t0 + E] << 16) : 0u;
    return r;
}
template <int E> FHD void conv_apply(const RawRow& r, float w0, float w1, float w2, float bias, typename VecT<E>::type& out) {
    float um, up; __builtin_memcpy(&um, &r.um, 4); __builtin_memcpy(&up, &r.up, 4);
    const uint4 q0 = r.q0;
    const float x0 = bflo_(q0.x), x1 = bfhi_(q0.x), x2 = bflo_(q0.y), x3 = bfhi_(q0.y), x4 = bflo_(q0.z), x5 = bfhi_(q0.z), x6 = bflo_(q0.w), x7 = bfhi_(q0.w);
    out[0] = w0 * um + w1 * x0 + w2 * x1 + bias; out[1] = w0 * x0 + w1 * x1 + w2 * x2 + bias; out[2] = w0 * x1 + w1 * x2 + w2 * x3 + bias; out[3] = w0 * x2 + w1 * x3 + w2 * x4 + bias;
    out[4] = w0 * x3 + w1 * x4 + w2 * x5 + bias; out[5] = w0 * x4 + w1 * x5 + w2 * x6 + bias; out[6] = w0 * x5 + w1 * x6 + w2 * x7 + bias;
    if constexpr (E == 8) { out[7] = w0 * x6 + w1 * x7 + w2 * up + bias; }
    else {
        const uint4 q1 = r.q1;
        const float y0 = bflo_(q1.x), y1 = bfhi_(q1.x), y2 = bflo_(q1.y), y3 = bfhi_(q1.y), y4 = bflo_(q1.z), y5 = bfhi_(q1.z), y6 = bflo_(q1.w), y7 = bfhi_(q1.w);
        out[7] = w0 * x6 + w1 * x7 + w2 * y0 + bias;
        out[8] = w0 * x7 + w1 * y0 + w2 * y1 + bias; out[9] = w0 * y0 + w1 * y1 + w2 * y2 + bias; out[10] = w0 * y1 + w1 * y2 + w2 * y3 + bias; out[11] = w0 * y2 + w1 * y3 + w2 * y4 + bias;
        out[12] = w0 * y3 + w1 * y4 + w2 * y5 + bias; out[13] = w0 * y4 + w1 * y5 + w2 * y6 + bias; out[14] = w0 * y5 + w1 * y6 + w2 * y7 + bias; out[15] = w0 * y6 + w1 * y7 + w2 * up + bias;
    }
}
template <int E> FHD void load_conv(const bf16raw* row, int L, int t0, float w0, float w1, float w2, float bias, typename VecT<E>::type& out) {
    const RawRow r = raw_load<E>(row, L, t0); conv_apply<E>(r, w0, w1, w2, bias, out);
}
template <int E> FHD void store_bf16_run(bf16raw* dst, const typename VecT<E>::type& v) {
#pragma unroll
    for (int q = 0; q < E / 8; ++q) {
        uint4 o;
        o.x = PK2(v[8 * q + 0], v[8 * q + 1]); o.y = PK2(v[8 * q + 2], v[8 * q + 3]);
        o.z = PK2(v[8 * q + 4], v[8 * q + 5]); o.w = PK2(v[8 * q + 6], v[8 * q + 7]);
        *(uint4*)(dst + 8 * q) = o;
    }
}
#ifndef HOST_TEST
#define UNIT_SYNC() __syncthreads()
#define TID_LOOP
#define TID_DECL const int tid = threadIdx.x
#else
#define UNIT_SYNC()
#endif

template <int E> struct HyState { typename VecT<E>::type a, b; };

struct HyArgs {
    const bf16raw* rowX1A; const bf16raw* rowX2A; const bf16raw* rowVA;
    bf16raw* outA;
    const unsigned* K1; const unsigned* K2;
    float sw[3][3]; float sb[3];
    float skip0, skip1;
};
template <int LOGL> FHD void hy_sec_load_v(LP cf* buf, const HyArgs& A, int tid, HyState<(1 << LOGL) / NT>& st) {
    constexpr int L = 1 << LOGL, E = L / NT; const int t0 = tid * E;
    load_conv<E>(A.rowVA, L, t0, A.sw[2][0], A.sw[2][1], A.sw[2][2], A.sb[2], st.a);
    load_conv<E>(A.rowVA + L, L, t0, A.sw[2][0], A.sw[2][1], A.sw[2][2], A.sb[2], st.b);
    LP cf* pb = buf + PADI(t0);
#pragma unroll
    for (int e = 0; e < E; ++e) { pb[e] = cmk(st.a[e], st.b[e]); pb[PADI(L) + e] = cmk(0.f, 0.f); }
}
struct HyRaw { RawRow x1a, x1b, x2a, x2b; };
template <int LOGL> FHD void hy_raw_load(const HyArgs& A, int tid, HyRaw& R) {
    constexpr int L = 1 << LOGL, E = L / NT; const int t0 = tid * E;
    R.x1a = raw_load<E>(A.rowX1A, L, t0); R.x1b = raw_load<E>(A.rowX1A + L, L, t0); R.x2a = raw_load<E>(A.rowX2A, L, t0); R.x2b = raw_load<E>(A.rowX2A + L, L, t0);
}
template <int LOGL> FHD void hy_sec_gate1_pre(LP cf* buf, const HyArgs& A, int tid, HyState<(1 << LOGL) / NT>& st, const HyRaw& R) {
    constexpr int L = 1 << LOGL, E = L / NT; const int t0 = tid * E;
    typename VecT<E>::type xa, xb;
    conv_apply<E>(R.x1a, A.sw[0][0], A.sw[0][1], A.sw[0][2], A.sb[0], xa); conv_apply<E>(R.x1b, A.sw[0][0], A.sw[0][1], A.sw[0][2], A.sb[0], xb);
    LP cf* pb = buf + PADI(t0);
#pragma unroll
    for (int e = 0; e < E; ++e) { const cf y = pb[e];
        st.a[e] = xa[e] * (y.x + st.a[e] * A.skip0); st.b[e] = xb[e] * (y.y + st.b[e] * A.skip0);
        pb[e] = cmk(st.a[e], st.b[e]); pb[PADI(L) + e] = cmk(0.f, 0.f); }
}
template <int LOGL> FHD void hy_sec_gate2_pre(LP cf* buf, const HyArgs& A, int tid, HyState<(1 << LOGL) / NT>& st, const HyRaw& R) {
    constexpr int L = 1 << LOGL, E = L / NT; const int t0 = tid * E;
    typename VecT<E>::type xa, xb;
    conv_apply<E>(R.x2a, A.sw[1][0], A.sw[1][1], A.sw[1][2], A.sb[1], xa); conv_apply<E>(R.x2b, A.sw[1][0], A.sw[1][1], A.sw[1][2], A.sb[1], xb);
    LP cf* pb = buf + PADI(t0);
#pragma unroll
    for (int e = 0; e < E; ++e) { const cf y = pb[e];
        xa[e] = xa[e] * (y.x + st.a[e] * A.skip1); xb[e] = xb[e] * (y.y + st.b[e] * A.skip1); }
    store_bf16_run<E>(A.outA + t0, xa); store_bf16_run<E>(A.outA + L + t0, xb);
}
template <int LOGL> FHD void hy_sec_gate1(LP cf* buf, const HyArgs& A, int tid, HyState<(1 << LOGL) / NT>& st) {
    constexpr int L = 1 << LOGL, E = L / NT; const int t0 = tid * E;
    typename VecT<E>::type xa, xb;
    load_conv<E>(A.rowX1A, L, t0, A.sw[0][0], A.sw[0][1], A.sw[0][2], A.sb[0], xa);
    load_conv<E>(A.rowX1A + L, L, t0, A.sw[0][0], A.sw[0][1], A.sw[0][2], A.sb[0], xb);
    LP cf* pb = buf + PADI(t0);
#pragma unroll
    for (int e = 0; e < E; ++e) { const cf y = pb[e];
        st.a[e] = xa[e] * (y.x + st.a[e] * A.skip0); st.b[e] = xb[e] * (y.y + st.b[e] * A.skip0);
        pb[e] = cmk(st.a[e], st.b[e]); pb[PADI(L) + e] = cmk(0.f, 0.f); }
}
template <int LOGL> FHD void hy_sec_gate2(LP cf* buf, const HyArgs& A, int tid, HyState<(1 << LOGL) / NT>& st) {
    constexpr int L = 1 << LOGL, E = L / NT; const int t0 = tid * E;
    typename VecT<E>::type xa, xb;
    load_conv<E>(A.rowX2A, L, t0, A.sw[1][0], A.sw[1][1], A.sw[1][2], A.sb[1], xa);
    load_conv<E>(A.rowX2A + L, L, t0, A.sw[1][0], A.sw[1][1], A.sw[1][2], A.sb[1], xb);
    LP cf* pb = buf + PADI(t0);
#pragma unroll
    for (int e = 0; e < E; ++e) { const cf y = pb[e];
        xa[e] = xa[e] * (y.x + st.a[e] * A.skip1); xb[e] = xb[e] * (y.y + st.b[e] * A.skip1); }
    store_bf16_run<E>(A.outA + t0, xa); store_bf16_run<E>(A.outA + L + t0, xb);
}

template <int LOGL> FHD void kf_sec_load(LP cf* buf, const float* hf, const float* hb, int tid) {
    constexpr int L = 1 << LOGL;
    LP cf* pb = buf + PADI(tid);
#pragma unroll
    for (int i = 0; i < L / NT; ++i) { const int n = tid + NT * i;
        pb[544 * i] = cmk(hf[n], 0.f);
        pb[PADI(L) + 544 * i] = cmk(n == 0 ? 0.f : hb[L - n], 0.f);
    }
}
template <int LOGN> FHD void kf_sec_tail(LP cf* buf, unsigned* K, int id) {
    constexpr int RL = 1 << (LOGN - 12); constexpr float sc = 1.0f / (float)(1 << LOGN);
    cf x[RL];
#pragma unroll
    for (int k = 0; k < RL; ++k) x[k] = buf[PADI(RL * id) + k];
    if constexpr (RL == 4) { dft4<false>(x[0], x[1], x[2], x[3]); } else { dft2<false>(x[0], x[1]); }
#pragma unroll
    for (int k = 0; k < RL; ++k) K[RL * id + k] = PK2(x[k].x * sc, x[k].y * sc);
}

template <int LOGL> FHD void kf2_sec_load(LP cf* buf, const float* hf0, const float* hb0, const float* hf1, const float* hb1, int tid) {
    constexpr int L = 1 << LOGL;
    LP cf* pb = buf + PADI(tid);
#pragma unroll
    for (int i = 0; i < L / NT; ++i) { const int n = tid + NT * i;
        pb[544 * i] = cmk(hf0[n], hf1[n]);
        pb[PADI(L) + 544 * i] = n == 0 ? cmk(0.f, 0.f) : cmk(hb0[L - n], hb1[L - n]);
    }
}
template <int LOGN> FHD void kf2_sec_tail(LP cf* buf, int id) {
    constexpr int RL = 1 << (LOGN - 12);
    LP cf* pb = buf + PADI(RL * id);
    cf x[RL];
#pragma unroll
    for (int k = 0; k < RL; ++k) x[k] = pb[k];
    if constexpr (RL == 4) { dft4<false>(x[0], x[1], x[2], x[3]); } else { dft2<false>(x[0], x[1]); }
#pragma unroll
    for (int k = 0; k < RL; ++k) pb[k] = x[k];
}
template <int LOGN> FHD void kf2_sec_split(LP const cf* buf, unsigned* K0, unsigned* K1, int p) {
    constexpr int N = 1 << LOGN; constexpr float sc = 0.5f / (float)N;
    const int f = pos_to_freq(p, LOGN), pp = freq_to_pos((N - f) & (N - 1), LOGN);
    const cf Z = buf[PADI(p)], W = buf[PADI(pp)];
    K0[p] = PK2((Z.x + W.x) * sc, (Z.y - W.y) * sc);
    K1[p] = PK2((Z.y + W.y) * sc, (W.x - Z.x) * sc);
}

template <int LOGN> FHD int PADF(int k) { return LOGN == 13 ? (k + (k >> 8)) : (k + 4 * (k >> 6)); }
template <int LOGN> FHD void fn_sec_load(LP cf* buf, const bf16raw* rowC, const bf16raw* rowS, int tid) {
    constexpr int N = 1 << LOGN, E = N / NT; const int t0 = tid * E;
    LP cf* pb = buf + PADI(t0);
#pragma unroll
    for (int v = 0; v < E / 8; ++v) {
        const uint4 qc = *(const uint4*)(rowC + t0 + 8 * v), qs = *(const uint4*)(rowS + t0 + 8 * v);
        pb[8 * v + 0] = cmk(bflo_(qc.x), bflo_(qs.x)); pb[8 * v + 1] = cmk(bfhi_(qc.x), bfhi_(qs.x));
        pb[8 * v + 2] = cmk(bflo_(qc.y), bflo_(qs.y)); pb[8 * v + 3] = cmk(bfhi_(qc.y), bfhi_(qs.y));
        pb[8 * v + 4] = cmk(bflo_(qc.z), bflo_(qs.z)); pb[8 * v + 5] = cmk(bfhi_(qc.z), bfhi_(qs.z));
        pb[8 * v + 6] = cmk(bflo_(qc.w), bflo_(qs.w)); pb[8 * v + 7] = cmk(bfhi_(qc.w), bfhi_(qs.w));
    }
}
struct FnRaw { uint4 c0, c1, s0, s1; };
template <int LOGN> FHD FnRaw fn_raw_load(const bf16raw* rowC, const bf16raw* rowS, int tid) {
    constexpr int E = (1 << LOGN) / NT; const int t0 = tid * E; FnRaw r;
    r.c0 = *(const uint4*)(rowC + t0); r.s0 = *(const uint4*)(rowS + t0);
    if constexpr (E == 16) { r.c1 = *(const uint4*)(rowC + t0 + 8); r.s1 = *(const uint4*)(rowS + t0 + 8); } else { r.c1 = r.c0; r.s1 = r.s0; }
    return r;
}
template <int LOGN> FHD void fn_sec_put(LP cf* buf, const FnRaw& r, int tid, float sg = 1.f) {
    constexpr int E = (1 << LOGN) / NT; LP cf* pb = buf + PADI(tid * E);
    pb[0] = cmk(bflo_(r.c0.x), sg * bflo_(r.s0.x)); pb[1] = cmk(bfhi_(r.c0.x), sg * bfhi_(r.s0.x)); pb[2] = cmk(bflo_(r.c0.y), sg * bflo_(r.s0.y)); pb[3] = cmk(bfhi_(r.c0.y), sg * bfhi_(r.s0.y));
    pb[4] = cmk(bflo_(r.c0.z), sg * bflo_(r.s0.z)); pb[5] = cmk(bfhi_(r.c0.z), sg * bfhi_(r.s0.z)); pb[6] = cmk(bflo_(r.c0.w), sg * bflo_(r.s0.w)); pb[7] = cmk(bfhi_(r.c0.w), sg * bfhi_(r.s0.w));
    if constexpr (E == 16) {
        pb[8] = cmk(bflo_(r.c1.x), sg * bflo_(r.s1.x)); pb[9] = cmk(bfhi_(r.c1.x), sg * bfhi_(r.s1.x)); pb[10] = cmk(bflo_(r.c1.y), sg * bflo_(r.s1.y)); pb[11] = cmk(bfhi_(r.c1.y), sg * bfhi_(r.s1.y));
        pb[12] = cmk(bflo_(r.c1.z), sg * bflo_(r.s1.z)); pb[13] = cmk(bfhi_(r.c1.z), sg * bfhi_(r.s1.z)); pb[14] = cmk(bflo_(r.c1.w), sg * bflo_(r.s1.w)); pb[15] = cmk(bfhi_(r.c1.w), sg * bfhi_(r.s1.w));
    }
}
template <int LOGN> FHD void fn_sec_tail_read(LP cf* buf, int id, float (&re)[16]) {
    if (LOGN == 13) {
        cf a = buf[PADI(2 * id)], b = buf[PADI(2 * id) + 1]; dft2<false>(a, b); re[0] = a.x; re[1] = b.x;
    } else {
        cf x[16];
#pragma unroll
        for (int k = 0; k < 16; ++k) x[k] = buf[PADI(16 * id) + k];
        dft16<false>(x);
#pragma unroll
        for (int r = 0; r < 16; ++r) re[r] = x[DR16(r)].x;
    }
}
template <int LOGN> FHD void fn_sec_tail_write(LP float* fbuf, int id, const float (&re)[16]) {
    if (LOGN == 13) { fbuf[PADF<LOGN>(pos_to_freq(2 * id, LOGN))] = re[0]; fbuf[PADF<LOGN>(pos_to_freq(2 * id + 1, LOGN))] = re[1]; }
    else {
#pragma unroll
        for (int r = 0; r < 16; ++r) fbuf[PADF<LOGN>(pos_to_freq(16 * id + r, LOGN))] = re[r];
    }
}
template <int LOGN> FHD void fn_sec_store(LP const float* fbuf, bf16raw* out, float scale, int tid, bf16raw* out2 = nullptr) {
    constexpr int N = 1 << LOGN;
    for (int k = tid; k < N; k += NT) out[k] = f2bf(fbuf[PADF<LOGN>(k)] * scale);
    if (out2) for (int k = tid; k < N; k += NT) out2[k] = f2bf(fbuf[PADF<LOGN>((N - k) & (N - 1))] * scale);
}

#ifndef HOST_TEST
#define LAUNDER_TID(t) int t = threadIdx.x; asm volatile("" : "+v"(t))
template <int LOGN, bool INV, int LGS> __device__ __forceinline__ void dev_stage(LAS cf* buf) {
    LAUNDER_TID(tid);
#pragma unroll
    for (int i = 0; i < (1 << (LOGN - 4)) / NT; ++i) fft_stage16<INV, false, LGS>(buf, tid + NT * i);
    if constexpr ((1 << (LOGN - 4)) < NT) { if (tid < (1 << (LOGN - 4))) fft_stage16<INV, false, LGS>(buf, tid); }
    __syncthreads();
}
template <int LOGN, bool INV> __device__ __forceinline__ void dev_stages16(LAS cf* buf) {
    if constexpr (!INV) { dev_stage<LOGN, false, LOGN>(buf); dev_stage<LOGN, false, LOGN - 4>(buf); if constexpr (LOGN - 8 > 4) dev_stage<LOGN, false, LOGN - 8>(buf); }
    else { if constexpr (LOGN - 8 > 4) dev_stage<LOGN, true, LOGN - 8>(buf); dev_stage<LOGN, true, LOGN - 4>(buf); dev_stage<LOGN, true, LOGN>(buf); }
}
template <int LOGN> __device__ __forceinline__ void dev_fftconv(LAS cf* buf, const unsigned* K) {
    constexpr int RL = 1 << (LOGN - 12), NI = (1 << LOGN) / RL / NT;
    unsigned kp[NI][RL];
    { const int tid0 = threadIdx.x;
#pragma unroll
      for (int i = 0; i < NI; ++i) {
          if constexpr (RL == 4) { const uint4 q = *(const uint4*)(K + 4 * (tid0 + NT * i)); kp[i][0] = q.x; kp[i][1] = q.y; kp[i][2] = q.z; kp[i][3] = q.w; }
          else { const uint2 q = *(const uint2*)(K + 2 * (tid0 + NT * i)); kp[i][0] = q.x; kp[i][1] = q.y; } } }
    dev_stages16<LOGN, false>(buf);
    { LAUNDER_TID(tid);
#pragma unroll
      for (int i = 0; i < NI; ++i) { cf kk[RL];
#pragma unroll
          for (int k = 0; k < RL; ++k) kk[k] = cmk(bflo_(kp[i][k]), bfhi_(kp[i][k]));
          fft_mid_pre<RL>(buf, kk, tid + NT * i); } }
    __syncthreads();
    dev_stages16<LOGN, true>(buf);
}
template <int LOGL> __device__ __forceinline__ void dev_hyena_unit(LAS cf* buf, const HyArgs& A) {
    constexpr int L = 1 << LOGL, E = L / NT;
    HyState<E> st; HyRaw R;
    { LAUNDER_TID(tid); const int t0 = tid * E;
      const RawRow va = raw_load<E>(A.rowVA, L, t0), vb = raw_load<E>(A.rowVA + L, L, t0);
      hy_raw_load<LOGL>(A, tid, R);
      conv_apply<E>(va, A.sw[2][0], A.sw[2][1], A.sw[2][2], A.sb[2], st.a); conv_apply<E>(vb, A.sw[2][0], A.sw[2][1], A.sw[2][2], A.sb[2], st.b);
      LAS cf* pb = buf + PADI(t0);
#pragma unroll
      for (int e = 0; e < E; ++e) { pb[e] = cmk(st.a[e], st.b[e]); pb[PADI(L) + e] = cmk(0.f, 0.f); } }
    __syncthreads();
    dev_fftconv<LOGL + 1>(buf, A.K1);
    { LAUNDER_TID(tid); hy_sec_gate1_pre<LOGL>(buf, A, tid, st, R); } __syncthreads();
    dev_fftconv<LOGL + 1>(buf, A.K2);
    { LAUNDER_TID(tid); hy_sec_gate2_pre<LOGL>(buf, A, tid, st, R); } __syncthreads();
}
template <int LOGL> __device__ __forceinline__ void dev_kf_unit(LAS cf* buf, const float* hf, const float* hb, unsigned* K) {
    constexpr int LOGN = LOGL + 1, RL = 1 << (LOGN - 12);
    { LAUNDER_TID(tid); kf_sec_load<LOGL>(buf, hf, hb, tid); } __syncthreads();
    dev_stages16<LOGN, false>(buf);
    { LAUNDER_TID(tid); for (int id = tid; id < (1 << LOGN) / RL; id += NT) kf_sec_tail<LOGN>(buf, K, id); }
    __syncthreads();
}
template <int LOGL> __device__ __forceinline__ void dev_kf2_unit(LAS cf* buf, const float* hf0, const float* hb0, const float* hf1, const float* hb1, unsigned* K0, unsigned* K1) {
    constexpr int LOGN = LOGL + 1, RL = 1 << (LOGN - 12);
    { LAUNDER_TID(tid); kf2_sec_load<LOGL>(buf, hf0, hb0, hf1, hb1, tid); } __syncthreads();
    dev_stages16<LOGN, false>(buf);
    { LAUNDER_TID(tid); for (int id = tid; id < (1 << LOGN) / RL; id += NT) kf2_sec_tail<LOGN>(buf, id); }
    __syncthreads();
    { LAUNDER_TID(tid); for (int p = tid; p < (1 << LOGN); p += NT) kf2_sec_split<LOGN>((LAS const cf*)buf, K0, K1, p); }
    __syncthreads();
}
template <int LOGN> __device__ __forceinline__ void dev_fnet_unit(LAS cf* buf, const bf16raw* rowC, const bf16raw* rowS, float sg, bf16raw* out, bf16raw* out2, float scale) {
    { LAUNDER_TID(tid); const FnRaw raw = fn_raw_load<LOGN>(rowC, rowS, tid); fn_sec_put<LOGN>(buf, raw, tid, sg); } __syncthreads();
    dev_stages16<LOGN, false>(buf);
    LAUNDER_TID(tid);
    if constexpr (LOGN == 13) {
        float re[16];
#pragma unroll
        for (int h = 0; h < 8; ++h) { const int id = tid + NT * h; const cf a = buf[PADI(2 * id)], b = buf[PADI(2 * id) + 1]; re[2 * h] = a.x + b.x; re[2 * h + 1] = a.x - b.x; }
        __syncthreads();
        LAS float* fbuf = (LAS float*)buf;
#pragma unroll
        for (int h = 0; h < 8; ++h) { const int id = tid + NT * h; fbuf[PADF<LOGN>(pos_to_freq(2 * id, LOGN))] = re[2 * h]; fbuf[PADF<LOGN>(pos_to_freq(2 * id + 1, LOGN))] = re[2 * h + 1]; }
    } else {
        float re[16];
        if (tid < 256) fn_sec_tail_read<LOGN>(buf, tid, re);
        __syncthreads();
        if (tid < 256) fn_sec_tail_write<LOGN>((LAS float*)buf, tid, re);
    }
    __syncthreads();
    fn_sec_store<LOGN>((LAS const float*)buf, out, scale, tid, out2); __syncthreads();
}
#endif
constexpr int DM = 4096, NTOK = 32768, TOK_S0 = 16384, LP_ = 8192, LS_ = 4096, DFF = 11008, INW = 7168;
constexpr int LPOS = LP_ + LS_;
constexpr float ALPHA = 1.4142135623730951f;
constexpr float LN_EPS = 1e-5f;
#ifndef GP_SP2
#define GP_SP2 true
#endif
#ifndef GP_ALIGN
#define GP_ALIGN true
#endif
constexpr int NPH = 20;
constexpr size_t MiB = 1u << 20;
constexpr size_t WS_CTL = 0, CTL_ZERO_BYTES = 1 * MiB;
constexpr size_t WS_WIN = 1 * MiB, WS_WFN = 65 * MiB, WS_WOUT = 67 * MiB, WS_WGU = 99 * MiB, WS_WDN = 271 * MiB;
constexpr size_t WS_X = 357 * MiB, WS_UT = 613 * MiB, WS_QK = 965 * MiB, WS_TO = 1125 * MiB, WS_YF = 1253 * MiB, WS_MIX = 1317 * MiB, WS_H3 = 1573 * MiB, WS_END = 1589 * MiB;
constexpr size_t WS_H = WS_UT;
static_assert(WS_H + (size_t)NTOK * DFF * 2 <= WS_MIX, "H overlay");
constexpr size_t WS_W4P = WS_H3 + 12 * MiB;
constexpr size_t WS_HC = WS_MIX;
constexpr size_t OUT_KF0 = 0, OUT_KF1 = 128 * MiB, OUT_HC1 = 256 * MiB;
constexpr int CW_BAR = 4096;
constexpr int LDS_BYTES = 147456, LDS_MISC = 147456 - 256, LDS_AUX = 139264;

typedef short bf16x8 __attribute__((ext_vector_type(8)));
typedef float f32x4 __attribute__((ext_vector_type(4)));
typedef unsigned short bf16;
typedef unsigned u32x4v __attribute__((ext_vector_type(4)));
typedef unsigned u32x2v __attribute__((ext_vector_type(2)));

struct Params { const float* in[27]; float* out; unsigned char* ws; int ph_lo, ph_hi; };
typedef const __attribute__((opencl_constant)) Params* KP;
#define KARGS() ({ auto _k = __builtin_amdgcn_kernarg_segment_ptr(); asm volatile("" : "+s"(_k)); (KP)_k; })

__device__ __forceinline__ float wave_sum(float v) {
#pragma unroll
    for (int o = 1; o < 64; o <<= 1) v += __shfl_xor(v, o);
    return v;
}
__device__ __forceinline__ unsigned pk2(float lo, float hi) { return PK2(lo, hi); }

template <bool OUT_BF16> __device__ __forceinline__ void ln_row(const float* src, const float* g, const float* b, void* dst, int lane) {
    const f32x4* xr = (const f32x4*)src + lane;
    f32x4 v[16]; float s = 0.f;
#pragma unroll
    for (int j = 0; j < 16; ++j) { v[j] = xr[64 * j]; s += (v[j][0] + v[j][1]) + (v[j][2] + v[j][3]); }
    const float mean = wave_sum(s) * (1.f / DM); float s2 = 0.f;
#pragma unroll
    for (int j = 0; j < 16; ++j) { v[j] = v[j] - mean; s2 += (v[j][0] * v[j][0] + v[j][1] * v[j][1]) + (v[j][2] * v[j][2] + v[j][3] * v[j][3]); }
    const float rstd = 1.f / sqrtf(wave_sum(s2) * (1.f / DM) + LN_EPS);
#pragma unroll
    for (int j = 0; j < 16; ++j) {
        const f32x4 gg = ((const f32x4*)g)[lane + 64 * j], bb = ((const f32x4*)b)[lane + 64 * j];
        const f32x4 o = v[j] * rstd * gg + bb;
        if (OUT_BF16) { uint2 w; w.x = pk2(o[0], o[1]); w.y = pk2(o[2], o[3]); ((uint2*)dst)[lane + 64 * j] = w; }
        else ((f32x4*)dst)[lane + 64 * j] = o;
    }
}
template <bool OUT_BF16> __device__ __forceinline__ void ln_row_bf(const bf16* src, const float* g, const float* b, void* dst, int lane) {
    const u32x4v* xr = (const u32x4v*)src + lane;
    float v[64]; float s = 0.f;
#pragma unroll
    for (int j = 0; j < 8; ++j) { const u32x4v q = xr[64 * j];
        v[8 * j + 0] = __uint_as_float(q.x << 16); v[8 * j + 1] = __uint_as_float(q.x & 0xffff0000u); v[8 * j + 2] = __uint_as_float(q.y << 16); v[8 * j + 3] = __uint_as_float(q.y & 0xffff0000u);
        v[8 * j + 4] = __uint_as_float(q.z << 16); v[8 * j + 5] = __uint_as_float(q.z & 0xffff0000u); v[8 * j + 6] = __uint_as_float(q.w << 16); v[8 * j + 7] = __uint_as_float(q.w & 0xffff0000u);
#pragma unroll
        for (int e = 0; e < 8; ++e) s += v[8 * j + e]; }
    const float mean = wave_sum(s) * (1.f / DM); float s2 = 0.f;
#pragma unroll
    for (int i = 0; i < 64; ++i) { v[i] -= mean; s2 += v[i] * v[i]; }
    const float rstd = 1.f / sqrtf(wave_sum(s2) * (1.f / DM) + LN_EPS);
#pragma unroll
    for (int j = 0; j < 8; ++j) {
        const int c0 = 8 * lane + 512 * j;
        const f32x4 g0 = *(const f32x4*)(g + c0), g1 = *(const f32x4*)(g + c0 + 4), b0 = *(const f32x4*)(b + c0), b1 = *(const f32x4*)(b + c0 + 4);
        float o[8];
#pragma unroll
        for (int e = 0; e < 4; ++e) { o[e] = v[8 * j + e] * rstd * g0[e] + b0[e]; o[4 + e] = v[8 * j + 4 + e] * rstd * g1[e] + b1[e]; }
        if (OUT_BF16) { u32x4v w; w.x = pk2(o[0], o[1]); w.y = pk2(o[2], o[3]); w.z = pk2(o[4], o[5]); w.w = pk2(o[6], o[7]); ((u32x4v*)dst)[lane + 64 * j] = w; }
        else { float* d = (float*)dst + c0; *(f32x4*)d = (f32x4){o[0], o[1], o[2], o[3]}; *(f32x4*)(d + 4) = (f32x4){o[4], o[5], o[6], o[7]}; }
    }
}
__device__ __forceinline__ void tr_item(const float* W, int ldn, int k0, int n0, bf16* WT, int ldk, int drow0, LAS float* scr, int lane) {
    f32x4 v[16];
#pragma unroll
    for (int i = 0; i < 16; ++i) v[i] = *(const f32x4*)(W + (size_t)(k0 + 4 * i + (lane >> 4)) * ldn + n0 + 4 * (lane & 15));
#pragma unroll
    for (int i = 0; i < 16; ++i) { LAS float* s = scr + (4 * i + (lane >> 4)) * 65 + 4 * (lane & 15); s[0] = v[i][0]; s[1] = v[i][1]; s[2] = v[i][2]; s[3] = v[i][3]; }
    asm volatile("s_waitcnt lgkmcnt(0)" ::: "memory");
    const int c = lane & 7;
#pragma unroll
    for (int j = 0; j < 8; ++j) { const int n = (lane >> 3) + 8 * j; const LAS float* s = scr + (8 * c) * 65 + n;
        uint4 o; o.x = pk2(s[0 * 65], s[1 * 65]); o.y = pk2(s[2 * 65], s[3 * 65]); o.z = pk2(s[4 * 65], s[5 * 65]); o.w = pk2(s[6 * 65], s[7 * 65]);
        *(uint4*)(WT + (size_t)(drow0 + n) * ldk + k0 + 8 * c) = o; }
    asm volatile("s_waitcnt lgkmcnt(0)" ::: "memory");
}
__device__ __forceinline__ void convert_weights(KP p, int l, LAS unsigned char* lds, int gw, int ngw, int wave, int lane) {
    LAS float* scr = (LAS float*)(lds + wave * 17408);
    unsigned char* ws = p->ws;
    const float* w_in = p->in[4] + (size_t)l * DM * INW; const float* w_fn = p->in[16] + (size_t)l * 1024 * 1024; const float* w_out = p->in[19] + (size_t)l * DM * DM;
    const float* w_g = p->in[22] + (size_t)l * DM * DFF; const float* w_u = p->in[23] + (size_t)l * DM * DFF; const float* w_d = p->in[24] + (size_t)l * DFF * DM;
    constexpr int I_IN = 64 * 112, I_FN = 16 * 16, I_OUT = 64 * 64, I_G = 64 * 172, I_D = 172 * 64;
    constexpr int NITEMS = I_IN + I_FN + I_OUT + 2 * I_G + I_D;
    for (int it = gw; it < NITEMS; it += ngw) {
        int r = it;
        if (r < I_IN) { const int kb = r / 112, nb = r % 112, n0 = 64 * nb; int d0;
            if (n0 < 3072) d0 = n0; else if (n0 < 4096) continue; else if (n0 < 6144) d0 = 4608 + (n0 - 4096); else if (n0 < 6656) d0 = 6656 + (n0 - 6144); else d0 = 4096 + (n0 - 6656);
            tr_item(w_in, INW, 64 * kb, n0, (bf16*)(ws + WS_WIN), DM, d0, scr, lane); continue; }
        r -= I_IN;
        if (r < I_FN) { const int kb = r / 16, nb = r % 16; tr_item(w_fn, 1024, 64 * kb, 64 * nb, (bf16*)(ws + WS_WFN), 1024, 64 * nb, scr, lane); continue; }
        r -= I_FN;
        if (r < I_OUT) { const int kb = r / 64, nb = r % 64; tr_item(w_out, DM, 64 * kb, 64 * nb, (bf16*)(ws + WS_WOUT), DM, 64 * nb, scr, lane); continue; }
        r -= I_OUT;
        if (r < I_G) { const int kb = r / 172, nb = r % 172, n0 = 64 * nb; tr_item(w_g, DFF, 64 * kb, n0, (bf16*)(ws + WS_WGU), DM, 256 * (n0 >> 7) + (n0 & 127), scr, lane); continue; }
        r -= I_G;
        if (r < I_G) { const int kb = r / 172, nb = r % 172, n0 = 64 * nb; tr_item(w_u, DFF, 64 * kb, n0, (bf16*)(ws + WS_WGU), DM, 256 * (n0 >> 7) + 128 + (n0 & 127), scr, lane); continue; }
        r -= I_G;
        { const int kb = r / 64, nb = r % 64; tr_item(w_d, DM, 64 * kb, 64 * nb, (bf16*)(ws + WS_WDN), DFF, 64 * nb, scr, lane); }
    }
}
__device__ __forceinline__ void fold_fnet(KP p, int l, LAS unsigned char* lds, int bid, int nb) {
    LAUNDER_TID(tid); LAS float* wt = (LAS float*)lds;
    LAS float* ct = (LAS float*)(lds + 128 * 129 * 4);
    const float* w_in = p->in[4] + (size_t)l * DM * INW; bf16* WT = (bf16*)(p->ws + WS_WIN);
    if (tid < 128) { ct[tid] = __builtin_amdgcn_cosf((float)tid * (1.0f / 128.f)); ct[128 + tid] = __builtin_amdgcn_sinf((float)tid * (1.0f / 128.f)); }
    for (int it = bid; it < 256; it += nb) {
        const int kb = it >> 3, h = it & 7, k0 = 128 * kb;
        __syncthreads();
        for (int e = tid; e < 128 * 128; e += NT) { const int kk = e >> 7, d = e & 127; wt[kk * 129 + d] = w_in[(size_t)(k0 + kk) * INW + 3072 + h * 128 + d]; }
        __syncthreads();
        const int kg = tid & 15, rgp = (tid >> 4) & 15, kh2 = tid >> 8;
        int toff[8]; float sg[8];
#pragma unroll
        for (int b = 0; b < 8; ++b) { const int r = 8 * rgp + b; const bool is_s = r > 64; toff[b] = is_s ? 128 : 0; sg[b] = is_s ? -1.f : 1.f; }
        float acc[4][8];
#pragma unroll
        for (int a = 0; a < 4; ++a)
#pragma unroll
            for (int b = 0; b < 8; ++b) acc[a][b] = 0.f;
        for (int d = 0; d < 128; ++d) {
            float wv[4], tv[8];
#pragma unroll
            for (int a = 0; a < 4; ++a) wv[a] = wt[(64 * kh2 + 4 * kg + a) * 129 + d];
#pragma unroll
            for (int b = 0; b < 8; ++b) { const int r = 8 * rgp + b, k2 = r > 64 ? r - 64 : r; tv[b] = ct[toff[b] + ((k2 * d) & 127)]; }
#pragma unroll
            for (int a = 0; a < 4; ++a)
#pragma unroll
                for (int b = 0; b < 8; ++b) acc[a][b] += wv[a] * tv[b];
        }
#pragma unroll
        for (int b = 0; b < 8; ++b) {
            uint2 o; o.x = pk2(sg[b] * acc[0][b], sg[b] * acc[1][b]); o.y = pk2(sg[b] * acc[2][b], sg[b] * acc[3][b]);
            *(uint2*)(WT + (size_t)(3072 + h * 128 + 8 * rgp + b) * DM + k0 + 64 * kh2 + 4 * kg) = o; }
    }
    __syncthreads();
}
__device__ __forceinline__ void h3_items(KP p, LAS unsigned char* lds, int bid, int nb) {
    LAUNDER_TID(tid); const int pp = tid >> 6, j = tid & 63;
    LAS float* z = (LAS float*)lds; LAS float* hA = z + 8 * 36; LAS float* hB = hA + 8 * 64;
    bf16* h3p = (bf16*)(p->ws + WS_H3);
    for (int it = bid; it < 2 * (LPOS / 8); it += nb) {
        const int l = it / (LPOS / 8), g = (it % (LPOS / 8)) * 8 + pp; const int Lt = g < LP_ ? LP_ : LS_, t = g < LP_ ? g : g - LP_;
        const float* w1 = p->in[7] + l * 33 * 64; const float* b1 = p->in[8] + l * 64; const float* w2 = p->in[9] + l * 4096; const float* b2 = p->in[10] + l * 64;
        const float* w3 = p->in[11] + l * 4096; const float* b3 = p->in[12] + l * 64; const float* fq = p->in[13] + l * 192;
        __syncthreads();
        if (j < 33) { const float wv = (6.283185307179586f / (float)Lt) * (float)t; float val;
            if (j == 0) val = (float)t / (float)(Lt - 1);
            else if (j <= 16) { const float f = 1e-4f + (float)(j - 1) * ((15.0f - 1e-4f) / 15.0f); val = cosf(f * wv); }
            else { const float f = 1e-4f + (float)(j - 17) * ((15.0f - 1e-4f) / 15.0f); val = -sinf(f * wv); }
            z[pp * 36 + j] = val; }
        __syncthreads();
        float a = b1[j];
        for (int i = 0; i < 33; ++i) a += z[pp * 36 + i] * w1[i * 64 + j];
        hA[pp * 64 + j] = sinf(fq[j] * a);
        __syncthreads();
        a = b2[j];
        for (int m = 0; m < 64; ++m) a += hA[pp * 64 + m] * w2[m * 64 + j];
        hB[pp * 64 + j] = sinf(fq[64 + j] * a);
        __syncthreads();
        a = b3[j];
        for (int m = 0; m < 64; ++m) a += hB[pp * 64 + m] * w3[m * 64 + j];
        { const float v = sinf(fq[128 + j] * a); const bf16 hi = f2bf(v), lo = f2bf(v - bf2f(hi));
          bf16* row = h3p + ((size_t)l * LPOS + g) * 256; row[j] = hi; row[64 + j] = lo; row[128 + j] = hi; row[192 + j] = 0; }
    }
    __syncthreads();
    { bf16* w4p = (bf16*)(p->ws + WS_W4P);
      for (int e = bid * NT + tid; e < 2 * 4096 * 64; e += nb * NT) { const int l = e >> 18, jj = (e >> 6) & 4095, mm = e & 63;
          const float v = p->in[14][((size_t)l * 64 + mm) * 4096 + jj]; const bf16 hi = f2bf(v), lo = f2bf(v - bf2f(hi));
          bf16* row = w4p + ((size_t)l * 4096 + jj) * 256; row[mm] = hi; row[64 + mm] = hi; row[128 + mm] = lo; row[192 + mm] = 0; } }
}
__device__ __forceinline__ void hc_gemm(KP p, int l, LAS unsigned char* lds, int bid, int nb) {
    pg8::Gemm g{(const bf16*)(p->ws + WS_W4P) + (size_t)l * 4096 * 256, (const bf16*)(p->ws + WS_H3) + (size_t)l * LPOS * 256, 4096, LPOS, 256};
    pg8::StaticOrder S; S.init(4096, LPOS, nb, bid);
    pg8::EpiHc E{l == 0 ? (float*)(p->ws + WS_HC) : (float*)((unsigned char*)p->out + OUT_HC1), LPOS};
    pg8::gemm_phase<pg8::EpiHc, pg8::StaticOrder, GP_ALIGN, GP_SP2>(lds, g, S, E);
}
__device__ __forceinline__ void kf_units(KP p, int l, LAS unsigned char* lds, int bid, int nb) {
    const float* Hc = l == 0 ? (const float*)(p->ws + WS_HC) : (const float*)((const unsigned char*)p->out + OUT_HC1); LAS cf* buf = (LAS cf*)lds;
    for (int u = bid; u < 2048; u += nb) {
        const int lt = u >> 10, c = u & 1023; const size_t go = lt ? LP_ : 0;
        const float* hf0 = Hc + (size_t)c * LPOS + go; const float* hb0 = Hc + (size_t)(2048 + c) * LPOS + go;
        const float* hf1 = Hc + (size_t)(1024 + c) * LPOS + go; const float* hb1 = Hc + (size_t)(3072 + c) * LPOS + go;
        if (lt == 0) { unsigned* K = (unsigned*)((unsigned char*)p->out + OUT_KF0); dev_kf2_unit<13>(buf, hf0, hb0, hf1, hb1, K + (size_t)c * 16384, K + (size_t)(1024 + c) * 16384); }
        else { unsigned* K = (unsigned*)((unsigned char*)p->out + OUT_KF1); dev_kf2_unit<12>(buf, hf0, hb0, hf1, hb1, K + (size_t)c * 8192, K + (size_t)(1024 + c) * 8192); }
    }
}
struct AttnUnit { int tok0, nblk, n, h; };
__device__ __forceinline__ AttnUnit attn_decode(int u) {
    const bool pr = u < 2048; const int v = pr ? u : u - 2048, h = v & 15, r = v >> 4; const int nblk = pr ? 64 : 32, sq = r / nblk, n = r % nblk;
    AttnUnit a; a.tok0 = pr ? sq * LP_ : TOK_S0 + sq * LS_; a.nblk = nblk; a.n = n; a.h = h; return a;
}
__device__ __forceinline__ void attn_phase(LAS unsigned char* lds, const bf16* QK, const bf16* UT, bf16* MIX, const float* sink, int bid, int nb) {
    LAUNDER_TID(tid); const int lane = tid & 63, w = __builtin_amdgcn_readfirstlane(tid >> 6), fr = lane & 15, g = lane >> 4;
    const float LOG2E = 1.4426950408889634f, sc = 0.08838834764831845f * LOG2E;
    const int nun = (4096 - bid + nb - 1) / nb;
    int ci = 0, cj = 0;
    AttnUnit cu = attn_decode(bid + nb * ci);
    u32x4v kv[4], vv[4]; bf16x8 qf[4], qn[4];
    const int lr = tid >> 2, lq = tid & 3;
    auto slot_tile = [&](int jc, int sl) -> int { return jc == 0 ? sl : 2 * sl + (sl < 4 ? (jc == 1 ? -7 : -8) : (jc == 1 ? 0 : 1)); };
    auto issue_kv = [&](const AttnUnit& a, int jc) {
        const int kh = a.h >> 2, nkeys = 128 * a.nblk;
        int krow = 128 * a.n + 16 * slot_tile(jc, lr >> 4) + (lr & 15); if (krow < 0 || krow >= nkeys) krow = 128 * a.n + lr;
        int kc0 = 128 * a.n + 16 * slot_tile(jc, 2 * lq), kc1 = 128 * a.n + 16 * slot_tile(jc, 2 * lq + 1);
        if (kc0 < 0 || kc0 >= nkeys) { kc0 = 128 * a.n + 32 * lq; kc1 = kc0 + 16; }
        const bf16* srcK = QK + (size_t)(a.tok0 + krow) * 2560 + 2048 + 128 * kh + 32 * lq;
        const bf16* rowV = UT + (size_t)(4096 + 128 * kh + lr) * NTOK + a.tok0;
#pragma unroll
        for (int i = 0; i < 4; ++i) kv[i] = *(const u32x4v*)(srcK + 8 * i);
        vv[0] = *(const u32x4v*)(rowV + kc0); vv[1] = *(const u32x4v*)(rowV + kc0 + 8); vv[2] = *(const u32x4v*)(rowV + kc1); vv[3] = *(const u32x4v*)(rowV + kc1 + 8);
    };
    auto issue_q = [&](const AttnUnit& a, bf16x8 (&q)[4]) {
        const bf16* qrow = QK + (size_t)(a.tok0 + 128 * a.n + 16 * w + fr) * 2560 + 128 * a.h;
#pragma unroll
        for (int kk = 0; kk < 4; ++kk) q[kk] = *(const bf16x8*)(qrow + 32 * kk + 8 * g);
    };
    if (nun > 0) { issue_kv(cu, cj); issue_q(cu, qf); }
    float m_run = 0.f, l_run = 1.f; f32x4 o[8]; bool fresh = true; int pb = 0;
    while (ci < nun) {
        LAS bf16* Ks = (LAS bf16*)(lds + pb * 69632); LAS bf16* Vs = Ks + 128 * 136;
#pragma unroll
        for (int i = 0; i < 4; ++i) { *(LAS u32x4v*)(Ks + lr * 136 + 32 * lq + 8 * i) = kv[i]; *(LAS u32x4v*)(Vs + lr * 136 + 32 * lq + 8 * i) = vv[i]; }
        int ni = ci, nj = cj + 1; AttnUnit nu = cu;
        if (nj > 2) { ni = ci + 1; nj = 0; if (ni < nun) nu = attn_decode(bid + nb * ni); }
        const bool has_next = ni < nun, new_unit = ni != ci;
        if (has_next) { issue_kv(nu, nj); if (new_unit) issue_q(nu, qn); }
        __syncthreads();
        if (fresh) { m_run = sink[cu.h] * LOG2E; l_run = 1.f;
#pragma unroll
            for (int dt = 0; dt < 8; ++dt) o[dt] = (f32x4){0.f, 0.f, 0.f, 0.f}; }
        const float slope = exp2f(-0.5f * (float)(cu.h + 1)) * LOG2E;
        const int ta = cj == 0 ? 1 : 2, tbL = cj == 0 ? 0 : (cj == 1 ? -7 : -8), tbR = cj == 0 ? 0 : (cj == 1 ? 0 : 1);
        const float dq = (float)(16 * w + fr - 4 * g), dL = dq - (float)(16 * tbL), dR = dq - (float)(16 * tbR), da = (float)(16 * ta);
        int kt_lo = cj == 0 ? 0 : (cj == 1 ? (w >> 1) : ((w + 1) >> 1)), kt_hi = cj == 0 ? 7 : (cj == 1 ? 4 + (w >> 1) : ((w + 7) >> 1));
        if (cj != 0) { if (cu.n == 0) kt_lo = 4; if (cu.n == cu.nblk - 1) kt_hi = 3; }
        f32x4 s[8];
#pragma unroll
        for (int kt = 0; kt < 8; ++kt) { f32x4 acc = (f32x4){0.f, 0.f, 0.f, 0.f};
            if (kt >= kt_lo && kt <= kt_hi) {
#pragma unroll
                for (int kk = 0; kk < 4; ++kk) { const bf16x8 a = *(const LAS bf16x8*)(Ks + (16 * kt + fr) * 136 + 32 * kk + 8 * g); acc = __builtin_amdgcn_mfma_f32_16x16x32_bf16(a, qf[kk], acc, 0, 0, 0); } }
            s[kt] = acc; }
        float mx = -3.0e38f;
#pragma unroll
        for (int kt = 0; kt < 8; ++kt) if (kt >= kt_lo && kt <= kt_hi) {
#pragma unroll
            for (int i = 0; i < 4; ++i) { const float ad = fabsf(((kt < 4 ? dL : dR) - da * (float)kt) - (float)i);
                float v = s[kt][i] * sc - slope * ad; v = (ad <= 128.f) ? v : -__builtin_inff(); s[kt][i] = v; mx = fmaxf(mx, v); } }
        mx = fmaxf(mx, __shfl_xor(mx, 16)); mx = fmaxf(mx, __shfl_xor(mx, 32));
        const float m_new = fmaxf(m_run, mx), alpha = __builtin_amdgcn_exp2f(m_run - m_new);
        float ps = 0.f;
#pragma unroll
        for (int kt = 0; kt < 8; ++kt) if (kt >= kt_lo && kt <= kt_hi) {
#pragma unroll
            for (int i = 0; i < 4; ++i) { const float pv = __builtin_amdgcn_exp2f(s[kt][i] - m_new); ps += pv; s[kt][i] = pv; } }
        ps += __shfl_xor(ps, 16); ps += __shfl_xor(ps, 32);
        l_run = l_run * alpha + ps; m_run = m_new;
#pragma unroll
        for (int dt = 0; dt < 8; ++dt) o[dt] *= alpha;
#pragma unroll
        for (int ks = 0; ks < 4; ++ks) if (2 * ks + 1 >= kt_lo && 2 * ks <= kt_hi) {
            union { bf16x8 v; unsigned u[4]; } pbk;
            pbk.u[0] = pk2(s[2 * ks][0], s[2 * ks][1]); pbk.u[1] = pk2(s[2 * ks][2], s[2 * ks][3]); pbk.u[2] = pk2(s[2 * ks + 1][0], s[2 * ks + 1][1]); pbk.u[3] = pk2(s[2 * ks + 1][2], s[2 * ks + 1][3]);
#pragma unroll
            for (int dt = 0; dt < 8; ++dt) { const LAS bf16* vp = Vs + (16 * dt + fr) * 136 + 32 * ks + 4 * g;
                union { bf16x8 v; u32x2v h[2]; } a; a.h[0] = *(const LAS u32x2v*)vp; a.h[1] = *(const LAS u32x2v*)(vp + 16);
                o[dt] = __builtin_amdgcn_mfma_f32_16x16x32_bf16(a.v, pbk.v, o[dt], 0, 0, 0); }
        }
        fresh = false;
        if (new_unit) {
            const float inv = 1.0f / l_run;
            bf16* orow = MIX + (size_t)(cu.tok0 + 128 * cu.n + 16 * w + fr) * DM + 2048 + 128 * cu.h + 4 * g;
#pragma unroll
            for (int dt = 0; dt < 8; ++dt) { uint2 wv; wv.x = pk2(o[dt][0] * inv, o[dt][1] * inv); wv.y = pk2(o[dt][2] * inv, o[dt][3] * inv); *(uint2*)(orow + 16 * dt) = wv; }
            fresh = true;
#pragma unroll
            for (int kk = 0; kk < 4; ++kk) qf[kk] = qn[kk];
        }
        ci = ni; cj = nj; cu = nu; pb ^= 1;
    }
    __syncthreads();
}
__device__ __forceinline__ void mixer_phase(KP p, int l, LAS unsigned char* lds, int bid, int nb) {
    const bf16* UT = (const bf16*)(p->ws + WS_UT); bf16* TO = (bf16*)(p->ws + WS_TO); LAS cf* buf = (LAS cf*)lds;
    const unsigned* KF0 = (const unsigned*)((const unsigned char*)p->out + OUT_KF0); const unsigned* KF1 = (const unsigned*)((const unsigned char*)p->out + OUT_KF1);
    const float* sw = p->in[5] + (size_t)l * 3 * 3072; const float* sb = p->in[6] + (size_t)l * 3072; const float* skip = p->in[15] + (size_t)l * 2048;
#ifndef SK_HY
#ifndef MX_REP
#define MX_REP 0
#endif
    for (int mr = 0; mr < 1 + (MX_REP & 1); ++mr)
    for (int ui = 0; bid + nb * (ui < 4 ? ui : 4 + ((ui - 4) >> 1)) < (ui < 4 ? 1024 : 2048); ++ui) {
        const bool pr = ui < 4; const int c = pr ? bid + nb * ui : bid + nb * ((ui - 4) >> 1), tokA = pr ? 0 : TOK_S0 + ((ui - 4) & 1) * 2 * LS_;
        HyArgs A; A.rowX1A = UT + (size_t)c * NTOK + tokA; A.rowX2A = UT + (size_t)(1024 + c) * NTOK + tokA; A.rowVA = UT + (size_t)(2048 + c) * NTOK + tokA; A.outA = TO + (size_t)c * NTOK + tokA;
        A.K1 = pr ? KF0 + (size_t)c * 16384 : KF1 + (size_t)c * 8192; A.K2 = pr ? KF0 + (size_t)(1024 + c) * 16384 : KF1 + (size_t)(1024 + c) * 8192;
#pragma unroll
        for (int i = 0; i < 3; ++i) {
#pragma unroll
            for (int k = 0; k < 3; ++k) A.sw[i][k] = sw[k * 3072 + i * 1024 + c];
            A.sb[i] = sb[i * 1024 + c]; }
        A.skip0 = skip[c]; A.skip1 = skip[1024 + c];
        if (pr) dev_hyena_unit<13>(buf, A); else dev_hyena_unit<12>(buf, A);
    }
#endif
#ifndef SK_FN
    for (int mr = 0; mr < 1 + ((MX_REP >> 1) & 1); ++mr) {
        for (int u = bid; u < 2 * 8 * 65; u += nb) { const int b = u / 520, r = u % 520, h = r / 65, k2 = r % 65; const float sg = (k2 == 0 || k2 == 64) ? 0.f : 1.f;
            const bf16* rc = UT + (size_t)(3072 + h * 128 + k2) * NTOK + b * LP_; const bf16* rs = (sg == 0.f) ? rc : UT + (size_t)(3072 + h * 128 + 64 + k2) * NTOK + b * LP_;
            bf16* o1 = TO + (size_t)(1024 + h * 128 + k2) * NTOK + b * LP_; bf16* o2 = (sg == 0.f) ? nullptr : TO + (size_t)(1024 + h * 128 + 128 - k2) * NTOK + b * LP_;
            dev_fnet_unit<13>(buf, rc, rs, sg, o1, o2, 9.765625e-4f  ); }
        for (int v = bid; v < 4 * 8 * 65; v += nb) { const int b = v / 520, r = v % 520, h = r / 65, k2 = r % 65; const float sg = (k2 == 0 || k2 == 64) ? 0.f : 1.f;
            const bf16* rc = UT + (size_t)(3072 + h * 128 + k2) * NTOK + TOK_S0 + b * LS_; const bf16* rs = (sg == 0.f) ? rc : UT + (size_t)(3072 + h * 128 + 64 + k2) * NTOK + TOK_S0 + b * LS_;
            bf16* o1 = TO + (size_t)(1024 + h * 128 + k2) * NTOK + TOK_S0 + b * LS_; bf16* o2 = (sg == 0.f) ? nullptr : TO + (size_t)(1024 + h * 128 + 128 - k2) * NTOK + TOK_S0 + b * LS_;
            dev_fnet_unit<12>(buf, rc, rs, sg, o1, o2, 1.3810679320049757e-3f  ); }
    }
#endif
#ifndef SK_AT
    const bf16* QK = (const bf16*)(p->ws + WS_QK); bf16* MIX = (bf16*)(p->ws + WS_MIX); const float* sink = p->in[18] + l * 16;
    for (int mr = 0; mr < 1 + ((MX_REP >> 2) & 1); ++mr) attn_phase(lds, QK, UT, MIX, sink, bid, nb);
#endif
    __syncthreads();
}
__device__ __forceinline__ void transpose_out(KP p, int gw, int ngw, int lane) {
    const bf16* TO = (const bf16*)(p->ws + WS_TO); bf16* MIX = (bf16*)(p->ws + WS_MIX); bf16* YF = (bf16*)(p->ws + WS_YF);
    for (int it = gw; it < 64 * 256; it += ngw) {
        const int cb = it & 63, tb = it >> 6, ch0 = 32 * cb, tok = 128 * tb + 2 * lane;
        unsigned w[32];
#pragma unroll
        for (int i = 0; i < 32; ++i) w[i] = *(const unsigned*)(TO + (size_t)(ch0 + i) * NTOK + tok);
#pragma unroll
        for (int t = 0; t < 2; ++t) {
            bf16* dst = ch0 < 1024 ? MIX + (size_t)(tok + t) * DM + ch0 : YF + (size_t)(tok + t) * 1024 + (ch0 - 1024);
#pragma unroll
            for (int q = 0; q < 4; ++q) { uint4 o;
                if (t == 0) { o.x = (w[8 * q] & 0xffffu) | (w[8 * q + 1] << 16); o.y = (w[8 * q + 2] & 0xffffu) | (w[8 * q + 3] << 16); o.z = (w[8 * q + 4] & 0xffffu) | (w[8 * q + 5] << 16); o.w = (w[8 * q + 6] & 0xffffu) | (w[8 * q + 7] << 16); }
                else { o.x = (w[8 * q] >> 16) | (w[8 * q + 1] & 0xffff0000u); o.y = (w[8 * q + 2] >> 16) | (w[8 * q + 3] & 0xffff0000u); o.z = (w[8 * q + 4] >> 16) | (w[8 * q + 5] & 0xffff0000u); o.w = (w[8 * q + 6] >> 16) | (w[8 * q + 7] & 0xffff0000u); }
                *(uint4*)(dst + 8 * q) = o; } }
    }
}

__global__ void __launch_bounds__(512, 2) mega_fwd(Params p) {
    extern __shared__ __attribute__((aligned(16))) unsigned char lds_raw[];
    LAS unsigned char* lds = (LAS unsigned char*)lds_raw;
    const int tid = threadIdx.x;
    const int bid0 = blockIdx.x, nb0 = gridDim.x;
#define PH_IDS LAUNDER_TID(tid_); const int lane = tid_ & 63, wave = __builtin_amdgcn_readfirstlane(tid_ >> 6), gw = bid * 8 + wave, ngw = nb * 8; (void)lane; (void)gw; (void)ngw
    volatile LAS unsigned* misc = (volatile LAS unsigned*)(lds + LDS_MISC);
    if (tid < 64) misc[tid] = 0u;
    __syncthreads();
#ifdef CLK_PROBE
    const unsigned long long ck_c0 = __builtin_readcyclecounter(), ck_r0 = __builtin_amdgcn_s_memrealtime();
#endif
    const int lo = p.ph_lo, hi = p.ph_hi;
    const bool multi = (hi - lo) > 1;
    XcdBarrier bar; bar.bar = (unsigned*)(p.ws + WS_CTL) + CW_BAR; bar.x = 0; bar.st = nullptr;
    if (multi) bar = xcd_barrier_post((unsigned*)(p.ws + WS_CTL) + CW_BAR, misc + 8);
#ifndef PH_EN
#define PH_EN 0x7FF
#endif
#define IN(k) (((PH_EN >> ((k) < 2 ? (k) : 2 + ((k) - 2) % 9)) & 1) && lo <= (k) && (k) < hi)
#ifndef REP_MASK
#define REP_MASK 0
#endif
#define REPS(t) (1 + ((REP_MASK >> (t)) & 1))
#ifndef TM_MASK
#define TM_MASK 0
#endif
    unsigned long long tm_acc = 0ull, tm_t0 = TM_MASK ? __builtin_amdgcn_s_memrealtime() : 0ull; (void)tm_acc; (void)tm_t0;
#define TM_T(k) ((k) < 2 ? (k) : 2 + ((k) - 2) % 9)
#define SEAM(k) do { if (IN(k) && IN((k) + 1)) xcd_barrier(bar); \
    if (TM_MASK) { const unsigned long long _t = __builtin_amdgcn_s_memrealtime(); if ((TM_MASK >> TM_T(k)) & 1) tm_acc += _t - tm_t0; tm_t0 = _t; } } while (0)
#define PH_ARGS int bid = bid0, nb = nb0; asm volatile("" : "+s"(bid), "+s"(nb)); KP kp = KARGS(); unsigned char* ws = kp->ws; bf16* X = (bf16*)(ws + WS_X); bf16* MIX = (bf16*)(ws + WS_MIX); (void)X; (void)MIX

    if (IN(0)) for (int rep = 0; rep < REPS(0); ++rep) { PH_ARGS; PH_IDS;
        h3_items(kp, lds, bid, nb);
        convert_weights(kp, 0, lds, gw, ngw, wave, lane);
        __syncthreads();
        fold_fnet(kp, 0, lds, bid, nb);
        for (int m = gw; m < NTOK; m += ngw) ln_row<true>(m < TOK_S0 ? kp->in[0] + (size_t)m * DM : kp->in[1] + (size_t)(m - TOK_S0) * DM, kp->in[2], kp->in[3], X + (size_t)m * DM, lane);
    }
    SEAM(0);
    if (IN(1)) for (int rep = 0; rep < REPS(1); ++rep) { PH_ARGS; for (int hl = 0; hl < 2; ++hl) hc_gemm(kp, hl, lds, bid, nb); }
    SEAM(1);
    for (int l = 0; l < 2; ++l) {
        const int pb = 2 + 9 * l;
        if (IN(pb + 0)) for (int rep = 0; rep < REPS(2); ++rep) { PH_ARGS;
#ifndef SK_GA
            for (int gi = 0; gi < 2; ++gi) {
                const bf16* Wt = (const bf16*)(ws + WS_WIN);
                pg8::Gemm g{gi == 0 ? Wt : X, gi == 0 ? X : Wt + (size_t)4608 * DM, gi == 0 ? 4608 : NTOK, gi == 0 ? NTOK : 2560, DM};
                pg8::StaticOrder S; S.init(g.M, g.N, nb, bid);
                pg8::EpiBf16<0> E{gi == 0 ? (bf16*)(ws + WS_UT) : (bf16*)(ws + WS_QK), gi == 0 ? NTOK : 2560, nullptr, 0, 0};
                pg8::gemm_phase<pg8::EpiBf16<0>, pg8::StaticOrder, GP_ALIGN, GP_SP2>(lds, g, S, E);
            }
#endif
#ifndef SK_KF
            kf_units(kp, l, lds, bid, nb);
#endif
        }
        SEAM(pb + 0);
        if (IN(pb + 1)) for (int rep = 0; rep < REPS(3); ++rep) { PH_ARGS; mixer_phase(kp, l, lds, bid, nb); }
        SEAM(pb + 1);
        if (IN(pb + 2)) for (int rep = 0; rep < REPS(4); ++rep) { PH_ARGS; PH_IDS; transpose_out(kp, gw, ngw, lane); }
        SEAM(pb + 2);
        if (IN(pb + 3)) for (int rep = 0; rep < REPS(5); ++rep) { PH_ARGS;
            pg8::Gemm g{(const bf16*)(ws + WS_YF), (const bf16*)(ws + WS_WFN), NTOK, 1024, 1024}; pg8::StaticOrder S; S.init(NTOK, 1024, nb, bid);
            pg8::EpiBf16<0> E{MIX + 1024, DM, kp->in[17] + l * 1024, 0, 0};
            pg8::gemm_phase<pg8::EpiBf16<0>, pg8::StaticOrder, GP_ALIGN, GP_SP2>(lds, g, S, E);
        }
        SEAM(pb + 3);
        if (IN(pb + 4)) for (int rep = 0; rep < REPS(6); ++rep) { PH_ARGS;
            pg8::Gemm g{MIX, (const bf16*)(ws + WS_WOUT), NTOK, DM, DM}; pg8::StaticOrder S; S.init(NTOK, DM, nb, bid, 2);
            pg8::EpiResBf16 E{(bf16*)(ws + WS_UT), X, DM, ALPHA};
            pg8::gemm_phase<pg8::EpiResBf16, pg8::StaticOrder, GP_ALIGN, GP_SP2>(lds, g, S, E);
        }
        SEAM(pb + 4);
        if (IN(pb + 5)) for (int rep = 0; rep < REPS(7); ++rep) { PH_ARGS; PH_IDS; for (int m = gw; m < NTOK; m += ngw) ln_row_bf<true>((const bf16*)(ws + WS_UT) + (size_t)m * DM, kp->in[20] + l * DM, kp->in[21] + l * DM, MIX + (size_t)m * DM, lane); }
        SEAM(pb + 5);
        if (IN(pb + 6)) for (int rep = 0; rep < REPS(8); ++rep) { PH_ARGS;
            pg8::Gemm g{MIX, (const bf16*)(ws + WS_WGU), NTOK, 2 * DFF, DM}; pg8::StaticOrder S; S.init(NTOK, 2 * DFF, nb, bid);
            pg8::EpiSwiGLU E{(bf16*)(ws + WS_H), DFF};
            pg8::gemm_phase<pg8::EpiSwiGLU, pg8::StaticOrder, GP_ALIGN, GP_SP2>(lds, g, S, E);
        }
        SEAM(pb + 6);
        if (IN(pb + 7)) for (int rep = 0; rep < REPS(9); ++rep) { PH_ARGS;
            pg8::Gemm g{(const bf16*)(ws + WS_H), (const bf16*)(ws + WS_WDN), NTOK, DM, DFF}; pg8::StaticOrder S; S.init(NTOK, DM, nb, bid, 2);
            pg8::EpiResBf16 E{X, MIX, DM, ALPHA};
            pg8::gemm_phase<pg8::EpiResBf16, pg8::StaticOrder, GP_ALIGN, GP_SP2>(lds, g, S, E);
        }
        SEAM(pb + 7);
        if (IN(pb + 8)) for (int rep = 0; rep < (l == 0 ? REPS(10) : 1); ++rep) { PH_ARGS; PH_IDS;
            if (l == 0) {
                for (int m = gw; m < NTOK; m += ngw) ln_row_bf<true>(X + (size_t)m * DM, kp->in[25] + l * DM, kp->in[26] + l * DM, X + (size_t)m * DM, lane);
                __syncthreads();
                convert_weights(kp, 1, lds, gw, ngw, wave, lane);
                __syncthreads();
                fold_fnet(kp, 1, lds, bid, nb);
            } else {
                for (int m = gw; m < NTOK; m += ngw) ln_row_bf<false>(X + (size_t)m * DM, kp->in[25] + l * DM, kp->in[26] + l * DM, kp->out + (size_t)m * DM, lane);
            }
        }
        if (l == 0) SEAM(pb + 8);
    }
    if (TM_MASK) { const unsigned long long _t = __builtin_amdgcn_s_memrealtime(); if ((TM_MASK >> 10) & 1) tm_acc += _t - tm_t0;
        while (__builtin_amdgcn_s_memrealtime() - _t < tm_acc) __builtin_amdgcn_s_sleep(8); }
#ifdef BAR_PROBE
    if (multi) { for (int i = 0; i < BAR_PROBE; ++i) xcd_barrier(bar); }
#endif
#ifdef CLK_PROBE
    { const unsigned long long c1 = __builtin_readcyclecounter(), r1 = __builtin_amdgcn_s_memrealtime();
      const unsigned long long ticks = (c1 - ck_c0) * 10000ull / (r1 - ck_r0); while (__builtin_amdgcn_s_memrealtime() - r1 < ticks) __builtin_amdgcn_s_sleep(8); }
#endif
#undef IN
#undef SEAM
}

extern "C" void kernel_launch(void* const* d_in, const int* in_sizes, int n_in, void* d_out, int out_size, void* d_ws, size_t ws_size, hipStream_t stream) {
    static int grid = 0;
    if (grid == 0) {
        if (n_in != 27 || out_size != 2 * TOK_S0 * DM || ws_size < WS_END) { fprintf(stderr, "kernel_launch: unexpected shapes (n_in %d, out %d, ws %zu)\n", n_in, out_size, ws_size); grid = -1; return; }
        int dev = 0, cus = 0, per_cu = 0;
        if (hipGetDevice(&dev) != hipSuccess || hipDeviceGetAttribute(&cus, hipDeviceAttributeMultiprocessorCount, dev) != hipSuccess) { grid = -1; return; }
        if (hipFuncSetAttribute((const void*)mega_fwd, hipFuncAttributeMaxDynamicSharedMemorySize, LDS_BYTES) != hipSuccess) { fprintf(stderr, "kernel_launch: hipFuncSetAttribute failed\n"); grid = -1; return; }
        if (hipOccupancyMaxActiveBlocksPerMultiprocessor(&per_cu, (const void*)mega_fwd, 512, LDS_BYTES) != hipSuccess || per_cu < 1) fprintf(stderr, "kernel_launch: occupancy query reports %d\n", per_cu);
        (void)hipGetLastError();
        grid = cus;
    }
    if (grid < 0) return;
    (void)in_sizes;
    if (hipMemsetAsync((char*)d_ws + WS_CTL, 0, CTL_ZERO_BYTES, stream) != hipSuccess) return;
    Params p{};
    for (int i = 0; i < 27; ++i) p.in[i] = (const float*)d_in[i];
    p.out = (float*)d_out; p.ws = (unsigned char*)d_ws;
#if MK_MULTI
    for (int k = 0; k < NPH; ++k) { p.ph_lo = k; p.ph_hi = k + 1; hipLaunchKernelGGL(mega_fwd, dim3(grid), dim3(512), LDS_BYTES, stream, p); }
#else
    p.ph_lo = 0; p.ph_hi = NPH;
    hipLaunchKernelGGL(mega_fwd, dim3(grid), dim3(512), LDS_BYTES, stream, p);
#endif
}
```

```cpp
#include <hip/hip_runtime.h>
#include <cstdio>
#include <cmath>
#define MK_MULTI 0
namespace pg8 {
#define PG8_LAS __attribute__((address_space(3)))
typedef unsigned short bf16_t;
typedef short bf16x8 __attribute__((ext_vector_type(8)));
typedef float f32x4 __attribute__((ext_vector_type(4)));
typedef unsigned u32x4 __attribute__((ext_vector_type(4)));
constexpr int BM = 256, BK = 64, HALF = 128, HTB = HALF * BK * 2  , STAGE_BYTES = 8 * HTB, NXCD = 8, WGM = 8;

__host__ __device__ __forceinline__ int lds_byte(int r, int c) { const int st = (r >> 4) * 2 + (c >> 5), rr = r & 15, cc = c & 31, ob = rr * 64 + cc * 2; return st * 1024 + (ob ^ (((ob >> 9) & 1) << 5)); }
__host__ __device__ __forceinline__ void stage_rc(int b, int& R, int& C) { const int st = b / 1024, sb = b % 1024, swz = sb ^ (((sb >> 9) & 1) << 5); R = (st >> 1) * 16 + swz / 64; C = (st & 1) * 32 + (swz % 64) / 2; }
__host__ __device__ __forceinline__ int perm32(int rho) { const int n = rho >> 4, i = rho & 15; return 8 * (i >> 2) + 4 * n + (i & 3); }

struct Unit { int pm, pn; };
struct Gemm { const bf16_t* A; const bf16_t* Bt; int M, N, K; };

struct StaticOrder {
    int nM, nN, nwg, G, c, wgm;
    __host__ __device__ void init(int M, int N, int G_, int c_, int wgm_ = WGM) { nM = M / BM; nN = N / BM; nwg = nM * nN; G = G_; c = c_; wgm = wgm_; }
    __host__ __device__ bool next(int i, Unit& u) const {
        const long L = (long)i * G + c; if (L >= nwg) return false;
        int wgid = (int)L; { const int q = nwg / NXCD, r = nwg % NXCD, xcd = wgid % NXCD, off = wgid / NXCD; wgid = (xcd < r ? xcd * (q + 1) : r * (q + 1) + (xcd - r) * q) + off; }
        const int nig = wgm * nN, gid = wgid / nig, fm = gid * wgm, gsz = (nM - fm) < wgm ? (nM - fm) : wgm;
        u.pm = fm + ((wgid % nig) % gsz); u.pn = (wgid % nig) / gsz; return true;
    }
    __device__ __forceinline__ void a_ready(const Unit&) const {}
    __device__ __forceinline__ void done(const Unit&) const {}
};
struct CountedOrder : StaticOrder {
    const unsigned* ready; unsigned need; unsigned* tmo;
    __device__ __forceinline__ void a_ready(const Unit& u) const {
        if (threadIdx.x < 64) {
            const unsigned long long t0 = __builtin_amdgcn_s_memrealtime(); unsigned polls = 0;
            while ((unsigned)__builtin_amdgcn_readfirstlane(__hip_atomic_load(ready + 64 * u.pm, __ATOMIC_RELAXED, __HIP_MEMORY_SCOPE_AGENT)) < need) {
                if ((++polls & 255u) == 0u && __builtin_amdgcn_readfirstlane(__hip_atomic_load(tmo, __ATOMIC_RELAXED, __HIP_MEMORY_SCOPE_AGENT)) != 0u) break;
                if (__builtin_amdgcn_s_memrealtime() - t0 > 2000000ull) {
                    if (threadIdx.x == 0) { unsigned expect = 0u; __hip_atomic_compare_exchange_strong(tmo + 1, &expect, 0x600u | (unsigned)(u.pm & 0xff), __ATOMIC_RELAXED, __ATOMIC_RELAXED, __HIP_MEMORY_SCOPE_AGENT); __hip_atomic_store(tmo, 1u, __ATOMIC_RELAXED, __HIP_MEMORY_SCOPE_AGENT); }
                    break; }
                __builtin_amdgcn_s_sleep(2); }
            __builtin_amdgcn_fence(__ATOMIC_ACQUIRE, "agent");
            asm volatile("s_waitcnt vmcnt(0)" ::: "memory");
        }
#if !defined(BROKEN_HOOK_NO_BARRIER)
        asm volatile("" ::: "memory"); __builtin_amdgcn_s_barrier(); asm volatile("" ::: "memory");
#endif
    }
};

__device__ __forceinline__ unsigned cvt_pk_bf16(float lo, float hi) { unsigned r; asm volatile("v_cvt_pk_bf16_f32 %0, %1, %2" : "=v"(r) : "v"(lo), "v"(hi)); return r; }
typedef float f32x2 __attribute__((ext_vector_type(2)));
__device__ __forceinline__ f32x2 gelu_pk(f32x2 v) {
    const f32x2 av = __builtin_elementwise_abs(v), d = av * 0.2316418882f + 1.0f;
    f32x2 t; t.x = __builtin_amdgcn_rcpf(d.x); t.y = __builtin_amdgcn_rcpf(d.y);
    f32x2 q = t * 0.5307027145f + (-0.7265760135f); q = q * t + 0.7107068705f; q = q * t + (-0.142248368f); q = q * t + 0.127414796f; q = q * t;
    const f32x2 s = (v * v) * (-0.72134752044f);
    f32x2 e; e.x = __builtin_amdgcn_exp2f(s.x); e.y = __builtin_amdgcn_exp2f(s.y);
    const f32x2 m = v * (q * e), r = v - m;
    f32x2 o; o.x = v.x < 0.f ? m.x : r.x; o.y = v.y < 0.f ? m.y : r.y; return o;
}

struct EpiF32 {
    static constexpr bool PERM = false, AFTER_DRAIN = false;
    float* C; int ldc; const float* bias;
    __device__ __forceinline__ void operator()(const f32x4 (&acc)[2][2][4][2], const Unit& u, int wr, int wc, int fr, int fq) const {
        const int row0 = u.pm * BM + wr * 64 + fr, col0 = u.pn * BM + wc * 32 + 4 * fq;
        f32x4 bv[2][2];
#pragma unroll
        for (int bj = 0; bj < 2; ++bj)
#pragma unroll
            for (int n = 0; n < 2; ++n) bv[bj][n] = bias ? *(const f32x4*)(bias + col0 + bj * HALF + n * 16) : (f32x4){0.f, 0.f, 0.f, 0.f};
#pragma unroll
        for (int ai = 0; ai < 2; ++ai)
#pragma unroll
            for (int m = 0; m < 4; ++m) { float* rowp = C + (size_t)(row0 + ai * HALF + m * 16) * ldc + col0;
#pragma unroll
                for (int bj = 0; bj < 2; ++bj)
#pragma unroll
                    for (int n = 0; n < 2; ++n) *(f32x4*)(rowp + bj * HALF + n * 16) = acc[ai][bj][m][n] + bv[bj][n]; }
    }
};
template <int ACT  > struct EpiBf16 {
    static constexpr bool PERM = true, AFTER_DRAIN = false;
    bf16_t* O; int ldc; const float* bias; int split_cols; size_t split_stride;
    __device__ __forceinline__ void operator()(const f32x4 (&acc)[2][2][4][2], const Unit& u, int wr, int wc, int fr, int fq) const {
        const int row0 = u.pm * BM + wr * 64 + fr; int colt = u.pn * BM; bf16_t* base = O;
        if (split_cols) { const int t = colt / split_cols; base += (size_t)t * split_stride; colt -= t * split_cols; }
        const int col0 = colt + wc * 32 + 8 * fq, bcol0 = u.pn * BM + wc * 32 + 8 * fq;
        f32x4 bv[2][2];
#pragma unroll
        for (int bj = 0; bj < 2; ++bj)
#pragma unroll
            for (int n = 0; n < 2; ++n) bv[bj][n] = bias ? *(const f32x4*)(bias + bcol0 + bj * HALF + 4 * n) : (f32x4){0.f, 0.f, 0.f, 0.f};
#pragma unroll
        for (int ai = 0; ai < 2; ++ai)
#pragma unroll
            for (int m = 0; m < 4; ++m) { bf16_t* rowp = base + (size_t)(row0 + ai * HALF + m * 16) * ldc + col0;
#pragma unroll
                for (int bj = 0; bj < 2; ++bj) { f32x4 v0 = acc[ai][bj][m][0] + bv[bj][0], v1 = acc[ai][bj][m][1] + bv[bj][1];
                    if (ACT == 1) { f32x2 a = gelu_pk((f32x2){v0[0], v0[1]}), b = gelu_pk((f32x2){v0[2], v0[3]}), c = gelu_pk((f32x2){v1[0], v1[1]}), d = gelu_pk((f32x2){v1[2], v1[3]});
                        v0 = (f32x4){a.x, a.y, b.x, b.y}; v1 = (f32x4){c.x, c.y, d.x, d.y}; }
                    if (ACT == 2) {
#pragma unroll
                        for (int j = 0; j < 4; ++j) { v0[j] = 0.5f * v0[j] * (1.0f + erff(v0[j] * 0.70710678f)); v1[j] = 0.5f * v1[j] * (1.0f + erff(v1[j] * 0.70710678f)); } }
                    u32x4 w; w.x = cvt_pk_bf16(v0[0], v0[1]); w.y = cvt_pk_bf16(v0[2], v0[3]); w.z = cvt_pk_bf16(v1[0], v1[1]); w.w = cvt_pk_bf16(v1[2], v1[3]);
                    *(u32x4*)(rowp + bj * HALF) = w; } }
    }
};

struct PanelStats {
    unsigned* xbuf;
    unsigned* cnt;
    unsigned* tmo;
    int ntn; float eps;
    unsigned code;
    __device__ __forceinline__ bool run(const f32x4 (&v)[2][2][4][2], const Unit& u, int wr, int wc, int fr, int fq, PG8_LAS unsigned char* lds, int wid, int lane) const {
        typedef float f32x2v __attribute__((ext_vector_type(2)));
        PG8_LAS f32x2v* P = (PG8_LAS f32x2v*)lds;
        PG8_LAS f32x2v* S = (PG8_LAS f32x2v*)(lds + 8192);
        PG8_LAS unsigned* flag = (PG8_LAS unsigned*)(lds + 8192 + 2048);
#pragma unroll
        for (int ai = 0; ai < 2; ++ai)
#pragma unroll
            for (int m = 0; m < 4; ++m) {
                float s = 0.f;
#pragma unroll
                for (int bj = 0; bj < 2; ++bj)
#pragma unroll
                    for (int n = 0; n < 2; ++n) { const f32x4 x = v[ai][bj][m][n]; s += (x[0] + x[1]) + (x[2] + x[3]); }
                s += __shfl_xor(s, 16); s += __shfl_xor(s, 32);
                const float mw = s * (1.0f / 64.0f); float q = 0.f;
#pragma unroll
                for (int bj = 0; bj < 2; ++bj)
#pragma unroll
                    for (int n = 0; n < 2; ++n) { const f32x4 d = v[ai][bj][m][n] - mw; q += (d[0] * d[0] + d[1] * d[1]) + (d[2] * d[2] + d[3] * d[3]); }
                q += __shfl_xor(q, 16); q += __shfl_xor(q, 32);
                if (fq == 0) P[(ai * HALF + wr * 64 + m * 16 + fr) * 4 + wc] = (f32x2v){mw, q};
            }
        asm volatile("s_waitcnt lgkmcnt(0)" ::: "memory"); __builtin_amdgcn_s_barrier(); asm volatile("" ::: "memory");
#if defined(BROKEN_NO_WAIT)
        if (blockIdx.x >= 64) { const long long t0 = clock64(); while (clock64() - t0 < 60000) __builtin_amdgcn_s_sleep(8); }
#endif
        const int row = wid * 32 + (lane & 31);
        if (lane < 32) {
            const f32x2v a = P[row * 4 + 0], b = P[row * 4 + 1], c = P[row * 4 + 2], d = P[row * 4 + 3];
            const float mt = (a.x + b.x + c.x + d.x) * 0.25f;
            const float da = a.x - mt, db = b.x - mt, dc = c.x - mt, dd = d.x - mt;
            const float m2 = (a.y + b.y) + (c.y + d.y) + 64.0f * ((da * da + db * db) + (dc * dc + dd * dd));
            unsigned long long* slot = (unsigned long long*)xbuf + ((size_t)(u.pm * BM + row) * 4 + u.pn);
            __hip_atomic_store(slot, ((unsigned long long)__float_as_uint(m2) << 32) | __float_as_uint(mt), __ATOMIC_RELAXED, __HIP_MEMORY_SCOPE_AGENT);
        }
        asm volatile("s_waitcnt vmcnt(0)" ::: "memory");
        if (lane == 0) __hip_atomic_fetch_add(cnt + 64 * u.pm, 1u, __ATOMIC_RELAXED, __HIP_MEMORY_SCOPE_AGENT);
        if (wid == 0) {
            bool dead = false; const unsigned long long t0 = __builtin_amdgcn_s_memrealtime(); const unsigned want = 8u * (unsigned)ntn;
            for (;;) {
#if defined(BROKEN_NO_WAIT)
                break;
#endif
                if ((unsigned)__builtin_amdgcn_readfirstlane(__hip_atomic_load(cnt + 64 * u.pm, __ATOMIC_RELAXED, __HIP_MEMORY_SCOPE_AGENT)) >= want) break;
                if (__builtin_amdgcn_s_memrealtime() - t0 > 2000000ull) {
                    if (lane == 0) { unsigned expect = 0u; __hip_atomic_compare_exchange_strong(tmo + 1, &expect, code | (unsigned)(u.pm & 0xff), __ATOMIC_RELAXED, __ATOMIC_RELAXED, __HIP_MEMORY_SCOPE_AGENT);
                                     __hip_atomic_store(tmo, 1u, __ATOMIC_RELAXED, __HIP_MEMORY_SCOPE_AGENT); }
                    dead = true; break; }
                __builtin_amdgcn_s_sleep(2);
            }
            __builtin_amdgcn_fence(__ATOMIC_ACQUIRE, "agent");
            if (lane == 0) flag[0] = dead ? 1u : 0u;
        }
        asm volatile("s_waitcnt vmcnt(0) lgkmcnt(0)" ::: "memory"); __builtin_amdgcn_s_barrier(); asm volatile("" ::: "memory");
        const bool bad = flag[0] != 0u;
        if (lane < 32) {
            const unsigned long long* slot = (const unsigned long long*)xbuf + (size_t)(u.pm * BM + row) * 4; float mt[4], m2[4]; float ms = 0.f;
#pragma unroll
            for (int t = 0; t < 4; ++t) { if (t < ntn) { const unsigned long long w = __hip_atomic_load(slot + t, __ATOMIC_RELAXED, __HIP_MEMORY_SCOPE_AGENT); mt[t] = __uint_as_float((unsigned)w); m2[t] = __uint_as_float((unsigned)(w >> 32)); } else { mt[t] = 0.f; m2[t] = 0.f; } ms += mt[t]; }
            const float mean = ms / (float)ntn; float q = 0.f;
#pragma unroll
            for (int t = 0; t < 4; ++t) if (t < ntn) { const float dm = mt[t] - mean; q += m2[t] + 256.0f * dm * dm; }
            S[row] = (f32x2v){mean, 1.0f / sqrtf(q / (256.0f * (float)ntn) + eps)};
        }
        asm volatile("s_waitcnt lgkmcnt(0)" ::: "memory"); __builtin_amdgcn_s_barrier(); asm volatile("" ::: "memory");
        return bad;
    }
};
struct EpiLnRes {
    static constexpr bool PERM = false, AFTER_DRAIN = true;
    const float* base; float* out; int ldc; const float* bias; PanelStats st; unsigned poison;
    __device__ __forceinline__ void refuse(size_t i0, size_t stride, int M, int N) const { const float q = __builtin_nanf(""); for (size_t i = i0; i < (size_t)M * N; i += stride) out[(i / N) * ldc + i % N] = q;
        if (i0 == 0) { unsigned expect = 0u; __hip_atomic_compare_exchange_strong(st.tmo + 1, &expect, 0x7f0u, __ATOMIC_RELAXED, __ATOMIC_RELAXED, __HIP_MEMORY_SCOPE_AGENT); __hip_atomic_store(st.tmo, 1u, __ATOMIC_RELAXED, __HIP_MEMORY_SCOPE_AGENT); } }
    __device__ __forceinline__ void fused(f32x4 (&acc)[2][2][4][2], const Unit& u, int wr, int wc, int fr, int fq, PG8_LAS unsigned char* lds, int wid, int lane) const {
        typedef float f32x2v __attribute__((ext_vector_type(2)));
        const PG8_LAS f32x2v* S = (const PG8_LAS f32x2v*)(lds + 8192);
        const int col0 = u.pn * BM + wc * 32 + 4 * fq;
#pragma unroll
        for (int bj = 0; bj < 2; ++bj)
#pragma unroll
            for (int n = 0; n < 2; ++n) { const f32x4 bv = bias ? *(const f32x4*)(bias + col0 + bj * HALF + n * 16) : (f32x4){0.f, 0.f, 0.f, 0.f};
#pragma unroll
                for (int ai = 0; ai < 2; ++ai)
#pragma unroll
                    for (int m = 0; m < 4; ++m) acc[ai][bj][m][n] += bv; }
        const bool bad = st.run(acc, u, wr, wc, fr, fq, lds, wid, lane) || poison != 0u;
        const float qnan = __builtin_nanf("");
#pragma unroll
        for (int ai = 0; ai < 2; ++ai)
#pragma unroll
            for (int m = 0; m < 4; ++m) { const int r = ai * HALF + wr * 64 + m * 16 + fr; const f32x2v sr = S[r]; const size_t off = (size_t)(u.pm * BM + r) * ldc + col0;
#pragma unroll
                for (int bj = 0; bj < 2; ++bj)
#pragma unroll
                    for (int n = 0; n < 2; ++n) { const f32x4 bs = *(const f32x4*)(base + off + bj * HALF + n * 16); f32x4 o = bs + (acc[ai][bj][m][n] - sr.x) * sr.y;
                        if (bad) o = (f32x4){qnan, qnan, qnan, qnan}; *(f32x4*)(out + off + bj * HALF + n * 16) = o; }
                asm volatile("" ::: "memory"); }
    }
};
struct EpiLnResLn {
    static constexpr bool PERM = false, AFTER_DRAIN = true;
    const float* base; float* out; bf16_t* xn; int ldc; const float* bias; PanelStats st1, st2; unsigned poison;
    __device__ __forceinline__ void refuse(size_t i0, size_t stride, int M, int N) const { const float q = __builtin_nanf(""); for (size_t i = i0; i < (size_t)M * N; i += stride) { const size_t o = (i / N) * ldc + i % N; out[o] = q; xn[o] = (bf16_t)0x7fc0u; }
        if (i0 == 0) { unsigned expect = 0u; __hip_atomic_compare_exchange_strong(st1.tmo + 1, &expect, 0x7f0u, __ATOMIC_RELAXED, __ATOMIC_RELAXED, __HIP_MEMORY_SCOPE_AGENT); __hip_atomic_store(st1.tmo, 1u, __ATOMIC_RELAXED, __HIP_MEMORY_SCOPE_AGENT); } }
    __device__ __forceinline__ void fused(f32x4 (&acc)[2][2][4][2], const Unit& u, int wr, int wc, int fr, int fq, PG8_LAS unsigned char* lds, int wid, int lane) const {
        typedef float f32x2v __attribute__((ext_vector_type(2))); typedef unsigned u32x2v __attribute__((ext_vector_type(2)));
        const PG8_LAS f32x2v* S = (const PG8_LAS f32x2v*)(lds + 8192);
        const int col0 = u.pn * BM + wc * 32 + 4 * fq;
#pragma unroll
        for (int bj = 0; bj < 2; ++bj)
#pragma unroll
            for (int n = 0; n < 2; ++n) { const f32x4 bv = bias ? *(const f32x4*)(bias + col0 + bj * HALF + n * 16) : (f32x4){0.f, 0.f, 0.f, 0.f};
#pragma unroll
                for (int ai = 0; ai < 2; ++ai)
#pragma unroll
                    for (int m = 0; m < 4; ++m) acc[ai][bj][m][n] += bv; }
        bool bad = st1.run(acc, u, wr, wc, fr, fq, lds, wid, lane) || poison != 0u;
        const float qnan = __builtin_nanf("");
#pragma unroll
        for (int ai = 0; ai < 2; ++ai)
#pragma unroll
            for (int m = 0; m < 4; ++m) { const int r = ai * HALF + wr * 64 + m * 16 + fr; const f32x2v sr = S[r]; const size_t off = (size_t)(u.pm * BM + r) * ldc + col0;
#pragma unroll
                for (int bj = 0; bj < 2; ++bj)
#pragma unroll
                    for (int n = 0; n < 2; ++n) { const f32x4 bs = *(const f32x4*)(base + off + bj * HALF + n * 16); acc[ai][bj][m][n] = bs + (acc[ai][bj][m][n] - sr.x) * sr.y; }
                asm volatile("" : "+v"(acc[ai][0][m][0]), "+v"(acc[ai][0][m][1]), "+v"(acc[ai][1][m][0]), "+v"(acc[ai][1][m][1]));
                if (m & 1) asm volatile("" ::: "memory"); }
        const bool bad1 = bad;
        bad = st2.run(acc, u, wr, wc, fr, fq, lds, wid, lane) || bad;
#pragma unroll
        for (int ai = 0; ai < 2; ++ai)
#pragma unroll
            for (int m = 0; m < 4; ++m) { const int r = ai * HALF + wr * 64 + m * 16 + fr; const f32x2v sr = S[r]; const size_t off = (size_t)(u.pm * BM + r) * ldc + col0;
#pragma unroll
                for (int bj = 0; bj < 2; ++bj)
#pragma unroll
                    for (int n = 0; n < 2; ++n) { const f32x4 x1 = acc[ai][bj][m][n]; *(f32x4*)(out + off + bj * HALF + n * 16) = bad1 ? (f32x4){qnan, qnan, qnan, qnan} : x1;
                        const f32x4 o = (x1 - sr.x) * sr.y; u32x2v w; w.x = cvt_pk_bf16(o[0], o[1]); w.y = cvt_pk_bf16(o[2], o[3]);
                        if (bad) { w.x = 0x7fc07fc0u; w.y = 0x7fc07fc0u; } *(u32x2v*)(xn + off + bj * HALF + n * 16) = w; }
                asm volatile("" ::: "memory"); }
    }
};

template <class Epi, class Sched, bool ALIGN_EPI = false, bool SP2 = false>
__device__ __forceinline__ void gemm_phase(PG8_LAS unsigned char* lds, const Gemm g, const Sched& S, const Epi& E) {
    int tid = threadIdx.x; asm volatile("" : "+v"(tid));
    const int wid = __builtin_amdgcn_readfirstlane(tid >> 6), lane = tid & 63, wr = wid >> 2, wc = wid & 3, fr = lane & 15, fq = lane >> 4;
    const int K = g.K, nt = K / BK;
    unsigned voffA[2], voffB[2];
#pragma unroll
    for (int i = 0; i < 2; ++i) { int R, C; stage_rc(tid * 16 + i * 8192, R, C); const int Rb = Epi::PERM ? ((R & ~31) + perm32(R & 31)) : R;
        voffA[i] = (unsigned)(R * K + C) * 2u; voffB[i] = (unsigned)(Rb * K + C) * 2u; }
    const size_t kstep = (size_t)(BK * 2);
    const size_t hstep = (size_t)HALF * K * 2;
    const size_t tstep = 2 * hstep;
    const unsigned ldsw = (unsigned)wid * 1024u;
    const int aoff = lds_byte(wr * 64 + fr, fq * 8), boff = lds_byte(wc * 32 + fr, fq * 8);
#define PG8_SA(b, h) (((b) * 2 + (h)) * HTB)
#define PG8_SB(b, h) ((4 + (b) * 2 + (h)) * HTB)
#define PG8_STAGE(bufoff, gbase, voff) do { _Pragma("unroll") for (int _i = 0; _i < 2; ++_i) \
        __builtin_amdgcn_global_load_lds((const unsigned*)((const char*)(gbase) + (voff)[_i]), (PG8_LAS unsigned*)(lds + (bufoff) + ldsw + _i * 8192), 16, 0, 0); } while (0)
#define PG8_LDA(dst, b, h) do { _Pragma("unroll") for (int m = 0; m < 4; ++m) _Pragma("unroll") for (int k = 0; k < 2; ++k) dst[m][k] = *(const PG8_LAS bf16x8*)(lds + PG8_SA(b, h) + aoff + m * 2048 + k * 1024); } while (0)
#define PG8_LDB(dst, b, h) do { _Pragma("unroll") for (int n = 0; n < 2; ++n) _Pragma("unroll") for (int k = 0; k < 2; ++k) dst[n][k] = *(const PG8_LAS bf16x8*)(lds + PG8_SB(b, h) + boff + n * 2048 + k * 1024); } while (0)
#define PG8_MMA(ai, bj, At, Bt) do { __builtin_amdgcn_s_setprio(1); _Pragma("unroll") for (int m = 0; m < 4; ++m) _Pragma("unroll") for (int n = 0; n < 2; ++n) _Pragma("unroll") for (int k = 0; k < 2; ++k) \
        acc[ai][bj][m][n] = __builtin_amdgcn_mfma_f32_16x16x32_bf16(Bt[n][k], At[m][k], acc[ai][bj][m][n], 0, 0, 0); __builtin_amdgcn_s_setprio(0); } while (0)
#define PG8_WAIT_V(n) asm volatile("s_waitcnt vmcnt(" #n ")" ::: "memory")
#define PG8_WAIT_L(n) asm volatile("s_waitcnt lgkmcnt(" #n ")" ::: "memory")
#define PG8_BAR __builtin_amdgcn_s_barrier()
#define PG8_SCHED __builtin_amdgcn_sched_barrier(0)
    Unit cur, nxt; int ui = 0;
    if (!S.next(0, cur)) return;
    f32x4 acc[2][2][4][2];
#pragma unroll
    for (int a = 0; a < 2; ++a)
#pragma unroll
        for (int b = 0; b < 2; ++b)
#pragma unroll
            for (int m = 0; m < 4; ++m)
#pragma unroll
                for (int n = 0; n < 2; ++n) acc[a][b][m][n] = (f32x4){0.f, 0.f, 0.f, 0.f};
    bf16x8 At[4][2], B0[2][2], B1[2][2];
    const char* cA = (const char*)g.A + (size_t)cur.pm * tstep; const char* cB = (const char*)g.Bt + (size_t)cur.pn * tstep;
    S.a_ready(cur);
    if constexpr (SP2) {
        PG8_STAGE(PG8_SB(0, 0), cB, voffB); PG8_STAGE(PG8_SB(0, 1), cB + hstep, voffB); PG8_STAGE(PG8_SA(0, 0), cA, voffA); PG8_STAGE(PG8_SA(0, 1), cA + hstep, voffA);
        if (wr == 1) PG8_BAR;
        PG8_WAIT_V(2); PG8_BAR;
        PG8_STAGE(PG8_SB(1, 0), cB + kstep, voffB); PG8_STAGE(PG8_SA(1, 0), cA + kstep, voffA); PG8_STAGE(PG8_SB(1, 1), cB + hstep + kstep, voffB);
        PG8_WAIT_V(6); PG8_BAR;
    } else {
        PG8_STAGE(PG8_SB(0, 0), cB, voffB); PG8_STAGE(PG8_SA(0, 0), cA, voffA); PG8_STAGE(PG8_SB(0, 1), cB + hstep, voffB); PG8_STAGE(PG8_SA(0, 1), cA + hstep, voffA);
        if (wr == 1) PG8_BAR;
        PG8_WAIT_V(4); PG8_BAR;
        PG8_STAGE(PG8_SB(1, 0), cB + kstep, voffB); PG8_STAGE(PG8_SA(1, 0), cA + kstep, voffA); PG8_STAGE(PG8_SB(1, 1), cB + hstep + kstep, voffB);
        PG8_WAIT_V(6); PG8_BAR;
    }
    for (;;) {
        const bool has_next = S.next(ui + 1, nxt);
        const char* nA = has_next ? (const char*)g.A + (size_t)nxt.pm * tstep : cA; const char* nB = has_next ? (const char*)g.Bt + (size_t)nxt.pn * tstep : cB;
        for (int t = 0; t < nt; t += 2) {
            const bool last = (t == nt - 2);
            const char* a1 = cA + (size_t)(t + 1) * kstep;
            const char* a2 = last ? nA : cA + (size_t)(t + 2) * kstep; const char* b2 = last ? nB : cB + (size_t)(t + 2) * kstep;
            const char* a3 = a2 + kstep; const char* b3 = b2 + kstep;
            if (last && has_next) S.a_ready(nxt);
            if constexpr (SP2) {
            PG8_LDB(B0, 0, 0); PG8_LDB(B1, 0, 1); PG8_SCHED; PG8_LDA(At, 0, 0); PG8_STAGE(PG8_SA(1, 1), a1 + hstep, voffA);
            PG8_WAIT_V(8); PG8_WAIT_L(0); PG8_BAR; PG8_MMA(0, 0, At, B0); PG8_MMA(0, 1, At, B1); PG8_BAR; PG8_SCHED;
            PG8_LDA(At, 0, 1); PG8_STAGE(PG8_SB(0, 0), b2, voffB); PG8_STAGE(PG8_SB(0, 1), b2 + hstep, voffB); PG8_STAGE(PG8_SA(0, 0), a2, voffA);
            PG8_WAIT_V(8); PG8_WAIT_L(0); PG8_BAR; PG8_MMA(1, 0, At, B0); PG8_MMA(1, 1, At, B1); PG8_BAR; PG8_SCHED;
            PG8_LDB(B0, 1, 0); PG8_LDB(B1, 1, 1); PG8_SCHED; PG8_LDA(At, 1, 0); PG8_STAGE(PG8_SA(0, 1), a2 + hstep, voffA);
            PG8_WAIT_V(8); PG8_WAIT_L(0); PG8_BAR; PG8_MMA(0, 0, At, B0); PG8_MMA(0, 1, At, B1); PG8_BAR; PG8_SCHED;
            PG8_LDA(At, 1, 1); PG8_STAGE(PG8_SB(1, 0), b3, voffB); PG8_STAGE(PG8_SB(1, 1), b3 + hstep, voffB); PG8_STAGE(PG8_SA(1, 0), a3, voffA);
            PG8_WAIT_V(8); PG8_WAIT_L(0); PG8_BAR; PG8_MMA(1, 0, At, B0); PG8_MMA(1, 1, At, B1); PG8_BAR; PG8_SCHED;
            } else {
            PG8_LDB(B0, 0, 0); PG8_SCHED; PG8_LDA(At, 0, 0); PG8_STAGE(PG8_SA(1, 1), a1 + hstep, voffA);
            PG8_WAIT_L(8); PG8_BAR; PG8_WAIT_L(0); PG8_MMA(0, 0, At, B0); PG8_BAR; PG8_SCHED;
            PG8_LDB(B1, 0, 1); PG8_STAGE(PG8_SB(0, 0), b2, voffB);
            PG8_BAR; PG8_WAIT_L(0); PG8_MMA(0, 1, At, B1); PG8_BAR;
            PG8_LDA(At, 0, 1); PG8_STAGE(PG8_SA(0, 0), a2, voffA);
            PG8_BAR; PG8_WAIT_L(0); PG8_MMA(1, 0, At, B0); PG8_BAR; PG8_SCHED;
            PG8_STAGE(PG8_SB(0, 1), b2 + hstep, voffB);
            PG8_WAIT_V(6); PG8_BAR; PG8_MMA(1, 1, At, B1); PG8_BAR;
            PG8_LDB(B0, 1, 0); PG8_SCHED; PG8_LDA(At, 1, 0); PG8_STAGE(PG8_SA(0, 1), a2 + hstep, voffA);
            PG8_WAIT_L(8); PG8_BAR; PG8_WAIT_L(0); PG8_MMA(0, 0, At, B0); PG8_BAR; PG8_SCHED;
            PG8_LDB(B1, 1, 1); PG8_STAGE(PG8_SB(1, 0), b3, voffB);
            PG8_BAR; PG8_WAIT_L(0); PG8_MMA(0, 1, At, B1); PG8_BAR;
            PG8_LDA(At, 1, 1); PG8_STAGE(PG8_SA(1, 0), a3, voffA);
            PG8_BAR; PG8_WAIT_L(0); PG8_MMA(1, 0, At, B0); PG8_BAR; PG8_SCHED;
            PG8_STAGE(PG8_SB(1, 1), b3 + hstep, voffB);
            PG8_WAIT_V(6); PG8_BAR; PG8_MMA(1, 1, At, B1); PG8_BAR;
            }
        }
        if constexpr (ALIGN_EPI) { if (wr == 0) PG8_BAR; }
        if constexpr (!Epi::AFTER_DRAIN) { E(acc, cur, wr, wc, fr, fq); S.done(cur); }
        if (!has_next) break;
#pragma unroll
        for (int a = 0; a < 2; ++a)
#pragma unroll
            for (int b = 0; b < 2; ++b)
#pragma unroll
                for (int m = 0; m < 4; ++m)
#pragma unroll
                    for (int n = 0; n < 2; ++n) acc[a][b][m][n] = (f32x4){0.f, 0.f, 0.f, 0.f};
        cur = nxt; cA = nA; cB = nB; ++ui;
        if constexpr (ALIGN_EPI) { if (wr == 1) PG8_BAR; }
    }
    PG8_WAIT_V(0);
    if constexpr (!ALIGN_EPI) { if (wr == 0) PG8_BAR; }
    PG8_BAR;
    if constexpr (Epi::AFTER_DRAIN) { E.fused(acc, cur, wr, wc, fr, fq, lds, wid, lane); S.done(cur); }
#undef PG8_SA
#undef PG8_SB
#undef PG8_STAGE
#undef PG8_LDA
#undef PG8_LDB
#undef PG8_MMA
#undef PG8_WAIT_V
#undef PG8_WAIT_L
#undef PG8_BAR
#undef PG8_SCHED
}
}
namespace pg8 {
__device__ __forceinline__ float bflo(unsigned w) { return __uint_as_float(w << 16); }
__device__ __forceinline__ float bfhi(unsigned w) { return __uint_as_float(w & 0xffff0000u); }
struct EpiResF32 {
    static constexpr bool PERM = true, AFTER_DRAIN = false;
    float* C; const bf16_t* R; int ldc; float alpha;
    __device__ __forceinline__ void operator()(const f32x4 (&acc)[2][2][4][2], const Unit& u, int wr, int wc, int fr, int fq) const {
        const int row0 = u.pm * BM + wr * 64 + fr, col0 = u.pn * BM + wc * 32 + 8 * fq;
        u32x4 r[2][4][2];
#pragma unroll
        for (int ai = 0; ai < 2; ++ai)
#pragma unroll
            for (int m = 0; m < 4; ++m)
#pragma unroll
                for (int bj = 0; bj < 2; ++bj) r[ai][m][bj] = *(const u32x4*)(R + (size_t)(row0 + ai * HALF + m * 16) * ldc + col0 + bj * HALF);
#pragma unroll
        for (int ai = 0; ai < 2; ++ai)
#pragma unroll
            for (int m = 0; m < 4; ++m) { const size_t off = (size_t)(row0 + ai * HALF + m * 16) * ldc + col0;
#pragma unroll
                for (int bj = 0; bj < 2; ++bj) { const u32x4 rr = r[ai][m][bj];
                    f32x4 v0 = acc[ai][bj][m][0], v1 = acc[ai][bj][m][1];
                    v0[0] += alpha * bflo(rr.x); v0[1] += alpha * bfhi(rr.x); v0[2] += alpha * bflo(rr.y); v0[3] += alpha * bfhi(rr.y);
                    v1[0] += alpha * bflo(rr.z); v1[1] += alpha * bfhi(rr.z); v1[2] += alpha * bflo(rr.w); v1[3] += alpha * bfhi(rr.w);
                    *(f32x4*)(C + off + bj * HALF) = v0; *(f32x4*)(C + off + bj * HALF + 4) = v1; } }
    }
};
struct EpiResBf16 {
    static constexpr bool PERM = true, AFTER_DRAIN = false;
    bf16_t* C; const bf16_t* R; int ldc; float alpha;
    __device__ __forceinline__ void operator()(const f32x4 (&acc)[2][2][4][2], const Unit& u, int wr, int wc, int fr, int fq) const {
        const int row0 = u.pm * BM + wr * 64 + fr, col0 = u.pn * BM + wc * 32 + 8 * fq;
        u32x4 r[2][4][2];
#pragma unroll
        for (int ai = 0; ai < 2; ++ai)
#pragma unroll
            for (int m = 0; m < 4; ++m)
#pragma unroll
                for (int bj = 0; bj < 2; ++bj) r[ai][m][bj] = *(const u32x4*)(R + (size_t)(row0 + ai * HALF + m * 16) * ldc + col0 + bj * HALF);
#pragma unroll
        for (int ai = 0; ai < 2; ++ai)
#pragma unroll
            for (int m = 0; m < 4; ++m) { const size_t off = (size_t)(row0 + ai * HALF + m * 16) * ldc + col0;
#pragma unroll
                for (int bj = 0; bj < 2; ++bj) { const u32x4 rr = r[ai][m][bj];
                    const f32x4 v0 = acc[ai][bj][m][0], v1 = acc[ai][bj][m][1];
                    u32x4 w; w.x = cvt_pk_bf16(v0[0] + alpha * bflo(rr.x), v0[1] + alpha * bfhi(rr.x)); w.y = cvt_pk_bf16(v0[2] + alpha * bflo(rr.y), v0[3] + alpha * bfhi(rr.y));
                    w.z = cvt_pk_bf16(v1[0] + alpha * bflo(rr.z), v1[1] + alpha * bfhi(rr.z)); w.w = cvt_pk_bf16(v1[2] + alpha * bflo(rr.w), v1[3] + alpha * bfhi(rr.w));
                    *(u32x4*)(C + off + bj * HALF) = w; } }
    }
};
struct EpiHc {
    static constexpr bool PERM = false, AFTER_DRAIN = false;
    float* C; int ldc;
    __device__ __forceinline__ void operator()(const f32x4 (&acc)[2][2][4][2], const Unit& u, int wr, int wc, int fr, int fq) const {
        const int row0 = u.pm * BM + wr * 64 + fr, col0 = u.pn * BM + wc * 32 + 4 * fq;
        const float dmin = -3.0701134573253946f, dmax = -15.350567286626973f, dstep = (dmax - dmin) / 1023.0f;
#pragma unroll
        for (int bj = 0; bj < 2; ++bj)
#pragma unroll
            for (int n = 0; n < 2; ++n) {
                f32x4 tl;
#pragma unroll
                for (int e = 0; e < 4; ++e) { const int g = col0 + bj * HALF + n * 16 + e; const bool lp = g < 8192; const int t = lp ? g : g - 8192;
                    tl[e] = -1.4426950408889634f * (float)t * (lp ? (1.0f / 8191.0f) : (1.0f / 4095.0f)); }
#pragma unroll
                for (int ai = 0; ai < 2; ++ai)
#pragma unroll
                    for (int m = 0; m < 4; ++m) { const int j = row0 + ai * HALF + m * 16; const float delta = __builtin_fabsf(dmin + (float)(j & 1023) * dstep);
                        f32x4 o;
#pragma unroll
                        for (int e = 0; e < 4; ++e) o[e] = acc[ai][bj][m][n][e] * __builtin_amdgcn_exp2f(tl[e] * delta);
                        *(f32x4*)(C + (size_t)j * ldc + col0 + bj * HALF + n * 16) = o; }
            }
    }
};
struct EpiSwiGLU {
    static constexpr bool PERM = true, AFTER_DRAIN = false;
    bf16_t* O; int ldc;
    __device__ __forceinline__ static float silu_mul(float g, float u) { return g * u * __builtin_amdgcn_rcpf(1.0f + __builtin_amdgcn_exp2f(-1.4426950408889634f * g)); }
    __device__ __forceinline__ void operator()(const f32x4 (&acc)[2][2][4][2], const Unit& u, int wr, int wc, int fr, int fq) const {
        const int row0 = u.pm * BM + wr * 64 + fr, col0 = u.pn * HALF + wc * 32 + 8 * fq;
#pragma unroll
        for (int ai = 0; ai < 2; ++ai)
#pragma unroll
            for (int m = 0; m < 4; ++m) { bf16_t* rowp = O + (size_t)(row0 + ai * HALF + m * 16) * ldc + col0;
                const f32x4 g0 = acc[ai][0][m][0], g1 = acc[ai][0][m][1], u0 = acc[ai][1][m][0], u1 = acc[ai][1][m][1];
                u32x4 w; w.x = cvt_pk_bf16(silu_mul(g0[0], u0[0]), silu_mul(g0[1], u0[1])); w.y = cvt_pk_bf16(silu_mul(g0[2], u0[2]), silu_mul(g0[3], u0[3]));
                w.z = cvt_pk_bf16(silu_mul(g1[0], u1[0]), silu_mul(g1[1], u1[1])); w.w = cvt_pk_bf16(silu_mul(g1[2], u1[2]), silu_mul(g1[3], u1[3]));
                __builtin_nontemporal_store(w, (u32x4*)rowp); }
    }
};
}
#define XB_TMO      128
#define XB_XCNT(j)  (256  + 64 * (j))
#define XB_XSUB(j)  (1280 + 64 * (j))
#define XB_XGEN(j)  (2304 + 64 * (j))
#define XB_TOP      3328
#define XB_TOPGEN   3392
#define XCD_BAR_WORDS 3456
#define XB_SPIN_CAP (1u << 18)
#define LAS __attribute__((address_space(3)))

__device__ __forceinline__ unsigned xb_ld(unsigned* p)              { return __hip_atomic_load(p, __ATOMIC_RELAXED, __HIP_MEMORY_SCOPE_AGENT); }
__device__ __forceinline__ unsigned xb_add(unsigned* p, unsigned v) { return __hip_atomic_fetch_add(p, v, __ATOMIC_RELAXED, __HIP_MEMORY_SCOPE_AGENT); }
__device__ __forceinline__ unsigned xb_xcc_id() { return (unsigned)__builtin_amdgcn_s_getreg((3 << 11) | 20) & 0xFu; }
#define XB_SPIN(cond, bar) do { unsigned _sp = 0; while (cond) { __builtin_amdgcn_s_sleep(1); \
    if ((++_sp & 255u) == 0u) { if (xb_ld(&(bar)[XB_TMO])) break; if (_sp > XB_SPIN_CAP) { atomicAdd(&(bar)[XB_TMO], 1u); break; } } } } while (0)

struct XcdBarrier {
    unsigned* bar; unsigned x;
    volatile LAS unsigned* st;
};

__device__ __forceinline__ XcdBarrier xcd_barrier_post(unsigned* bar, volatile LAS unsigned* st) {
    XcdBarrier b; b.bar = bar; b.x = xb_xcc_id(); b.st = st;
    if (threadIdx.x == 0) (void)xb_add(&bar[XB_XCNT(b.x)], 1u);
    return b;
}
__device__ __forceinline__ void xcd_barrier_complete(unsigned* bar, unsigned x, unsigned& nloc, unsigned& nx) {
    const unsigned G = gridDim.x * gridDim.y * gridDim.z;
    unsigned sum, cnt, mine, sp = 0u;
    for (;;) {
        sum = 0u; cnt = 0u; mine = 0u;
#pragma unroll
        for (unsigned j = 0; j < 16; ++j) { const unsigned c = xb_ld(&bar[XB_XCNT(j)]); sum += c; cnt += (c > 0u) ? 1u : 0u; mine = (j == x) ? c : mine; }
        if (sum == G) break;
        __builtin_amdgcn_s_sleep(1);
        if ((++sp & 255u) == 0u) { if (xb_ld(&bar[XB_TMO])) break; if (sp > XB_SPIN_CAP) { atomicAdd(&bar[XB_TMO], 1u); break; } }
    }
    nloc = mine > 0u ? mine : 1u; nx = cnt > 0u ? cnt : 1u;
}

__device__ __forceinline__ void xcd_barrier(const XcdBarrier& b) {
    asm volatile("s_waitcnt vmcnt(0)" ::: "memory");
    __syncthreads();
    if (threadIdx.x == 0) {
        unsigned* bar = b.bar;
        __builtin_amdgcn_s_waitcnt(0);
        unsigned nloc = b.st[0], nx = b.st[1];
        if (nloc == 0u) { xcd_barrier_complete(bar, b.x, nloc, nx); b.st[0] = nloc; b.st[1] = nx; }
        const unsigned old = xb_add(&bar[XB_XSUB(b.x)], 1u);
        const unsigned gen = old / nloc;
        if (old + 1u == (gen + 1u) * nloc) {
            __builtin_amdgcn_fence(__ATOMIC_RELEASE, "agent");
            asm volatile("s_waitcnt vmcnt(0)" ::: "memory");
            const unsigned og = xb_add(&bar[XB_TOP], 1u);
            const unsigned tg = og / nx;
            if (og + 1u == (tg + 1u) * nx) xb_add(&bar[XB_TOPGEN], 1u);
            else XB_SPIN(xb_ld(&bar[XB_TOPGEN]) == tg, bar);
            __builtin_amdgcn_fence(__ATOMIC_ACQUIRE, "agent");
            xb_add(&bar[XB_XGEN(b.x)], 1u);
            asm volatile("s_waitcnt vmcnt(0)" ::: "memory");
        } else {
            XB_SPIN(xb_ld(&bar[XB_XGEN(b.x)]) == gen, bar);
            __builtin_amdgcn_fence(__ATOMIC_ACQUIRE, "agent");
            asm volatile("s_waitcnt vmcnt(0)" ::: "memory");
        }
    }
    __syncthreads();
}

#ifndef HOST_TEST
#define FHD __device__ __forceinline__
#define SIN2PI(x) __builtin_amdgcn_sinf(x)
#define COS2PI(x) __builtin_amdgcn_cosf(x)
#define LP LAS
#else
#define FHD inline
#define SIN2PI(x) ((float)sin(6.283185307179586 * (double)(x)))
#define COS2PI(x) ((float)cos(6.283185307179586 * (double)(x)))
#define LP
#endif
typedef float cf __attribute__((ext_vector_type(2)));
FHD cf cmk(float a, float b) { cf r = {a, b}; return r; }
FHD cf cadd(cf a, cf b) { return cmk(a.x + b.x, a.y + b.y); }
FHD cf csub(cf a, cf b) { return cmk(a.x - b.x, a.y - b.y); }
#ifndef HOST_TEST
FHD cf cmul(cf a, cf b) {
    cf t, r;
    asm("v_pk_mul_f32 %0, %1, %2 op_sel:[0,0] op_sel_hi:[0,1]" : "=v"(t) : "v"(a), "v"(b));
    asm("v_pk_fma_f32 %0, %1, %2, %3 op_sel:[1,1,0] op_sel_hi:[1,0,1] neg_lo:[1,0,0]" : "=v"(r) : "v"(a), "v"(b), "v"(t));
    return r;
}
#else
FHD cf cmul(cf a, cf b) { return cmk(a.x * b.x - a.y * b.y, a.x * b.y + a.y * b.x); }
#endif
FHD int PADI(int a) { return a + (a >> 4); }
constexpr int FFT_BUF_CF = 16384 + 1024;

template <bool INV> FHD void dft2(cf& a, cf& b) { const cf s = cadd(a, b), d = csub(a, b); a = s; b = d; }
template <bool INV> FHD void dft4(cf& a, cf& b, cf& c, cf& d) {
    const cf s0 = cadd(a, c), s1 = csub(a, c), s2 = cadd(b, d), s3 = csub(b, d);
    a = cadd(s0, s2); c = csub(s0, s2);
    if (!INV) { b = cmk(s1.x + s3.y, s1.y - s3.x); d = cmk(s1.x - s3.y, s1.y + s3.x); }
    else      { b = cmk(s1.x - s3.y, s1.y + s3.x); d = cmk(s1.x + s3.y, s1.y - s3.x); }
}
#define DR16(r) (4 * ((r) & 3) + ((r) >> 2))
template <bool INV> FHD void dft16(cf (&x)[16]) {
    constexpr float C1 = 0.92387953251128674f, S1 = 0.38268343236508977f, H = 0.70710678118654752f;
#pragma unroll
    for (int k0 = 0; k0 < 4; ++k0) dft4<INV>(x[k0], x[4 + k0], x[8 + k0], x[12 + k0]);
    const float sg = INV ? 1.f : -1.f;
    const cf w1 = cmk(C1, sg * S1), w2 = cmk(H, sg * H), w3 = cmk(S1, sg * C1), w4 = cmk(0.f, sg * 1.f), w6 = cmk(-H, sg * H), w9 = cmk(-C1, -sg * S1);
    x[4 * 1 + 1] = cmul(x[4 * 1 + 1], w1); x[4 * 1 + 2] = cmul(x[4 * 1 + 2], w2); x[4 * 1 + 3] = cmul(x[4 * 1 + 3], w3);
    x[4 * 2 + 1] = cmul(x[4 * 2 + 1], w2); x[4 * 2 + 2] = cmul(x[4 * 2 + 2], w4); x[4 * 2 + 3] = cmul(x[4 * 2 + 3], w6);
    x[4 * 3 + 1] = cmul(x[4 * 3 + 1], w3); x[4 * 3 + 2] = cmul(x[4 * 3 + 2], w6); x[4 * 3 + 3] = cmul(x[4 * 3 + 3], w9);
#pragma unroll
    for (int r0 = 0; r0 < 4; ++r0) dft4<INV>(x[4 * r0], x[4 * r0 + 1], x[4 * r0 + 2], x[4 * r0 + 3]);
}
template <bool INV> FHD void twid16(cf (&w)[16], float frac) {
    float c = COS2PI(frac), s = SIN2PI(frac);
#ifndef HOST_TEST
    asm volatile("s_nop 1" : "+v"(c), "+v"(s));
#endif
    w[1] = cmk(c, INV ? s : -s);
    w[2] = cmul(w[1], w[1]); w[3] = cmul(w[2], w[1]); w[4] = cmul(w[2], w[2]); w[5] = cmul(w[4], w[1]); w[6] = cmul(w[3], w[3]); w[7] = cmul(w[4], w[3]);
    w[8] = cmul(w[4], w[4]); w[9] = cmul(w[8], w[1]); w[10] = cmul(w[5], w[5]); w[11] = cmul(w[8], w[3]); w[12] = cmul(w[6], w[6]); w[13] = cmul(w[8], w[5]);
    w[14] = cmul(w[7], w[7]); w[15] = cmul(w[8], w[7]);
}
#define STG_OFF(k, lgst) (((k) << (lgst)) + ((((k) << (lgst))) >> 4))
template <bool INV, bool NOTW, int LGS> FHD void fft_stage16(LP cf* buf, int id) {
    constexpr int lgst = LGS - 4, st = 1 << lgst; const int blk = id >> lgst, j = id & (st - 1), base = (blk << LGS) + j;
    LP cf* pb = buf + PADI(base);
    cf x[16];
#pragma unroll
    for (int k = 0; k < 16; ++k) x[k] = pb[STG_OFF(k, lgst)];
    if (!INV) {
        dft16<false>(x);
        if (!NOTW) { cf w[16]; twid16<false>(w, (float)j * (1.0f / (float)(1 << LGS)));
#pragma unroll
            for (int r = 1; r < 16; ++r) x[DR16(r)] = cmul(x[DR16(r)], w[r]); }
#pragma unroll
        for (int r = 0; r < 16; ++r) pb[STG_OFF(r, lgst)] = x[DR16(r)];
    } else {
        if (!NOTW) { cf w[16]; twid16<true>(w, (float)j * (1.0f / (float)(1 << LGS)));
#pragma unroll
            for (int r = 1; r < 16; ++r) x[r] = cmul(x[r], w[r]); }
        dft16<true>(x);
#pragma unroll
        for (int r = 0; r < 16; ++r) pb[STG_OFF(r, lgst)] = x[DR16(r)];
    }
}
template <bool INV, int LGS> FHD void fft_stage16_dual(LP cf* bufA, LP cf* bufB, int id) {
    constexpr int lgst = LGS - 4, st = 1 << lgst; const int blk = id >> lgst, j = id & (st - 1), base = (blk << LGS) + j, po = PADI(base);
    LP cf* pa = bufA + po; LP cf* pb = bufB + po;
    cf x[16], y[16];
#pragma unroll
    for (int k = 0; k < 16; ++k) { x[k] = pa[STG_OFF(k, lgst)]; y[k] = pb[STG_OFF(k, lgst)]; }
    cf w[16]; twid16<INV>(w, (float)j * (1.0f / (float)(1 << LGS)));
    if (!INV) {
        dft16<false>(x); dft16<false>(y);
#pragma unroll
        for (int r = 1; r < 16; ++r) { x[DR16(r)] = cmul(x[DR16(r)], w[r]); y[DR16(r)] = cmul(y[DR16(r)], w[r]); }
    } else {
#pragma unroll
        for (int r = 1; r < 16; ++r) { x[r] = cmul(x[r], w[r]); y[r] = cmul(y[r], w[r]); }
        dft16<true>(x); dft16<true>(y);
    }
#pragma unroll
    for (int r = 0; r < 16; ++r) { pa[STG_OFF(r, lgst)] = x[DR16(r)]; pb[STG_OFF(r, lgst)] = y[DR16(r)]; }
}
template <int RL> FHD void fft_mid(LP cf* buf, const cf* K, int id) {
    LP cf* pb = buf + PADI(RL * id);
    cf x[RL];
#pragma unroll
    for (int k = 0; k < RL; ++k) x[k] = pb[k];
    cf kk[RL];
#pragma unroll
    for (int k = 0; k < RL; ++k) kk[k] = K[RL * id + k];
    if constexpr (RL == 4) { dft4<false>(x[0], x[1], x[2], x[3]); } else { dft2<false>(x[0], x[1]); }
#pragma unroll
    for (int k = 0; k < RL; ++k) x[k] = cmul(x[k], kk[k]);
    if constexpr (RL == 4) { dft4<true>(x[0], x[1], x[2], x[3]); } else { dft2<true>(x[0], x[1]); }
#pragma unroll
    for (int k = 0; k < RL; ++k) pb[k] = x[k];
}
template <int RL> FHD void fft_mid_pre(LP cf* buf, const cf (&kk)[RL], int id) {
    LP cf* pb = buf + PADI(RL * id);
    cf x[RL];
#pragma unroll
    for (int k = 0; k < RL; ++k) x[k] = pb[k];
    if constexpr (RL == 4) { dft4<false>(x[0], x[1], x[2], x[3]); } else { dft2<false>(x[0], x[1]); }
#pragma unroll
    for (int k = 0; k < RL; ++k) x[k] = cmul(x[k], kk[k]);
    if constexpr (RL == 4) { dft4<true>(x[0], x[1], x[2], x[3]); } else { dft2<true>(x[0], x[1]); }
#pragma unroll
    for (int k = 0; k < RL; ++k) pb[k] = x[k];
}
FHD int pos_to_freq(int p, int lgN) {
    const int lgRL = lgN - 12;
    const int r1 = p >> (lgN - 4), r2 = (p >> (lgN - 8)) & 15, r3 = (p >> lgRL) & 15, r4 = p & ((1 << lgRL) - 1);
    return r1 + 16 * r2 + 256 * r3 + 4096 * r4;
}
FHD int freq_to_pos(int k, int lgN) {
    const int lgRL = lgN - 12;
    const int r1 = k & 15, r2 = (k >> 4) & 15, r3 = (k >> 8) & 15, r4 = k >> 12;
    return (r1 << (lgN - 4)) + (r2 << (lgN - 8)) + (r3 << lgRL) + r4;
}
constexpr int NT = 512;
typedef unsigned short bf16raw;
FHD float bf2f(bf16raw b) { unsigned u = ((unsigned)b) << 16; float f; __builtin_memcpy(&f, &u, 4); return f; }
FHD bf16raw f2bf(float f) { unsigned u; __builtin_memcpy(&u, &f, 4); u += 0x7fffu + ((u >> 16) & 1u); return (bf16raw)(u >> 16); }
#ifndef HOST_TEST
typedef float f32x2_t __attribute__((ext_vector_type(2)));
typedef __bf16 bf16x2_t __attribute__((ext_vector_type(2)));
__device__ __forceinline__ unsigned PK2(float lo, float hi) { const f32x2_t v = {lo, hi}; return __builtin_bit_cast(unsigned, __builtin_convertvector(v, bf16x2_t)); }
#else
inline unsigned PK2(float lo, float hi) { return (unsigned)f2bf(lo) | ((unsigned)f2bf(hi) << 16); }
#endif

typedef float f32v8 __attribute__((ext_vector_type(8)));
typedef float f32v16 __attribute__((ext_vector_type(16)));
template <int E> struct VecT;
template <> struct VecT<8> { typedef f32v8 type; };
template <> struct VecT<16> { typedef f32v16 type; };
FHD float bflo_(unsigned w) { unsigned u = w << 16; float f; __builtin_memcpy(&f, &u, 4); return f; }
FHD float bfhi_(unsigned w) { unsigned u = w & 0xffff0000u; float f; __builtin_memcpy(&f, &u, 4); return f; }
struct RawRow { uint4 q0, q1; unsigned um, up; };
template <int E> FHD RawRow raw_load(const bf16raw* row, int L, int t0) {
    static_assert(E == 8 || E == 16, "E");
    RawRow r;
    r.q0 = *(const uint4*)(row + t0);
    if constexpr (E == 16) r.q1 = *(const uint4*)(row + t0 + 8); else r.q1 = r.q0;
    r.um = (t0 > 0) ? ((unsigned)row[t0 - 1] << 16) : 0u;
    r.up = (t0 + E < L) ? ((unsigned)row[t0 + E] << 16) : 0u;
    return r;
}
template <int E> FHD void conv_apply(const RawRow& r, float w0, float w1, float w2, float bias, typename VecT<E>::type& out) {
    float um, up; __builtin_memcpy(&um, &r.um, 4); __builtin_memcpy(&up, &r.up, 4);
    const uint4 q0 = r.q0;
    const float x0 = bflo_(q0.x), x1 = bfhi_(q0.x), x2 = bflo_(q0.y), x3 = bfhi_(q0.y), x4 = bflo_(q0.z), x5 = bfhi_(q0.z), x6 = bflo_(q0.w), x7 = bfhi_(q0.w);
    out[0] = w0 * um + w1 * x0 + w2 * x1 + bias; out[1] = w0 * x0 + w1 * x1 + w2 * x2 + bias; out[2] = w0 * x1 + w1 * x2 + w2 * x3 + bias; out[3] = w0 * x2 + w1 * x3 + w2 * x4 + bias;
    out[4] = w0 * x3 + w1 * x4 + w2 * x5 + bias; out[5] = w0 * x4 + w1 * x5 + w2 * x6 + bias; out[6] = w0 * x5 + w1 * x6 + w2 * x7 + bias;
    if constexpr (E == 8) { out[7] = w0 * x6 + w1 * x7 + w2 * up + bias; }
    else {
        const uint4 q1 = r.q1;
        const float y0 = bflo_(q1.x), y1 = bfhi_(q1.x), y2 = bflo_(q1.y), y3 = bfhi_(q1.y), y4 = bflo_(q1.z), y5 = bfhi_(q1.z), y6 = bflo_(q1.w), y7 = bfhi_(q1.w);
        out[7] = w0 * x6 + w1 * x7 + w2 * y0 + bias;
        out[8] = w0 * x7 + w1 * y0 + w2 * y1 + bias; out[9] = w0 * y0 + w1 * y1 + w2 * y2 + bias; out[10] = w0 * y1 + w1 * y2 + w2 * y3 + bias; out[11] = w0 * y2 + w1 * y3 + w2 * y4 + bias;
        out[12] = w0 * y3 + w1 * y4 + w2 * y5 + bias; out[13] = w0 * y4 + w1 * y5 + w2 * y6 + bias; out[14] = w0 * y5 + w1 * y6 + w2 * y7 + bias; out[15] = w0 * y6 + w1 * y7 + w2 * up + bias;
    }
}
template <int E> FHD void load_conv(const bf16raw* row, int L, int t0, float w0, float w1, float w2, float bias, typename VecT<E>::type& out) {
    const RawRow r = raw_load<E>(row, L, t0); conv_apply<E>(r, w0, w1, w2, bias, out);
}
template <int E> FHD void store_bf16_run(bf16raw* dst, const typename VecT<E>::type& v) {
#pragma unroll
    for (int q = 0; q < E / 8; ++q) {
        uint4 o;
        o.x = PK2(v[8 * q + 0], v[8 * q + 1]); o.y = PK2(v[8 * q + 2], v[8 * q + 3]);
        o.z = PK2(v[8 * q + 4], v[8 * q + 5]); o.w = PK2(v[8 * q + 6], v[8 * q + 7]);
        *(uint4*)(dst + 8 * q) = o;
    }
}
#ifndef HOST_TEST
#define UNIT_SYNC() __syncthreads()
#define TID_LOOP
#define TID_DECL const int tid = threadIdx.x
#else
#define UNIT_SYNC()
#endif

template <int E> struct HyState { typename VecT<E>::type a, b; };

struct HyArgs {
    const bf16raw* rowX1A; const bf16raw* rowX2A; const bf16raw* rowVA;
    bf16raw* outA;
    const unsigned* K1; const unsigned* K2;
    float sw[3][3]; float sb[3];
    float skip0, skip1;
};
template <int LOGL> FHD void hy_sec_load_v(LP cf* buf, const HyArgs& A, int tid, HyState<(1 << LOGL) / NT>& st) {
    constexpr int L = 1 << LOGL, E = L / NT; const int t0 = tid * E;
    load_conv<E>(A.rowVA, L, t0, A.sw[2][0], A.sw[2][1], A.sw[2][2], A.sb[2], st.a);
    load_conv<E>(A.rowVA + L, L, t0, A.sw[2][0], A.sw[2][1], A.sw[2][2], A.sb[2], st.b);
    LP cf* pb = buf + PADI(t0);
#pragma unroll
    for (int e = 0; e < E; ++e) { pb[e] = cmk(st.a[e], st.b[e]); pb[PADI(L) + e] = cmk(0.f, 0.f); }
}
struct HyRaw { RawRow x1a, x1b, x2a, x2b; };
template <int LOGL> FHD void hy_raw_load(const HyArgs& A, int tid, HyRaw& R) {
    constexpr int L = 1 << LOGL, E = L / NT; const int t0 = tid * E;
    R.x1a = raw_load<E>(A.rowX1A, L, t0); R.x1b = raw_load<E>(A.rowX1A + L, L, t0); R.x2a = raw_load<E>(A.rowX2A, L, t0); R.x2b = raw_load<E>(A.rowX2A + L, L, t0);
}
template <int LOGL> FHD void hy_sec_gate1_pre(LP cf* buf, const HyArgs& A, int tid, HyState<(1 << LOGL) / NT>& st, const HyRaw& R) {
    constexpr int L = 1 << LOGL, E = L / NT; const int t0 = tid * E;
    typename VecT<E>::type xa, xb;
    conv_apply<E>(R.x1a, A.sw[0][0], A.sw[0][1], A.sw[0][2], A.sb[0], xa); conv_apply<E>(R.x1b, A.sw[0][0], A.sw[0][1], A.sw[0][2], A.sb[0], xb);
    LP cf* pb = buf + PADI(t0);
#pragma unroll
    for (int e = 0; e < E; ++e) { const cf y = pb[e];
        st.a[e] = xa[e] * (y.x + st.a[e] * A.skip0); st.b[e] = xb[e] * (y.y + st.b[e] * A.skip0);
        pb[e] = cmk(st.a[e], st.b[e]); pb[PADI(L) + e] = cmk(0.f, 0.f); }
}
template <int LOGL> FHD void hy_sec_gate2_pre(LP cf* buf, const HyArgs& A, int tid, HyState<(1 << LOGL) / NT>& st, const HyRaw& R) {
    constexpr int L = 1 << LOGL, E = L / NT; const int t0 = tid * E;
    typename VecT<E>::type xa, xb;
    conv_apply<E>(R.x2a, A.sw[1][0], A.sw[1][1], A.sw[1][2], A.sb[1], xa); conv_apply<E>(R.x2b, A.sw[1][0], A.sw[1][1], A.sw[1][2], A.sb[1], xb);
    LP cf* pb = buf + PADI(t0);
#pragma unroll
    for (int e = 0; e < E; ++e) { const cf y = pb[e];
        xa[e] = xa[e] * (y.x + st.a[e] * A.skip1); xb[e] = xb[e] * (y.y + st.b[e] * A.skip1); }
    store_bf16_run<E>(A.outA + t0, xa); store_bf16_run<E>(A.outA + L + t0, xb);
}
template <int LOGL> FHD void hy_sec_gate1(LP cf* buf, const HyArgs& A, int tid, HyState<(1 << LOGL) / NT>& st) {
    constexpr int L = 1 << LOGL, E = L / NT; const int t0 = tid * E;
    typename VecT<E>::type xa, xb;
    load_conv<E>(A.rowX1A, L, t0, A.sw[0][0], A.sw[0][1], A.sw[0][2], A.sb[0], xa);
    load_conv<E>(A.rowX1A + L, L, t0, A.sw[0][0], A.sw[0][1], A.sw[0][2], A.sb[0], xb);
    LP cf* pb = buf + PADI(t0);
#pragma unroll
    for (int e = 0; e < E; ++e) { const cf y = pb[e];
        st.a[e] = xa[e] * (y.x + st.a[e] * A.skip0); st.b[e] = xb[e] * (y.y + st.b[e] * A.skip0);
        pb[e] = cmk(st.a[e], st.b[e]); pb[PADI(L) + e] = cmk(0.f, 0.f); }
}
template <int LOGL> FHD void hy_sec_gate2(LP cf* buf, const HyArgs& A, int tid, HyState<(1 << LOGL) / NT>& st) {
    constexpr int L = 1 << LOGL, E = L / NT; const int t0 = tid * E;
    typename VecT<E>::type xa, xb;
    load_conv<E>(A.rowX2A, L, t0, A.sw[1][0], A.sw[1][1], A.sw[1][2], A.sb[1], xa);
    load_conv<E>(A.rowX2A + L, L, t0, A.sw[1][0], A.sw[1][1], A.sw[1][2], A.sb[1], xb);
    LP cf* pb = buf + PADI(t0);
#pragma unroll
    for (int e = 0; e < E; ++e) { const cf y = pb[e];
        xa[e] = xa[e] * (y.x + st.a[e] * A.skip1); xb[e] = xb[e] * (y.y + st.b[e] * A.skip1); }
    store_bf16_run<E>(A.outA + t0, xa); store_bf16_run<E>(A.outA + L + t0, xb);
}

template <int LOGL> FHD void kf_sec_load(LP cf* buf, const float* hf, const float* hb, int tid) {
    constexpr int L = 1 << LOGL;
    LP cf* pb = buf + PADI(tid);
#pragma unroll
    for (int i = 0; i < L / NT; ++i) { const int n = tid + NT * i;
        pb[544 * i] = cmk(hf[n], 0.f);
        pb[PADI(L) + 544 * i] = cmk(n == 0 ? 0.f : hb[L - n], 0.f);
    }
}
template <int LOGN> FHD void kf_sec_tail(LP cf* buf, unsigned* K, int id) {
    constexpr int RL = 1 << (LOGN - 12); constexpr float sc = 1.0f / (float)(1 << LOGN);
    cf x[RL];
#pragma unroll
    for (int k = 0; k < RL; ++k) x[k] = buf[PADI(RL * id) + k];
    if constexpr (RL == 4) { dft4<false>(x[0], x[1], x[2], x[3]); } else { dft2<false>(x[0], x[1]); }
#pragma unroll
    for (int k = 0; k < RL; ++k) K[RL * id + k] = PK2(x[k].x * sc, x[k].y * sc);
}

template <int LOGL> FHD void kf2_sec_load(LP cf* buf, const float* hf0, const float* hb0, const float* hf1, const float* hb1, int tid) {
    constexpr int L = 1 << LOGL;
    LP cf* pb = buf + PADI(tid);
#pragma unroll
    for (int i = 0; i < L / NT; ++i) { const int n = tid + NT * i;
        pb[544 * i] = cmk(hf0[n], hf1[n]);
        pb[PADI(L) + 544 * i] = n == 0 ? cmk(0.f, 0.f) : cmk(hb0[L - n], hb1[L - n]);
    }
}
template <int LOGN> FHD void kf2_sec_tail(LP cf* buf, int id) {
    constexpr int RL = 1 << (LOGN - 12);
    LP cf* pb = buf + PADI(RL * id);
    cf x[RL];
#pragma unroll
    for (int k = 0; k < RL; ++k) x[k] = pb[k];
    if constexpr (RL == 4) { dft4<false>(x[0], x[1], x[2], x[3]); } else { dft2<false>(x[0], x[1]); }
#pragma unroll
    for (int k = 0; k < RL; ++k) pb[k] = x[k];
}
template <int LOGN> FHD void kf2_sec_split(LP const cf* buf, unsigned* K0, unsigned* K1, int p) {
    constexpr int N = 1 << LOGN; constexpr float sc = 0.5f / (float)N;
    const int f = pos_to_freq(p, LOGN), pp = freq_to_pos((N - f) & (N - 1), LOGN);
    const cf Z = buf[PADI(p)], W = buf[PADI(pp)];
    K0[p] = PK2((Z.x + W.x) * sc, (Z.y - W.y) * sc);
    K1[p] = PK2((Z.y + W.y) * sc, (W.x - Z.x) * sc);
}

template <int LOGN> FHD int PADF(int k) { return LOGN == 13 ? (k + (k >> 8)) : (k + 4 * (k >> 6)); }
template <int LOGN> FHD void fn_sec_load(LP cf* buf, const bf16raw* rowC, const bf16raw* rowS, int tid) {
    constexpr int N = 1 << LOGN, E = N / NT; const int t0 = tid * E;
    LP cf* pb = buf + PADI(t0);
#pragma unroll
    for (int v = 0; v < E / 8; ++v) {
        const uint4 qc = *(const uint4*)(rowC + t0 + 8 * v), qs = *(const uint4*)(rowS + t0 + 8 * v);
        pb[8 * v + 0] = cmk(bflo_(qc.x), bflo_(qs.x)); pb[8 * v + 1] = cmk(bfhi_(qc.x), bfhi_(qs.x));
        pb[8 * v + 2] = cmk(bflo_(qc.y), bflo_(qs.y)); pb[8 * v + 3] = cmk(bfhi_(qc.y), bfhi_(qs.y));
        pb[8 * v + 4] = cmk(bflo_(qc.z), bflo_(qs.z)); pb[8 * v + 5] = cmk(bfhi_(qc.z), bfhi_(qs.z));
        pb[8 * v + 6] = cmk(bflo_(qc.w), bflo_(qs.w)); pb[8 * v + 7] = cmk(bfhi_(qc.w), bfhi_(qs.w));
    }
}
struct FnRaw { uint4 c0, c1, s0, s1; };
template <int LOGN> FHD FnRaw fn_raw_load(const bf16raw* rowC, const bf16raw* rowS, int tid) {
    constexpr int E = (1 << LOGN) / NT; const int t0 = tid * E; FnRaw r;
    r.c0 = *(const uint4*)(rowC + t0); r.s0 = *(const uint4*)(rowS + t0);
    if constexpr (E == 16) { r.c1 = *(const uint4*)(rowC + t0 + 8); r.s1 = *(const uint4*)(rowS + t0 + 8); } else { r.c1 = r.c0; r.s1 = r.s0; }
    return r;
}
template <int LOGN> FHD void fn_sec_put(LP cf* buf, const FnRaw& r, int tid, float sg = 1.f) {
    constexpr int E = (1 << LOGN) / NT; LP cf* pb = buf + PADI(tid * E);
    pb[0] = cmk(bflo_(r.c0.x), sg * bflo_(r.s0.x)); pb[1] = cmk(bfhi_(r.c0.x), sg * bfhi_(r.s0.x)); pb[2] = cmk(bflo_(r.c0.y), sg * bflo_(r.s0.y)); pb[3] = cmk(bfhi_(r.c0.y), sg * bfhi_(r.s0.y));
    pb[4] = cmk(bflo_(r.c0.z), sg * bflo_(r.s0.z)); pb[5] = cmk(bfhi_(r.c0.z), sg * bfhi_(r.s0.z)); pb[6] = cmk(bflo_(r.c0.w), sg * bflo_(r.s0.w)); pb[7] = cmk(bfhi_(r.c0.w), sg * bfhi_(r.s0.w));
    if constexpr (E == 16) {
        pb[8] = cmk(bflo_(r.c1.x), sg * bflo_(r.s1.x)); pb[9] = cmk(bfhi_(r.c1.x), sg * bfhi_(r.s1.x)); pb[10] = cmk(bflo_(r.c1.y), sg * bflo_(r.s1.y)); pb[11] = cmk(bfhi_(r.c1.y), sg * bfhi_(r.s1.y));
        pb[12] = cmk(bflo_(r.c1.z), sg * bflo_(r.s1.z)); pb[13] = cmk(bfhi_(r.c1.z), sg * bfhi_(r.s1.z)); pb[14] = cmk(bflo_(r.c1.w), sg * bflo_(r.s1.w)); pb[15] = cmk(bfhi_(r.c1.w), sg * bfhi_(r.s1.w));
    }
}
template <int LOGN> FHD void fn_sec_tail_read(LP cf* buf, int id, float (&re)[16]) {
    if (LOGN == 13) {
        cf a = buf[PADI(2 * id)], b = buf[PADI(2 * id) + 1]; dft2<false>(a, b); re[0] = a.x; re[1] = b.x;
    } else {
        cf x[16];
#pragma unroll
        for (int k = 0; k < 16; ++k) x[k] = buf[PADI(16 * id) + k];
        dft16<false>(x);
#pragma unroll
        for (int r = 0; r < 16; ++r) re[r] = x[DR16(r)].x;
    }
}
template <int LOGN> FHD void fn_sec_tail_write(LP float* fbuf, int id, const float (&re)[16]) {
    if (LOGN == 13) { fbuf[PADF<LOGN>(pos_to_freq(2 * id, LOGN))] = re[0]; fbuf[PADF<LOGN>(pos_to_freq(2 * id + 1, LOGN))] = re[1]; }
    else {
#pragma unroll
        for (int r = 0; r < 16; ++r) fbuf[PADF<LOGN>(pos_to_freq(16 * id + r, LOGN))] = re[r];
    }
}
template <int LOGN> FHD void fn_sec_store(LP const float* fbuf, bf16raw* out, float scale, int tid, bf16raw* out2 = nullptr) {
    constexpr int N = 1 << LOGN;
    for (int k = tid; k < N; k += NT) out[k] = f2bf(fbuf[PADF<LOGN>(k)] * scale);
    if (out2) for (int k = tid; k < N; k += NT) out2[k] = f2bf(fbuf[PADF<LOGN>((N - k) & (N - 1))] * scale);
}

#ifndef HOST_TEST
#define LAUNDER_TID(t) int t = threadIdx.x; asm volatile("" : "+v"(t))
template <int LOGN, bool INV, int LGS> __device__ __forceinline__ void dev_stage(LAS cf* buf) {
    LAUNDER_TID(tid);
#pragma unroll
    for (int i = 0; i < (1 << (LOGN - 4)) / NT; ++i) fft_stage16<INV, false, LGS>(buf, tid + NT * i);
    if constexpr ((1 << (LOGN - 4)) < NT) { if (tid < (1 << (LOGN - 4))) fft_stage16<INV, false, LGS>(buf, tid); }
    __syncthreads();
}
template <int LOGN, bool INV> __device__ __forceinline__ void dev_stages16(LAS cf* buf) {
    if constexpr (!INV) { dev_stage<LOGN, false, LOGN>(buf); dev_stage<LOGN, false, LOGN - 4>(buf); if constexpr (LOGN - 8 > 4) dev_stage<LOGN, false, LOGN - 8>(buf); }
    else { if constexpr (LOGN - 8 > 4) dev_stage<LOGN, true, LOGN - 8>(buf); dev_stage<LOGN, true, LOGN - 4>(buf); dev_stage<LOGN, true, LOGN>(buf); }
}
template <int LOGN> __device__ __forceinline__ void dev_fftconv(LAS cf* buf, const unsigned* K) {
    constexpr int RL = 1 << (LOGN - 12), NI = (1 << LOGN) / RL / NT;
    unsigned kp[NI][RL];
    { const int tid0 = threadIdx.x;
#pragma unroll
      for (int i = 0; i < NI; ++i) {
          if constexpr (RL == 4) { const uint4 q = *(const uint4*)(K + 4 * (tid0 + NT * i)); kp[i][0] = q.x; kp[i][1] = q.y; kp[i][2] = q.z; kp[i][3] = q.w; }
          else { const uint2 q = *(const uint2*)(K + 2 * (tid0 + NT * i)); kp[i][0] = q.x; kp[i][1] = q.y; } } }
    dev_stages16<LOGN, false>(buf);
    { LAUNDER_TID(tid);
#pragma unroll
      for (int i = 0; i < NI; ++i) { cf kk[RL];
#pragma unroll
          for (int k = 0; k < RL; ++k) kk[k] = cmk(bflo_(kp[i][k]), bfhi_(kp[i][k]));
          fft_mid_pre<RL>(buf, kk, tid + NT * i); } }
    __syncthreads();
    dev_stages16<LOGN, true>(buf);
}
template <int LOGL> __device__ __forceinline__ void dev_hyena_unit(LAS cf* buf, const HyArgs& A) {
    constexpr int L = 1 << LOGL, E = L / NT;
    HyState<E> st; HyRaw R;
    { LAUNDER_TID(tid); const int t0 = tid * E;
      const RawRow va = raw_load<E>(A.rowVA, L, t0), vb = raw_load<E>(A.rowVA + L, L, t0);
      hy_raw_load<LOGL>(A, tid, R);
      conv_apply<E>(va, A.sw[2][0], A.sw[2][1], A.sw[2][2], A.sb[2], st.a); conv_apply<E>(vb, A.sw[2][0], A.sw[2][1], A.sw[2][2], A.sb[2], st.b);
      LAS cf* pb = buf + PADI(t0);
#pragma unroll
      for (int e = 0; e < E; ++e) { pb[e] = cmk(st.a[e], st.b[e]); pb[PADI(L) + e] = cmk(0.f, 0.f); } }
    __syncthreads();
    dev_fftconv<LOGL + 1>(buf, A.K1);
    { LAUNDER_TID(tid); hy_sec_gate1_pre<LOGL>(buf, A, tid, st, R); } __syncthreads();
    dev_fftconv<LOGL + 1>(buf, A.K2);
    { LAUNDER_TID(tid); hy_sec_gate2_pre<LOGL>(buf, A, tid, st, R); } __syncthreads();
}
template <int LOGL> __device__ __forceinline__ void dev_kf_unit(LAS cf* buf, const float* hf, const float* hb, unsigned* K) {
    constexpr int LOGN = LOGL + 1, RL = 1 << (LOGN - 12);
    { LAUNDER_TID(tid); kf_sec_load<LOGL>(buf, hf, hb, tid); } __syncthreads();
    dev_stages16<LOGN, false>(buf);
    { LAUNDER_TID(tid); for (int id = tid; id < (1 << LOGN) / RL; id += NT) kf_sec_tail<LOGN>(buf, K, id); }
    __syncthreads();
}
template <int LOGL> __device__ __forceinline__ void dev_kf2_unit(LAS cf* buf, const float* hf0, const float* hb0, const float* hf1, const float* hb1, unsigned* K0, unsigned* K1) {
    constexpr int LOGN = LOGL + 1, RL = 1 << (LOGN - 12);
    { LAUNDER_TID(tid); kf2_sec_load<LOGL>(buf, hf0, hb0, hf1, hb1, tid); } __syncthreads();
    dev_stages16<LOGN, false>(buf);
    { LAUNDER_TID(tid); for (int id = tid; id < (1 << LOGN) / RL; id += NT) kf2_sec_tail<LOGN>(buf, id); }
    __syncthreads();
    { LAUNDER_TID(tid); for (int p = tid; p < (1 << LOGN); p += NT) kf2_sec_split<LOGN>((LAS const cf*)buf, K0, K1, p); }
    __syncthreads();
}
template <int LOGN> __device__ __forceinline__ void dev_fnet_unit(LAS cf* buf, const bf16raw* rowC, const bf16raw* rowS, float sg, bf16raw* out, bf16raw* out2, float scale) {
    { LAUNDER_TID(tid); const FnRaw raw = fn_raw_load<LOGN>(rowC, rowS, tid); fn_sec_put<LOGN>(buf, raw, tid, sg); } __syncthreads();
    dev_stages16<LOGN, false>(buf);
    LAUNDER_TID(tid);
    if constexpr (LOGN == 13) {
        float re[16];
#pragma unroll
        for (int h = 0; h < 8; ++h) { const int id = tid + NT * h; const cf a = buf[PADI(2 * id)], b = buf[PADI(2 * id) + 1]; re[2 * h] = a.x + b.x; re[2 * h + 1] = a.x - b.x; }
        __syncthreads();
        LAS float* fbuf = (LAS float*)buf;
#pragma unroll
        for (int h = 0; h < 8; ++h) { const int id = tid + NT * h; fbuf[PADF<LOGN>(pos_to_freq(2 * id, LOGN))] = re[2 * h]; fbuf[PADF<LOGN>(pos_to_freq(2 * id + 1, LOGN))] = re[2 * h + 1]; }
    } else {
        float re[16];
        if (tid < 256) fn_sec_tail_read<LOGN>(buf, tid, re);
        __syncthreads();
        if (tid < 256) fn_sec_tail_write<LOGN>((LAS float*)buf, tid, re);
    }
    __syncthreads();
    fn_sec_store<LOGN>((LAS const float*)buf, out, scale, tid, out2); __syncthreads();
}
#endif
constexpr int DM = 4096, NTOK = 32768, TOK_S0 = 16384, LP_ = 8192, LS_ = 4096, DFF = 11008, INW = 7168;
constexpr int LPOS = LP_ + LS_;
constexpr float ALPHA = 1.4142135623730951f;
constexpr float LN_EPS = 1e-5f;
#ifndef GP_SP2
#define GP_SP2 true
#endif
#ifndef GP_ALIGN
#define GP_ALIGN true
#endif
constexpr int NPH = 20;
constexpr size_t MiB = 1u << 20;
constexpr size_t WS_CTL = 0, CTL_ZERO_BYTES = 1 * MiB;
constexpr size_t WS_WIN = 1 * MiB, WS_WFN = 65 * MiB, WS_WOUT = 67 * MiB, WS_WGU = 99 * MiB, WS_WDN = 271 * MiB;
constexpr size_t WS_X = 357 * MiB, WS_UT = 613 * MiB, WS_QK = 965 * MiB, WS_TO = 1125 * MiB, WS_YF = 1253 * MiB, WS_MIX = 1317 * MiB, WS_H3 = 1573 * MiB, WS_END = 1589 * MiB;
constexpr size_t WS_H = WS_UT;
static_assert(WS_H + (size_t)NTOK * DFF * 2 <= WS_MIX, "H overlay");
constexpr size_t WS_W4P = WS_H3 + 12 * MiB;
constexpr size_t WS_HC = WS_MIX;
constexpr size_t OUT_KF0 = 0, OUT_KF1 = 128 * MiB, OUT_HC1 = 256 * MiB;
constexpr int CW_BAR = 4096;
constexpr int LDS_BYTES = 147456, LDS_MISC = 147456 - 256, LDS_AUX = 139264;

typedef short bf16x8 __attribute__((ext_vector_type(8)));
typedef float f32x4 __attribute__((ext_vector_type(4)));
typedef unsigned short bf16;
typedef unsigned u32x4v __attribute__((ext_vector_type(4)));
typedef unsigned u32x2v __attribute__((ext_vector_type(2)));

struct Params { const float* in[27]; float* out; unsigned char* ws; int ph_lo, ph_hi; };
typedef const __attribute__((opencl_constant)) Params* KP;
#define KARGS() ({ auto _k = __builtin_amdgcn_kernarg_segment_ptr(); asm volatile("" : "+s"(_k)); (KP)_k; })

__device__ __forceinline__ float wave_sum(float v) {
#pragma unroll
    for (int o = 1; o < 64; o <<= 1) v += __shfl_xor(v, o);
    return v;
}
__device__ __forceinline__ unsigned pk2(float lo, float hi) { return PK2(lo, hi); }

template <bool OUT_BF16> __device__ __forceinline__ void ln_row(const float* src, const float* g, const float* b, void* dst, int lane) {
    const f32x4* xr = (const f32x4*)src + lane;
    f32x4 v[16]; float s = 0.f;
#pragma unroll
    for (int j = 0; j < 16; ++j) { v[j] = xr[64 * j]; s += (v[j][0] + v[j][1]) + (v[j][2] + v[j][3]); }
    const float mean = wave_sum(s) * (1.f / DM); float s2 = 0.f;
#pragma unroll
    for (int j = 0; j < 16; ++j) { v[j] = v[j] - mean; s2 += (v[j][0] * v[j][0] + v[j][1] * v[j][1]) + (v[j][2] * v[j][2] + v[j][3] * v[j][3]); }
    const float rstd = 1.f / sqrtf(wave_sum(s2) * (1.f / DM) + LN_EPS);
#pragma unroll
    for (int j = 0; j < 16; ++j) {
        const f32x4 gg = ((const f32x4*)g)[lane + 64 * j], bb = ((const f32x4*)b)[lane + 64 * j];
        const f32x4 o = v[j] * rstd * gg + bb;
        if (OUT_BF16) { uint2 w; w.x = pk2(o[0], o[1]); w.y = pk2(o[2], o[3]); ((uint2*)dst)[lane + 64 * j] = w; }
        else ((f32x4*)dst)[lane + 64 * j] = o;
    }
}
template <bool OUT_BF16> __device__ __forceinline__ void ln_row_bf(const bf16* src, const float* g, const float* b, void* dst, int lane) {
    const u32x4v* xr = (const u32x4v*)src + lane;
    float v[64]; float s = 0.f;
#pragma unroll
    for (int j = 0; j < 8; ++j) { const u32x4v q = xr[64 * j];
        v[8 * j + 0] = __uint_as_float(q.x << 16); v[8 * j + 1] = __uint_as_float(q.x & 0xffff0000u); v[8 * j + 2] = __uint_as_float(q.y << 16); v[8 * j + 3] = __uint_as_float(q.y & 0xffff0000u);
        v[8 * j + 4] = __uint_as_float(q.z << 16); v[8 * j + 5] = __uint_as_float(q.z & 0xffff0000u); v[8 * j + 6] = __uint_as_float(q.w << 16); v[8 * j + 7] = __uint_as_float(q.w & 0xffff0000u);
#pragma unroll
        for (int e = 0; e < 8; ++e) s += v[8 * j + e]; }
    const float mean = wave_sum(s) * (1.f / DM); float s2 = 0.f;
#pragma unroll
    for (int i = 0; i < 64; ++i) { v[i] -= mean; s2 += v[i] * v[i]; }
    const float rstd = 1.f / sqrtf(wave_sum(s2) * (1.f / DM) + LN_EPS);
#pragma unroll
    for (int j = 0; j < 8; ++j) {
        const int c0 = 8 * lane + 512 * j;
        const f32x4 g0 = *(const f32x4*)(g + c0), g1 = *(const f32x4*)(g + c0 + 4), b0 = *(const f32x4*)(b + c0), b1 = *(const f32x4*)(b + c0 + 4);
        float o[8];
#pragma unroll
        for (int e = 0; e < 4; ++e) { o[e] = v[8 * j + e] * rstd * g0[e] + b0[e]; o[4 + e] = v[8 * j + 4 + e] * rstd * g1[e] + b1[e]; }
        if (OUT_BF16) { u32x4v w; w.x = pk2(o[0], o[1]); w.y = pk2(o[2], o[3]); w.z = pk2(o[4], o[5]); w.w = pk2(o[6], o[7]); ((u32x4v*)dst)[lane + 64 * j] = w; }
        else { float* d = (float*)dst + c0; *(f32x4*)d = (f32x4){o[0], o[1], o[2], o[3]}; *(f32x4*)(d + 4) = (f32x4){o[4], o[5], o[6], o[7]}; }
    }
}
__device__ __forceinline__ void tr_item(const float* W, int ldn, int k0, int n0, bf16* WT, int ldk, int drow0, LAS float* scr, int lane) {
    f32x4 v[16];
#pragma unroll
    for (int i = 0; i < 16; ++i) v[i] = *(const f32x4*)(W + (size_t)(k0 + 4 * i + (lane >> 4)) * ldn + n0 + 4 * (lane & 15));
#pragma unroll
    for (int i = 0; i < 16; ++i) { LAS float* s = scr + (4 * i + (lane >> 4)) * 65 + 4 * (lane & 15); s[0] = v[i][0]; s[1] = v[i][1]; s[2] = v[i][2]; s[3] = v[i][3]; }
    asm volatile("s_waitcnt lgkmcnt(0)" ::: "memory");
    const int c = lane & 7;
#pragma unroll
    for (int j = 0; j < 8; ++j) { const int n = (lane >> 3) + 8 * j; const LAS float* s = scr + (8 * c) * 65 + n;
        uint4 o; o.x = pk2(s[0 * 65], s[1 * 65]); o.y = pk2(s[2 * 65], s[3 * 65]); o.z = pk2(s[4 * 65], s[5 * 65]); o.w = pk2(s[6 * 65], s[7 * 65]);
        *(uint4*)(WT + (size_t)(drow0 + n) * ldk + k0 + 8 * c) = o; }
    asm volatile("s_waitcnt lgkmcnt(0)" ::: "memory");
}
__device__ __forceinline__ void convert_weights(KP p, int l, LAS unsigned char* lds, int gw, int ngw, int wave, int lane) {
    LAS float* scr = (LAS float*)(lds + wave * 17408);
    unsigned char* ws = p->ws;
    const float* w_in = p->in[4] + (size_t)l * DM * INW; const float* w_fn = p->in[16] + (size_t)l * 1024 * 1024; const float* w_out = p->in[19] + (size_t)l * DM * DM;
    const float* w_g = p->in[22] + (size_t)l * DM * DFF; const float* w_u = p->in[23] + (size_t)l * DM * DFF; const float* w_d = p->in[24] + (size_t)l * DFF * DM;
    constexpr int I_IN = 64 * 112, I_FN = 16 * 16, I_OUT = 64 * 64, I_G = 64 * 172, I_D = 172 * 64;
    constexpr int NITEMS = I_IN + I_FN + I_OUT + 2 * I_G + I_D;
    for (int it = gw; it < NITEMS; it += ngw) {
        int r = it;
        if (r < I_IN) { const int kb = r / 112, nb = r % 112, n0 = 64 * nb; int d0;
            if (n0 < 3072) d0 = n0; else if (n0 < 4096) continue; else if (n0 < 6144) d0 = 4608 + (n0 - 4096); else if (n0 < 6656) d0 = 6656 + (n0 - 6144); else d0 = 4096 + (n0 - 6656);
            tr_item(w_in, INW, 64 * kb, n0, (bf16*)(ws + WS_WIN), DM, d0, scr, lane); continue; }
        r -= I_IN;
        if (r < I_FN) { const int kb = r / 16, nb = r % 16; tr_item(w_fn, 1024, 64 * kb, 64 * nb, (bf16*)(ws + WS_WFN), 1024, 64 * nb, scr, lane); continue; }
        r -= I_FN;
        if (r < I_OUT) { const int kb = r / 64, nb = r % 64; tr_item(w_out, DM, 64 * kb, 64 * nb, (bf16*)(ws + WS_WOUT), DM, 64 * nb, scr, lane); continue; }
        r -= I_OUT;
        if (r < I_G) { const int kb = r / 172, nb = r % 172, n0 = 64 * nb; tr_item(w_g, DFF, 64 * kb, n0, (bf16*)(ws + WS_WGU), DM, 256 * (n0 >> 7) + (n0 & 127), scr, lane); continue; }
        r -= I_G;
        if (r < I_G) { const int kb = r / 172, nb = r % 172, n0 = 64 * nb; tr_item(w_u, DFF, 64 * kb, n0, (bf16*)(ws + WS_WGU), DM, 256 * (n0 >> 7) + 128 + (n0 & 127), scr, lane); continue; }
        r -= I_G;
        { const int kb = r / 64, nb = r % 64; tr_item(w_d, DM, 64 * kb, 64 * nb, (bf16*)(ws + WS_WDN), DFF, 64 * nb, scr, lane); }
    }
}
__device__ __forceinline__ void fold_fnet(KP p, int l, LAS unsigned char* lds, int bid, int nb) {
    LAUNDER_TID(tid); LAS float* wt = (LAS float*)lds;
    LAS float* ct = (LAS float*)(lds + 128 * 129 * 4);
    const float* w_in = p->in[4] + (size_t)l * DM * INW; bf16* WT = (bf16*)(p->ws + WS_WIN);
    if (tid < 128) { ct[tid] = __builtin_amdgcn_cosf((float)tid * (1.0f / 128.f)); ct[128 + tid] = __builtin_amdgcn_sinf((float)tid * (1.0f / 128.f)); }
    for (int it = bid; it < 256; it += nb) {
        const int kb = it >> 3, h = it & 7, k0 = 128 * kb;
        __syncthreads();
        for (int e = tid; e < 128 * 128; e += NT) { const int kk = e >> 7, d = e & 127; wt[kk * 129 + d] = w_in[(size_t)(k0 + kk) * INW + 3072 + h * 128 + d]; }
        __syncthreads();
        const int kg = tid & 15, rgp = (tid >> 4) & 15, kh2 = tid >> 8;
        int toff[8]; float sg[8];
#pragma unroll
        for (int b = 0; b < 8; ++b) { const int r = 8 * rgp + b; const bool is_s = r > 64; toff[b] = is_s ? 128 : 0; sg[b] = is_s ? -1.f : 1.f; }
        float acc[4][8];
#pragma unroll
        for (int a = 0; a < 4; ++a)
#pragma unroll
            for (int b = 0; b < 8; ++b) acc[a][b] = 0.f;
        for (int d = 0; d < 128; ++d) {
            float wv[4], tv[8];
#pragma unroll
            for (int a = 0; a < 4; ++a) wv[a] = wt[(64 * kh2 + 4 * kg + a) * 129 + d];
#pragma unroll
            for (int b = 0; b < 8; ++b) { const int r = 8 * rgp + b, k2 = r > 64 ? r - 64 : r; tv[b] = ct[toff[b] + ((k2 * d) & 127)]; }
#pragma unroll
            for (int a = 0; a < 4; ++a)
#pragma unroll
                for (int b = 0; b < 8; ++b) acc[a][b] += wv[a] * tv[b];
        }
#pragma unroll
        for (int b = 0; b < 8; ++b) {
            uint2 o; o.x = pk2(sg[b] * acc[0][b], sg[b] * acc[1][b]); o.y = pk2(sg[b] * acc[2][b], sg[b] * acc[3][b]);
            *(uint2*)(WT + (size_t)(3072 + h * 128 + 8 * rgp + b) * DM + k0 + 64 * kh2 + 4 * kg) = o; }
    }
    __syncthreads();
}
__device__ __forceinline__ void h3_items(KP p, LAS unsigned char* lds, int bid, int nb) {
    LAUNDER_TID(tid); const int pp = tid >> 6, j = tid & 63;
    LAS float* z = (LAS float*)lds; LAS float* hA = z + 8 * 36; LAS float* hB = hA + 8 * 64;
    bf16* h3p = (bf16*)(p->ws + WS_H3);
    for (int it = bid; it < 2 * (LPOS / 8); it += nb) {
        const int l = it / (LPOS / 8), g = (it % (LPOS / 8)) * 8 + pp; const int Lt = g < LP_ ? LP_ : LS_, t = g < LP_ ? g : g - LP_;
        const float* w1 = p->in[7] + l * 33 * 64; const float* b1 = p->in[8] + l * 64; const float* w2 = p->in[9] + l * 4096; const float* b2 = p->in[10] + l * 64;
        const float* w3 = p->in[11] + l * 4096; const float* b3 = p->in[12] + l * 64; const float* fq = p->in[13] + l * 192;
        __syncthreads();
        if (j < 33) { const float wv = (6.283185307179586f / (float)Lt) * (float)t; float val;
            if (j == 0) val = (float)t / (float)(Lt - 1);
            else if (j <= 16) { const float f = 1e-4f + (float)(j - 1) * ((15.0f - 1e-4f) / 15.0f); val = cosf(f * wv); }
            else { const float f = 1e-4f + (float)(j - 17) * ((15.0f - 1e-4f) / 15.0f); val = -sinf(f * wv); }
            z[pp * 36 + j] = val; }
        __syncthreads();
        float a = b1[j];
        for (int i = 0; i < 33; ++i) a += z[pp * 36 + i] * w1[i * 64 + j];
        hA[pp * 64 + j] = sinf(fq[j] * a);
        __syncthreads();
        a = b2[j];
        for (int m = 0; m < 64; ++m) a += hA[pp * 64 + m] * w2[m * 64 + j];
        hB[pp * 64 + j] = sinf(fq[64 + j] * a);
        __syncthreads();
        a = b3[j];
        for (int m = 0; m < 64; ++m) a += hB[pp * 64 + m] * w3[m * 64 + j];
        { const float v = sinf(fq[128 + j] * a); const bf16 hi = f2bf(v), lo = f2bf(v - bf2f(hi));
          bf16* row = h3p + ((size_t)l * LPOS + g) * 256; row[j] = hi; row[64 + j] = lo; row[128 + j] = hi; row[192 + j] = 0; }
    }
    __syncthreads();
    { bf16* w4p = (bf16*)(p->ws + WS_W4P);
      for (int e = bid * NT + tid; e < 2 * 4096 * 64; e += nb * NT) { const int l = e >> 18, jj = (e >> 6) & 4095, mm = e & 63;
          const float v = p->in[14][((size_t)l * 64 + mm) * 4096 + jj]; const bf16 hi = f2bf(v), lo = f2bf(v - bf2f(hi));
          bf16* row = w4p + ((size_t)l * 4096 + jj) * 256; row[mm] = hi; row[64 + mm] = hi; row[128 + mm] = lo; row[192 + mm] = 0; } }
}
__device__ __forceinline__ void hc_gemm(KP p, int l, LAS unsigned char* lds, int bid, int nb) {
    pg8::Gemm g{(const bf16*)(p->ws + WS_W4P) + (size_t)l * 4096 * 256, (const bf16*)(p->ws + WS_H3) + (size_t)l * LPOS * 256, 4096, LPOS, 256};
    pg8::StaticOrder S; S.init(4096, LPOS, nb, bid);
    pg8::EpiHc E{l == 0 ? (float*)(p->ws + WS_HC) : (float*)((unsigned char*)p->out + OUT_HC1), LPOS};
    pg8::gemm_phase<pg8::EpiHc, pg8::StaticOrder, GP_ALIGN, GP_SP2>(lds, g, S, E);
}
__device__ __forceinline__ void kf_units(KP p, int l, LAS unsigned char* lds, int bid, int nb) {
    const float* Hc = l == 0 ? (const float*)(p->ws + WS_HC) : (const float*)((const unsigned char*)p->out + OUT_HC1); LAS cf* buf = (LAS cf*)lds;
    for (int u = bid; u < 2048; u += nb) {
        const int lt = u >> 10, c = u & 1023; const size_t go = lt ? LP_ : 0;
        const float* hf0 = Hc + (size_t)c * LPOS + go; const float* hb0 = Hc + (size_t)(2048 + c) * LPOS + go;
        const float* hf1 = Hc + (size_t)(1024 + c) * LPOS + go; const float* hb1 = Hc + (size_t)(3072 + c) * LPOS + go;
        if (lt == 0) { unsigned* K = (unsigned*)((unsigned char*)p->out + OUT_KF0); dev_kf2_unit<13>(buf, hf0, hb0, hf1, hb1, K + (size_t)c * 16384, K + (size_t)(1024 + c) * 16384); }
        else { unsigned* K = (unsigned*)((unsigned char*)p->out + OUT_KF1); dev_kf2_unit<12>(buf, hf0, hb0, hf1, hb1, K + (size_t)c * 8192, K + (size_t)(1024 + c) * 8192); }
    }
}
struct AttnUnit { int tok0, nblk, n, h; };
__device__ __forceinline__ AttnUnit attn_decode(int u) {
    const bool pr = u < 2048; const int v = pr ? u : u - 2048, h = v & 15, r = v >> 4; const int nblk = pr ? 64 : 32, sq = r / nblk, n = r % nblk;
    AttnUnit a; a.tok0 = pr ? sq * LP_ : TOK_S0 + sq * LS_; a.nblk = nblk; a.n = n; a.h = h; return a;
}
__device__ __forceinline__ void attn_phase(LAS unsigned char* lds, const bf16* QK, const bf16* UT, bf16* MIX, const float* sink, int bid, int nb) {
    LAUNDER_TID(tid); const int lane = tid & 63, w = __builtin_amdgcn_readfirstlane(tid >> 6), fr = lane & 15, g = lane >> 4;
    const float LOG2E = 1.4426950408889634f, sc = 0.08838834764831845f * LOG2E;
    const int nun = (4096 - bid + nb - 1) / nb;
    struct St { int i, j; AttnUnit u; };
    auto next_step = [&](const St& c) -> St { St n = c; n.j = c.j + 1;
        if (n.j > 1 || c.u.n + n.j >= c.u.nblk) { n.i = c.i + 1; n.j = -1; if (n.i < nun) { n.u = attn_decode(bid + nb * n.i); if (n.u.n + n.j < 0) n.j = 0; } }
        return n; };
    St cur; cur.i = 0; cur.j = -1; cur.u = attn_decode(bid); if (cur.u.n + cur.j < 0) cur.j = 0;
    St nx1 = next_step(cur);
    u32x4v kvA[4], vvA[4], kvB[4], vvB[4]; bf16x8 qf[4], qn[4];
    const int lr = tid >> 2, lq = tid & 3;
    auto issue_kv = [&](const AttnUnit& a, int jc, u32x4v (&kx)[4], u32x4v (&vx)[4]) {
        const int kb = a.n + jc, kh = a.h >> 2;
        const bf16* srcK = QK + (size_t)(a.tok0 + 128 * kb + lr) * 2560 + 2048 + 128 * kh + 32 * lq;
        const bf16* srcV = UT + (size_t)(4096 + 128 * kh + lr) * NTOK + a.tok0 + 128 * kb + 32 * lq;
#pragma unroll
        for (int i = 0; i < 4; ++i) { kx[i] = *(const u32x4v*)(srcK + 8 * i); vx[i] = *(const u32x4v*)(srcV + 8 * i); }
    };
    auto issue_q = [&](const AttnUnit& a, bf16x8 (&q)[4]) {
        const bf16* qrow = QK + (size_t)(a.tok0 + 128 * a.n + 16 * w + fr) * 2560 + 128 * a.h;
#pragma unroll
        for (int kk = 0; kk < 4; ++kk) q[kk] = *(const bf16x8*)(qrow + 32 * kk + 8 * g);
    };
    if (nun > 0) { issue_kv(cur.u, cur.j, kvA, vvA); issue_q(cur.u, qf); if (nx1.i < nun) issue_kv(nx1.u, nx1.j, kvB, vvB); }
    float m_run = 0.f, l_run = 1.f; f32x4 o[8]; bool fresh = true; int pb = 0;
    auto do_step = [&](u32x4v (&kv)[4], u32x4v (&vv)[4]) {
        const int ci = cur.i, cj = cur.j; const AttnUnit cu = cur.u;
        LAS bf16* Ks = (LAS bf16*)(lds + pb * 69632); LAS bf16* Vs = Ks + 128 * 136;
#pragma unroll
        for (int i = 0; i < 4; ++i) { *(LAS u32x4v*)(Ks + lr * 136 + 32 * lq + 8 * i) = kv[i]; *(LAS u32x4v*)(Vs + lr * 136 + 32 * lq + 8 * i) = vv[i]; }
        const St nx2 = next_step(nx1);
        const bool new_unit = nx1.i != ci;
        if (nx2.i < nun) issue_kv(nx2.u, nx2.j, kv, vv);
        if (fresh && ci + 1 < nun) issue_q(attn_decode(bid + nb * (ci + 1)), qn);
        __syncthreads();
        if (fresh) { m_run = sink[cu.h] * LOG2E; l_run = 1.f;
#pragma unroll
            for (int dt = 0; dt < 8; ++dt) o[dt] = (f32x4){0.f, 0.f, 0.f, 0.f}; }
        const float slope = exp2f(-0.5f * (float)(cu.h + 1)) * LOG2E;
        const float d0 = (float)(16 * w + fr - 4 * g - 128 * cj);
        const int kt_lo = cj < 0 ? w : 0, kt_hi = cj > 0 ? w : 7;
        f32x4 s[8];
#pragma unroll
        for (int kt = 0; kt < 8; ++kt) { f32x4 acc = (f32x4){0.f, 0.f, 0.f, 0.f};
            if (kt >= kt_lo && kt <= kt_hi) {
#pragma unroll
                for (int kk = 0; kk < 4; ++kk) { const bf16x8 a = *(const LAS bf16x8*)(Ks + (16 * kt + fr) * 136 + 32 * kk + 8 * g); acc = __builtin_amdgcn_mfma_f32_16x16x32_bf16(a, qf[kk], acc, 0, 0, 0); } }
            s[kt] = acc; }
        float mx = -3.0e38f;
#pragma unroll
        for (int kt = 0; kt < 8; ++kt) if (kt >= kt_lo && kt <= kt_hi) {
#pragma unroll
            for (int i = 0; i < 4; ++i) { const float ad = fabsf(d0 - (float)(16 * kt + i));
                float v = s[kt][i] * sc - slope * ad; v = (ad <= 128.f) ? v : -__builtin_inff(); s[kt][i] = v; mx = fmaxf(mx, v); } }
        mx = fmaxf(mx, __shfl_xor(mx, 16)); mx = fmaxf(mx, __shfl_xor(mx, 32));
        const float m_new = fmaxf(m_run, mx), alpha = __builtin_amdgcn_exp2f(m_run - m_new);
        float ps = 0.f;
#pragma unroll
        for (int kt = 0; kt < 8; ++kt) if (kt >= kt_lo && kt <= kt_hi) {
#pragma unroll
            for (int i = 0; i < 4; ++i) { const float pv = __builtin_amdgcn_exp2f(s[kt][i] - m_new); ps += pv; s[kt][i] = pv; } }
        ps += __shfl_xor(ps, 16); ps += __shfl_xor(ps, 32);
        l_run = l_run * alpha + ps; m_run = m_new;
#pragma unroll
        for (int dt = 0; dt < 8; ++dt) o[dt] *= alpha;
#pragma unroll
        for (int ks = 0; ks < 4; ++ks) if (2 * ks + 1 >= kt_lo && 2 * ks <= kt_hi) {
            union { bf16x8 v; unsigned u[4]; } pbk;
            pbk.u[0] = pk2(s[2 * ks][0], s[2 * ks][1]); pbk.u[1] = pk2(s[2 * ks][2], s[2 * ks][3]); pbk.u[2] = pk2(s[2 * ks + 1][0], s[2 * ks + 1][1]); pbk.u[3] = pk2(s[2 * ks + 1][2], s[2 * ks + 1][3]);
#pragma unroll
            for (int dt = 0; dt < 8; ++dt) { const LAS bf16* vp = Vs + (16 * dt + fr) * 136 + 32 * ks + 4 * g;
                union { bf16x8 v; u32x2v h[2]; } a; a.h[0] = *(const LAS u32x2v*)vp; a.h[1] = *(const LAS u32x2v*)(vp + 16);
                o[dt] = __builtin_amdgcn_mfma_f32_16x16x32_bf16(a.v, pbk.v, o[dt], 0, 0, 0); }
        }
        fresh = false;
        if (new_unit) {
            const float inv = 1.0f / l_run;
            bf16* orow = MIX + (size_t)(cu.tok0 + 128 * cu.n + 16 * w + fr) * DM + 2048 + 128 * cu.h + 4 * g;
#pragma unroll
            for (int dt = 0; dt < 8; ++dt) { uint2 wv; wv.x = pk2(o[dt][0] * inv, o[dt][1] * inv); wv.y = pk2(o[dt][2] * inv, o[dt][3] * inv); *(uint2*)(orow + 16 * dt) = wv; }
            fresh = true;
#pragma unroll
            for (int kk = 0; kk < 4; ++kk) qf[kk] = qn[kk];
        }
        cur = nx1; nx1 = nx2; pb ^= 1;
    };
    while (cur.i < nun) { do_step(kvA, vvA); if (cur.i < nun) do_step(kvB, vvB); }
    __syncthreads();
}
__device__ __forceinline__ void mixer_phase(KP p, int l, LAS unsigned char* lds, int bid, int nb) {
    const bf16* UT = (const bf16*)(p->ws + WS_UT); bf16* TO = (bf16*)(p->ws + WS_TO); LAS cf* buf = (LAS cf*)lds;
    const unsigned* KF0 = (const unsigned*)((const unsigned char*)p->out + OUT_KF0); const unsigned* KF1 = (const unsigned*)((const unsigned char*)p->out + OUT_KF1);
    const float* sw = p->in[5] + (size_t)l * 3 * 3072; const float* sb = p->in[6] + (size_t)l * 3072; const float* skip = p->in[15] + (size_t)l * 2048;
#ifndef SK_HY
#ifndef MX_REP
#define MX_REP 0
#endif
    for (int mr = 0; mr < 1 + (MX_REP & 1); ++mr)
    for (int ui = 0; bid + nb * (ui < 4 ? ui : 4 + ((ui - 4) >> 1)) < (ui < 4 ? 1024 : 2048); ++ui) {
        const bool pr = ui < 4; const int c = pr ? bid + nb * ui : bid + nb * ((ui - 4) >> 1), tokA = pr ? 0 : TOK_S0 + ((ui - 4) & 1) * 2 * LS_;
        HyArgs A; A.rowX1A = UT + (size_t)c * NTOK + tokA; A.rowX2A = UT + (size_t)(1024 + c) * NTOK + tokA; A.rowVA = UT + (size_t)(2048 + c) * NTOK + tokA; A.outA = TO + (size_t)c * NTOK + tokA;
        A.K1 = pr ? KF0 + (size_t)c * 16384 : KF1 + (size_t)c * 8192; A.K2 = pr ? KF0 + (size_t)(1024 + c) * 16384 : KF1 + (size_t)(1024 + c) * 8192;
#pragma unroll
        for (int i = 0; i < 3; ++i) {
#pragma unroll
            for (int k = 0; k < 3; ++k) A.sw[i][k] = sw[k * 3072 + i * 1024 + c];
            A.sb[i] = sb[i * 1024 + c]; }
        A.skip0 = skip[c]; A.skip1 = skip[1024 + c];
        if (pr) dev_hyena_unit<13>(buf, A); else dev_hyena_unit<12>(buf, A);
    }
#endif
#ifndef SK_FN
    for (int mr = 0; mr < 1 + ((MX_REP >> 1) & 1); ++mr) {
        for (int u = bid; u < 2 * 8 * 65; u += nb) { const int b = u / 520, r = u % 520, h = r / 65, k2 = r % 65; const float sg = (k2 == 0 || k2 == 64) ? 0.f : 1.f;
            const bf16* rc = UT + (size_t)(3072 + h * 128 + k2) * NTOK + b * LP_; const bf16* rs = (sg == 0.f) ? rc : UT + (size_t)(3072 + h * 128 + 64 + k2) * NTOK + b * LP_;
            bf16* o1 = TO + (size_t)(1024 + h * 128 + k2) * NTOK + b * LP_; bf16* o2 = (sg == 0.f) ? nullptr : TO + (size_t)(1024 + h * 128 + 128 - k2) * NTOK + b * LP_;
            dev_fnet_unit<13>(buf, rc, rs, sg, o1, o2, 9.765625e-4f  ); }
        for (int v = bid; v < 4 * 8 * 65; v += nb) { const int b = v / 520, r = v % 520, h = r / 65, k2 = r % 65; const float sg = (k2 == 0 || k2 == 64) ? 0.f : 1.f;
            const bf16* rc = UT + (size_t)(3072 + h * 128 + k2) * NTOK + TOK_S0 + b * LS_; const bf16* rs = (sg == 0.f) ? rc : UT + (size_t)(3072 + h * 128 + 64 + k2) * NTOK + TOK_S0 + b * LS_;
            bf16* o1 = TO + (size_t)(1024 + h * 128 + k2) * NTOK + TOK_S0 + b * LS_; bf16* o2 = (sg == 0.f) ? nullptr : TO + (size_t)(1024 + h * 128 + 128 - k2) * NTOK + TOK_S0 + b * LS_;
            dev_fnet_unit<12>(buf, rc, rs, sg, o1, o2, 1.3810679320049757e-3f  ); }
    }
#endif
#ifndef SK_AT
    const bf16* QK = (const bf16*)(p->ws + WS_QK); bf16* MIX = (bf16*)(p->ws + WS_MIX); const float* sink = p->in[18] + l * 16;
    for (int mr = 0; mr < 1 + ((MX_REP >> 2) & 1); ++mr) attn_phase(lds, QK, UT, MIX, sink, bid, nb);
#endif
    __syncthreads();
}
__device__ __forceinline__ void transpose_out(KP p, int gw, int ngw, int lane) {
    const bf16* TO = (const bf16*)(p->ws + WS_TO); bf16* MIX = (bf16*)(p->ws + WS_MIX); bf16* YF = (bf16*)(p->ws + WS_YF);
    for (int it = gw; it < 64 * 256; it += ngw) {
        const int cb = it & 63, tb = it >> 6, ch0 = 32 * cb, tok = 128 * tb + 2 * lane;
        unsigned w[32];
#pragma unroll
        for (int i = 0; i < 32; ++i) w[i] = *(const unsigned*)(TO + (size_t)(ch0 + i) * NTOK + tok);
#pragma unroll
        for (int t = 0; t < 2; ++t) {
            bf16* dst = ch0 < 1024 ? MIX + (size_t)(tok + t) * DM + ch0 : YF + (size_t)(tok + t) * 1024 + (ch0 - 1024);
#pragma unroll
            for (int q = 0; q < 4; ++q) { uint4 o;
                if (t == 0) { o.x = (w[8 * q] & 0xffffu) | (w[8 * q + 1] << 16); o.y = (w[8 * q + 2] & 0xffffu) | (w[8 * q + 3] << 16); o.z = (w[8 * q + 4] & 0xffffu) | (w[8 * q + 5] << 16); o.w = (w[8 * q + 6] & 0xffffu) | (w[8 * q + 7] << 16); }
                else { o.x = (w[8 * q] >> 16) | (w[8 * q + 1] & 0xffff0000u); o.y = (w[8 * q + 2] >> 16) | (w[8 * q + 3] & 0xffff0000u); o.z = (w[8 * q + 4] >> 16) | (w[8 * q + 5] & 0xffff0000u); o.w = (w[8 * q + 6] >> 16) | (w[8 * q + 7] & 0xffff0000u); }
                *(uint4*)(dst + 8 * q) = o; } }
    }
}

__global__ void __launch_bounds__(512, 2) mega_fwd(Params p) {
    extern __shared__ __attribute__((aligned(16))) unsigned char lds_raw[];
    LAS unsigned char* lds = (LAS unsigned char*)lds_raw;
    const int tid = threadIdx.x;
    const int bid0 = blockIdx.x, nb0 = gridDim.x;
#define PH_IDS LAUNDER_TID(tid_); const int lane = tid_ & 63, wave = __builtin_amdgcn_readfirstlane(tid_ >> 6), gw = bid * 8 + wave, ngw = nb * 8; (void)lane; (void)gw; (void)ngw
    volatile LAS unsigned* misc = (volatile LAS unsigned*)(lds + LDS_MISC);
    if (tid < 64) misc[tid] = 0u;
    __syncthreads();
#ifdef CLK_PROBE
    const unsigned long long ck_c0 = __builtin_readcyclecounter(), ck_r0 = __builtin_amdgcn_s_memrealtime();
#endif
    const int lo = p.ph_lo, hi = p.ph_hi;
    const bool multi = (hi - lo) > 1;
    XcdBarrier bar; bar.bar = (unsigned*)(p.ws + WS_CTL) + CW_BAR; bar.x = 0; bar.st = nullptr;
    if (multi) bar = xcd_barrier_post((unsigned*)(p.ws + WS_CTL) + CW_BAR, misc + 8);
#ifndef PH_EN
#define PH_EN 0x7FF
#endif
#define IN(k) (((PH_EN >> ((k) < 2 ? (k) : 2 + ((k) - 2) % 9)) & 1) && lo <= (k) && (k) < hi)
#ifndef REP_MASK
#define REP_MASK 0
#endif
#define REPS(t) (1 + ((REP_MASK >> (t)) & 1))
#ifndef TM_MASK
#define TM_MASK 0
#endif
    unsigned long long tm_acc = 0ull, tm_t0 = TM_MASK ? __builtin_amdgcn_s_memrealtime() : 0ull; (void)tm_acc; (void)tm_t0;
#define TM_T(k) ((k) < 2 ? (k) : 2 + ((k) - 2) % 9)
#define SEAM(k) do { if (IN(k) && IN((k) + 1)) xcd_barrier(bar); \
    if (TM_MASK) { const unsigned long long _t = __builtin_amdgcn_s_memrealtime(); if ((TM_MASK >> TM_T(k)) & 1) tm_acc += _t - tm_t0; tm_t0 = _t; } } while (0)
#define PH_ARGS int bid = bid0, nb = nb0; asm volatile("" : "+s"(bid), "+s"(nb)); KP kp = KARGS(); unsigned char* ws = kp->ws; bf16* X = (bf16*)(ws + WS_X); bf16* MIX = (bf16*)(ws + WS_MIX); (void)X; (void)MIX

    if (IN(0)) for (int rep = 0; rep < REPS(0); ++rep) { PH_ARGS; PH_IDS;
        h3_items(kp, lds, bid, nb);
        convert_weights(kp, 0, lds, gw, ngw, wave, lane);
        __syncthreads();
        fold_fnet(kp, 0, lds, bid, nb);
        for (int m = gw; m < NTOK; m += ngw) ln_row<true>(m < TOK_S0 ? kp->in[0] + (size_t)m * DM : kp->in[1] + (size_t)(m - TOK_S0) * DM, kp->in[2], kp->in[3], X + (size_t)m * DM, lane);
    }
    SEAM(0);
    if (IN(1)) for (int rep = 0; rep < REPS(1); ++rep) { PH_ARGS; for (int hl = 0; hl < 2; ++hl) hc_gemm(kp, hl, lds, bid, nb); }
    SEAM(1);
    for (int l = 0; l < 2; ++l) {
        const int pb = 2 + 9 * l;
        if (IN(pb + 0)) for (int rep = 0; rep < REPS(2); ++rep) { PH_ARGS;
#ifndef SK_GA
            for (int gi = 0; gi < 2; ++gi) {
                const bf16* Wt = (const bf16*)(ws + WS_WIN);
                pg8::Gemm g{gi == 0 ? Wt : X, gi == 0 ? X : Wt + (size_t)4608 * DM, gi == 0 ? 4608 : NTOK, gi == 0 ? NTOK : 2560, DM};
                pg8::StaticOrder S; S.init(g.M, g.N, nb, bid);
                pg8::EpiBf16<0> E{gi == 0 ? (bf16*)(ws + WS_UT) : (bf16*)(ws + WS_QK), gi == 0 ? NTOK : 2560, nullptr, 0, 0};
                pg8::gemm_phase<pg8::EpiBf16<0>, pg8::StaticOrder, GP_ALIGN, GP_SP2>(lds, g, S, E);
            }
#endif
#ifndef SK_KF
            kf_units(kp, l, lds, bid, nb);
#endif
        }
        SEAM(pb + 0);
        if (IN(pb + 1)) for (int rep = 0; rep < REPS(3); ++rep) { PH_ARGS; mixer_phase(kp, l, lds, bid, nb); }
        SEAM(pb + 1);
        if (IN(pb + 2)) for (int rep = 0; rep < REPS(4); ++rep) { PH_ARGS; PH_IDS; transpose_out(kp, gw, ngw, lane); }
        SEAM(pb + 2);
        if (IN(pb + 3)) for (int rep = 0; rep < REPS(5); ++rep) { PH_ARGS;
            pg8::Gemm g{(const bf16*)(ws + WS_YF), (const bf16*)(ws + WS_WFN), NTOK, 1024, 1024}; pg8::StaticOrder S; S.init(NTOK, 1024, nb, bid);
            pg8::EpiBf16<0> E{MIX + 1024, DM, kp->in[17] + l * 1024, 0, 0};
            pg8::gemm_phase<pg8::EpiBf16<0>, pg8::StaticOrder, GP_ALIGN, GP_SP2>(lds, g, S, E);
        }
        SEAM(pb + 3);
        if (IN(pb + 4)) for (int rep = 0; rep < REPS(6); ++rep) { PH_ARGS;
            pg8::Gemm g{MIX, (const bf16*)(ws + WS_WOUT), NTOK, DM, DM}; pg8::StaticOrder S; S.init(NTOK, DM, nb, bid, 2);
            pg8::EpiResBf16 E{(bf16*)(ws + WS_UT), X, DM, ALPHA};
            pg8::gemm_phase<pg8::EpiResBf16, pg8::StaticOrder, GP_ALIGN, GP_SP2>(lds, g, S, E);
        }
        SEAM(pb + 4);
        if (IN(pb + 5)) for (int rep = 0; rep < REPS(7); ++rep) { PH_ARGS; PH_IDS; for (int m = gw; m < NTOK; m += ngw) ln_row_bf<true>((const bf16*)(ws + WS_UT) + (size_t)m * DM, kp->in[20] + l * DM, kp->in[21] + l * DM, MIX + (size_t)m * DM, lane); }
        SEAM(pb + 5);
        if (IN(pb + 6)) for (int rep = 0; rep < REPS(8); ++rep) { PH_ARGS;
            pg8::Gemm g{MIX, (const bf16*)(ws + WS_WGU), NTOK, 2 * DFF, DM}; pg8::StaticOrder S; S.init(NTOK, 2 * DFF, nb, bid);
            pg8::EpiSwiGLU E{(bf16*)(ws + WS_H), DFF};
            pg8::gemm_phase<pg8::EpiSwiGLU, pg8::StaticOrder, GP_ALIGN, GP_SP2>(lds, g, S, E);
        }
        SEAM(pb + 6);
        if (IN(pb + 7)) for (int rep = 0; rep < REPS(9); ++rep) { PH_ARGS;
            pg8::Gemm g{(const bf16*)(ws + WS_H), (const bf16*)(ws + WS_WDN), NTOK, DM, DFF}; pg8::StaticOrder S; S.init(NTOK, DM, nb, bid, 2);
            pg8::EpiResBf16 E{X, MIX, DM, ALPHA};
            pg8::gemm_phase<pg8::EpiResBf16, pg8::StaticOrder, GP_ALIGN, GP_SP2>(lds, g, S, E);
        }
        SEAM(pb + 7);
        if (IN(pb + 8)) for (int rep = 0; rep < (l == 0 ? REPS(10) : 1); ++rep) { PH_ARGS; PH_IDS;
            if (l == 0) {
                for (int m = gw; m < NTOK; m += ngw) ln_row_bf<true>(X + (size_t)m * DM, kp->in[25] + l * DM, kp->in[26] + l * DM, X + (size_t)m * DM, lane);
                __syncthreads();
                convert_weights(kp, 1, lds, gw, ngw, wave, lane);
                __syncthreads();
                fold_fnet(kp, 1, lds, bid, nb);
            } else {
                for (int m = gw; m < NTOK; m += ngw) ln_row_bf<false>(X + (size_t)m * DM, kp->in[25] + l * DM, kp->in[26] + l * DM, kp->out + (size_t)m * DM, lane);
            }
        }
        if (l == 0) SEAM(pb + 8);
    }
    if (TM_MASK) { const unsigned long long _t = __builtin_amdgcn_s_memrealtime(); if ((TM_MASK >> 10) & 1) tm_acc += _t - tm_t0;
        while (__builtin_amdgcn_s_memrealtime() - _t < tm_acc) __builtin_amdgcn_s_sleep(8); }
#ifdef BAR_PROBE
    if (multi) { for (int i = 0; i < BAR_PROBE; ++i) xcd_barrier(bar); }
#endif
#ifdef CLK_PROBE
    { const unsigned long long c1 = __builtin_readcyclecounter(), r1 = __builtin_amdgcn_s_memrealtime();
      const unsigned long long ticks = (c1 - ck_c0) * 10000ull / (r1 - ck_r0); while (__builtin_amdgcn_s_memrealtime() - r1 < ticks) __builtin_amdgcn_s_sleep(8); }
#endif
#undef IN
#undef SEAM
}

extern "C" void kernel_launch(void* const* d_in, const int* in_sizes, int n_in, void* d_out, int out_size, void* d_ws, size_t ws_size, hipStream_t stream) {
    static int grid = 0;
    if (grid == 0) {
        if (n_in != 27 || out_size != 2 * TOK_S0 * DM || ws_size < WS_END) { fprintf(stderr, "kernel_launch: unexpected shapes (n_in %d, out %d, ws %zu)\n", n_in, out_size, ws_size); grid = -1; return; }
        int dev = 0, cus = 0, per_cu = 0;
        if (hipGetDevice(&dev) != hipSuccess || hipDeviceGetAttribute(&cus, hipDeviceAttributeMultiprocessorCount, dev) != hipSuccess) { grid = -1; return; }
        if (hipFuncSetAttribute((const void*)mega_fwd, hipFuncAttributeMaxDynamicSharedMemorySize, LDS_BYTES) != hipSuccess) { fprintf(stderr, "kernel_launch: hipFuncSetAttribute failed\n"); grid = -1; return; }
        if (hipOccupancyMaxActiveBlocksPerMultiprocessor(&per_cu, (const void*)mega_fwd, 512, LDS_BYTES) != hipSuccess || per_cu < 1) fprintf(stderr, "kernel_launch: occupancy query reports %d\n", per_cu);
        (void)hipGetLastError();
        grid = cus;
    }
    if (grid < 0) return;
    (void)in_sizes;
    if (hipMemsetAsync((char*)d_ws + WS_CTL, 0, CTL_ZERO_BYTES, stream) != hipSuccess) return;
    Params p{};
    for (int i = 0; i < 27; ++i) p.in[i] = (const float*)d_in[i];
    p.out = (float*)d_out; p.ws = (unsigned char*)d_ws;
#if MK_MULTI
    for (int k = 0; k < NPH; ++k) { p.ph_lo = k; p.ph_hi = k + 1; hipLaunchKernelGGL(mega_fwd, dim3(grid), dim3(512), LDS_BYTES, stream, p); }
#else
    p.ph_lo = 0; p.ph_hi = NPH;
    hipLaunchKernelGGL(mega_fwd, dim3(grid), dim3(512), LDS_BYTES, stream, p);
#endif
}
```

```cpp
#include <hip/hip_runtime.h>
#include <cstdio>
#include <cmath>
#define MK_MULTI 0
namespace pg8 {
#define PG8_LAS __attribute__((address_space(3)))
typedef unsigned short bf16_t;
typedef short bf16x8 __attribute__((ext_vector_type(8)));
typedef float f32x4 __attribute__((ext_vector_type(4)));
typedef unsigned u32x4 __attribute__((ext_vector_type(4)));
constexpr int BM = 256, BK = 64, HALF = 128, HTB = HALF * BK * 2  , STAGE_BYTES = 8 * HTB, NXCD = 8, WGM = 8;

__host__ __device__ __forceinline__ int lds_byte(int r, int c) { const int st = (r >> 4) * 2 + (c >> 5), rr = r & 15, cc = c & 31, ob = rr * 64 + cc * 2; return st * 1024 + (ob ^ (((ob >> 9) & 1) << 5)); }
__host__ __device__ __forceinline__ void stage_rc(int b, int& R, int& C) { const int st = b / 1024, sb = b % 1024, swz = sb ^ (((sb >> 9) & 1) << 5); R = (st >> 1) * 16 + swz / 64; C = (st & 1) * 32 + (swz % 64) / 2; }
__host__ __device__ __forceinline__ int perm32(int rho) { const int n = rho >> 4, i = rho & 15; return 8 * (i >> 2) + 4 * n + (i & 3); }

struct Unit { int pm, pn; };
struct Gemm { const bf16_t* A; const bf16_t* Bt; int M, N, K; };

struct StaticOrder {
    int nM, nN, nwg, G, c, wgm;
    __host__ __device__ void init(int M, int N, int G_, int c_, int wgm_ = WGM) { nM = M / BM; nN = N / BM; nwg = nM * nN; G = G_; c = c_; wgm = wgm_; }
    __host__ __device__ bool next(int i, Unit& u) const {
        const long L = (long)i * G + c; if (L >= nwg) return false;
        int wgid = (int)L; { const int q = nwg / NXCD, r = nwg % NXCD, xcd = wgid % NXCD, off = wgid / NXCD; wgid = (xcd < r ? xcd * (q + 1) : r * (q + 1) + (xcd - r) * q) + off; }
        const int nig = wgm * nN, gid = wgid / nig, fm = gid * wgm, gsz = (nM - fm) < wgm ? (nM - fm) : wgm;
        u.pm = fm + ((wgid % nig) % gsz); u.pn = (wgid % nig) / gsz; return true;
    }
    __device__ __forceinline__ void a_ready(const Unit&) const {}
    __device__ __forceinline__ void done(const Unit&) const {}
};
struct CountedOrder : StaticOrder {
    const unsigned* ready; unsigned need; unsigned* tmo;
    __device__ __forceinline__ void a_ready(const Unit& u) const {
        if (threadIdx.x < 64) {
            const unsigned long long t0 = __builtin_amdgcn_s_memrealtime(); unsigned polls = 0;
            while ((unsigned)__builtin_amdgcn_readfirstlane(__hip_atomic_load(ready + 64 * u.pm, __ATOMIC_RELAXED, __HIP_MEMORY_SCOPE_AGENT)) < need) {
                if ((++polls & 255u) == 0u && __builtin_amdgcn_readfirstlane(__hip_atomic_load(tmo, __ATOMIC_RELAXED, __HIP_MEMORY_SCOPE_AGENT)) != 0u) break;
                if (__builtin_amdgcn_s_memrealtime() - t0 > 2000000ull) {
                    if (threadIdx.x == 0) { unsigned expect = 0u; __hip_atomic_compare_exchange_strong(tmo + 1, &expect, 0x600u | (unsigned)(u.pm & 0xff), __ATOMIC_RELAXED, __ATOMIC_RELAXED, __HIP_MEMORY_SCOPE_AGENT); __hip_atomic_store(tmo, 1u, __ATOMIC_RELAXED, __HIP_MEMORY_SCOPE_AGENT); }
                    break; }
                __builtin_amdgcn_s_sleep(2); }
            __builtin_amdgcn_fence(__ATOMIC_ACQUIRE, "agent");
            asm volatile("s_waitcnt vmcnt(0)" ::: "memory");
        }
#if !defined(BROKEN_HOOK_NO_BARRIER)
        asm volatile("" ::: "memory"); __builtin_amdgcn_s_barrier(); asm volatile("" ::: "memory");
#endif
    }
};

__device__ __forceinline__ unsigned cvt_pk_bf16(float lo, float hi) { unsigned r; asm volatile("v_cvt_pk_bf16_f32 %0, %1, %2" : "=v"(r) : "v"(lo), "v"(hi)); return r; }
typedef float f32x2 __attribute__((ext_vector_type(2)));
__device__ __forceinline__ f32x2 gelu_pk(f32x2 v) {
    const f32x2 av = __builtin_elementwise_abs(v), d = av * 0.2316418882f + 1.0f;
    f32x2 t; t.x = __builtin_amdgcn_rcpf(d.x); t.y = __builtin_amdgcn_rcpf(d.y);
    f32x2 q = t * 0.5307027145f + (-0.7265760135f); q = q * t + 0.7107068705f; q = q * t + (-0.142248368f); q = q * t + 0.127414796f; q = q * t;
    const f32x2 s = (v * v) * (-0.72134752044f);
    f32x2 e; e.x = __builtin_amdgcn_exp2f(s.x); e.y = __builtin_amdgcn_exp2f(s.y);
    const f32x2 m = v * (q * e), r = v - m;
    f32x2 o; o.x = v.x < 0.f ? m.x : r.x; o.y = v.y < 0.f ? m.y : r.y; return o;
}

struct EpiF32 {
    static constexpr bool PERM = false, AFTER_DRAIN = false;
    float* C; int ldc; const float* bias;
    __device__ __forceinline__ void operator()(const f32x4 (&acc)[2][2][4][2], const Unit& u, int wr, int wc, int fr, int fq) const {
        const int row0 = u.pm * BM + wr * 64 + fr, col0 = u.pn * BM + wc * 32 + 4 * fq;
        f32x4 bv[2][2];
#pragma unroll
        for (int bj = 0; bj < 2; ++bj)
#pragma unroll
            for (int n = 0; n < 2; ++n) bv[bj][n] = bias ? *(const f32x4*)(bias + col0 + bj * HALF + n * 16) : (f32x4){0.f, 0.f, 0.f, 0.f};
#pragma unroll
        for (int ai = 0; ai < 2; ++ai)
#pragma unroll
            for (int m = 0; m < 4; ++m) { float* rowp = C + (size_t)(row0 + ai * HALF + m * 16) * ldc + col0;
#pragma unroll
                for (int bj = 0; bj < 2; ++bj)
#pragma unroll
                    for (int n = 0; n < 2; ++n) *(f32x4*)(rowp + bj * HALF + n * 16) = acc[ai][bj][m][n] + bv[bj][n]; }
    }
};
template <int ACT  > struct EpiBf16 {
    static constexpr bool PERM = true, AFTER_DRAIN = false;
    bf16_t* O; int ldc; const float* bias; int split_cols; size_t split_stride;
    __device__ __forceinline__ void operator()(const f32x4 (&acc)[2][2][4][2], const Unit& u, int wr, int wc, int fr, int fq) const {
        const int row0 = u.pm * BM + wr * 64 + fr; int colt = u.pn * BM; bf16_t* base = O;
        if (split_cols) { const int t = colt / split_cols; base += (size_t)t * split_stride; colt -= t * split_cols; }
        const int col0 = colt + wc * 32 + 8 * fq, bcol0 = u.pn * BM + wc * 32 + 8 * fq;
        f32x4 bv[2][2];
#pragma unroll
        for (int bj = 0; bj < 2; ++bj)
#pragma unroll
            for (int n = 0; n < 2; ++n) bv[bj][n] = bias ? *(const f32x4*)(bias + bcol0 + bj * HALF + 4 * n) : (f32x4){0.f, 0.f, 0.f, 0.f};
#pragma unroll
        for (int ai = 0; ai < 2; ++ai)
#pragma unroll
            for (int m = 0; m < 4; ++m) { bf16_t* rowp = base + (size_t)(row0 + ai * HALF + m * 16) * ldc + col0;
#pragma unroll
                for (int bj = 0; bj < 2; ++bj) { f32x4 v0 = acc[ai][bj][m][0] + bv[bj][0], v1 = acc[ai][bj][m][1] + bv[bj][1];
                    if (ACT == 1) { f32x2 a = gelu_pk((f32x2){v0[0], v0[1]}), b = gelu_pk((f32x2){v0[2], v0[3]}), c = gelu_pk((f32x2){v1[0], v1[1]}), d = gelu_pk((f32x2){v1[2], v1[3]});
                        v0 = (f32x4){a.x, a.y, b.x, b.y}; v1 = (f32x4){c.x, c.y, d.x, d.y}; }
                    if (ACT == 2) {
#pragma unroll
                        for (int j = 0; j < 4; ++j) { v0[j] = 0.5f * v0[j] * (1.0f + erff(v0[j] * 0.70710678f)); v1[j] = 0.5f * v1[j] * (1.0f + erff(v1[j] * 0.70710678f)); } }
                    u32x4 w; w.x = cvt_pk_bf16(v0[0], v0[1]); w.y = cvt_pk_bf16(v0[2], v0[3]); w.z = cvt_pk_bf16(v1[0], v1[1]); w.w = cvt_pk_bf16(v1[2], v1[3]);
                    *(u32x4*)(rowp + bj * HALF) = w; } }
    }
};

struct PanelStats {
    unsigned* xbuf;
    unsigned* cnt;
    unsigned* tmo;
    int ntn; float eps;
    unsigned code;
    __device__ __forceinline__ bool run(const f32x4 (&v)[2][2][4][2], const Unit& u, int wr, int wc, int fr, int fq, PG8_LAS unsigned char* lds, int wid, int lane) const {
        typedef float f32x2v __attribute__((ext_vector_type(2)));
        PG8_LAS f32x2v* P = (PG8_LAS f32x2v*)lds;
        PG8_LAS f32x2v* S = (PG8_LAS f32x2v*)(lds + 8192);
        PG8_LAS unsigned* flag = (PG8_LAS unsigned*)(lds + 8192 + 2048);
#pragma unroll
        for (int ai = 0; ai < 2; ++ai)
#pragma unroll
            for (int m = 0; m < 4; ++m) {
                float s = 0.f;
#pragma unroll
                for (int bj = 0; bj < 2; ++bj)
#pragma unroll
                    for (int n = 0; n < 2; ++n) { const f32x4 x = v[ai][bj][m][n]; s += (x[0] + x[1]) + (x[2] + x[3]); }
                s += __shfl_xor(s, 16); s += __shfl_xor(s, 32);
                const float mw = s * (1.0f / 64.0f); float q = 0.f;
#pragma unroll
                for (int bj = 0; bj < 2; ++bj)
#pragma unroll
                    for (int n = 0; n < 2; ++n) { const f32x4 d = v[ai][bj][m][n] - mw; q += (d[0] * d[0] + d[1] * d[1]) + (d[2] * d[2] + d[3] * d[3]); }
                q += __shfl_xor(q, 16); q += __shfl_xor(q, 32);
                if (fq == 0) P[(ai * HALF + wr * 64 + m * 16 + fr) * 4 + wc] = (f32x2v){mw, q};
            }
        asm volatile("s_waitcnt lgkmcnt(0)" ::: "memory"); __builtin_amdgcn_s_barrier(); asm volatile("" ::: "memory");
#if defined(BROKEN_NO_WAIT)
        if (blockIdx.x >= 64) { const long long t0 = clock64(); while (clock64() - t0 < 60000) __builtin_amdgcn_s_sleep(8); }
#endif
        const int row = wid * 32 + (lane & 31);
        if (lane < 32) {
            const f32x2v a = P[row * 4 + 0], b = P[row * 4 + 1], c = P[row * 4 + 2], d = P[row * 4 + 3];
            const float mt = (a.x + b.x + c.x + d.x) * 0.25f;
            const float da = a.x - mt, db = b.x - mt, dc = c.x - mt, dd = d.x - mt;
            const float m2 = (a.y + b.y) + (c.y + d.y) + 64.0f * ((da * da + db * db) + (dc * dc + dd * dd));
            unsigned long long* slot = (unsigned long long*)xbuf + ((size_t)(u.pm * BM + row) * 4 + u.pn);
            __hip_atomic_store(slot, ((unsigned long long)__float_as_uint(m2) << 32) | __float_as_uint(mt), __ATOMIC_RELAXED, __HIP_MEMORY_SCOPE_AGENT);
        }
        asm volatile("s_waitcnt vmcnt(0)" ::: "memory");
        if (lane == 0) __hip_atomic_fetch_add(cnt + 64 * u.pm, 1u, __ATOMIC_RELAXED, __HIP_MEMORY_SCOPE_AGENT);
        if (wid == 0) {
            bool dead = false; const unsigned long long t0 = __builtin_amdgcn_s_memrealtime(); const unsigned want = 8u * (unsigned)ntn;
            for (;;) {
#if defined(BROKEN_NO_WAIT)
                break;
#endif
                if ((unsigned)__builtin_amdgcn_readfirstlane(__hip_atomic_load(cnt + 64 * u.pm, __ATOMIC_RELAXED, __HIP_MEMORY_SCOPE_AGENT)) >= want) break;
                if (__builtin_amdgcn_s_memrealtime() - t0 > 2000000ull) {
                    if (lane == 0) { unsigned expect = 0u; __hip_atomic_compare_exchange_strong(tmo + 1, &expect, code | (unsigned)(u.pm & 0xff), __ATOMIC_RELAXED, __ATOMIC_RELAXED, __HIP_MEMORY_SCOPE_AGENT);
                                     __hip_atomic_store(tmo, 1u, __ATOMIC_RELAXED, __HIP_MEMORY_SCOPE_AGENT); }
                    dead = true; break; }
                __builtin_amdgcn_s_sleep(2);
            }
            __builtin_amdgcn_fence(__ATOMIC_ACQUIRE, "agent");
            if (lane == 0) flag[0] = dead ? 1u : 0u;
        }
        asm volatile("s_waitcnt vmcnt(0) lgkmcnt(0)" ::: "memory"); __builtin_amdgcn_s_barrier(); asm volatile("" ::: "memory");
        const bool bad = flag[0] != 0u;
        if (lane < 32) {
            const unsigned long long* slot = (const unsigned long long*)xbuf + (size_t)(u.pm * BM + row) * 4; float mt[4], m2[4]; float ms = 0.f;
#pragma unroll
            for (int t = 0; t < 4; ++t) { if (t < ntn) { const unsigned long long w = __hip_atomic_load(slot + t, __ATOMIC_RELAXED, __HIP_MEMORY_SCOPE_AGENT); mt[t] = __uint_as_float((unsigned)w); m2[t] = __uint_as_float((unsigned)(w >> 32)); } else { mt[t] = 0.f; m2[t] = 0.f; } ms += mt[t]; }
            const float mean = ms / (float)ntn; float q = 0.f;
#pragma unroll
            for (int t = 0; t < 4; ++t) if (t < ntn) { const float dm = mt[t] - mean; q += m2[t] + 256.0f * dm * dm; }
            S[row] = (f32x2v){mean, 1.0f / sqrtf(q / (256.0f * (float)ntn) + eps)};
        }
        asm volatile("s_waitcnt lgkmcnt(0)" ::: "memory"); __builtin_amdgcn_s_barrier(); asm volatile("" ::: "memory");
        return bad;
    }
};
struct EpiLnRes {
    static constexpr bool PERM = false, AFTER_DRAIN = true;
    const float* base; float* out; int ldc; const float* bias; PanelStats st; unsigned poison;
    __device__ __forceinline__ void refuse(size_t i0, size_t stride, int M, int N) const { const float q = __builtin_nanf(""); for (size_t i = i0; i < (size_t)M * N; i += stride) out[(i / N) * ldc + i % N] = q;
        if (i0 == 0) { unsigned expect = 0u; __hip_atomic_compare_exchange_strong(st.tmo + 1, &expect, 0x7f0u, __ATOMIC_RELAXED, __ATOMIC_RELAXED, __HIP_MEMORY_SCOPE_AGENT); __hip_atomic_store(st.tmo, 1u, __ATOMIC_RELAXED, __HIP_MEMORY_SCOPE_AGENT); } }
    __device__ __forceinline__ void fused(f32x4 (&acc)[2][2][4][2], const Unit& u, int wr, int wc, int fr, int fq, PG8_LAS unsigned char* lds, int wid, int lane) const {
        typedef float f32x2v __attribute__((ext_vector_type(2)));
        const PG8_LAS f32x2v* S = (const PG8_LAS f32x2v*)(lds + 8192);
        const int col0 = u.pn * BM + wc * 32 + 4 * fq;
#pragma unroll
        for (int bj = 0; bj < 2; ++bj)
#pragma unroll
            for (int n = 0; n < 2; ++n) { const f32x4 bv = bias ? *(const f32x4*)(bias + col0 + bj * HALF + n * 16) : (f32x4){0.f, 0.f, 0.f, 0.f};
#pragma unroll
                for (int ai = 0; ai < 2; ++ai)
#pragma unroll
                    for (int m = 0; m < 4; ++m) acc[ai][bj][m][n] += bv; }
        const bool bad = st.run(acc, u, wr, wc, fr, fq, lds, wid, lane) || poison != 0u;
        const float qnan = __builtin_nanf("");
#pragma unroll
        for (int ai = 0; ai < 2; ++ai)
#pragma unroll
            for (int m = 0; m < 4; ++m) { const int r = ai * HALF + wr * 64 + m * 16 + fr; const f32x2v sr = S[r]; const size_t off = (size_t)(u.pm * BM + r) * ldc + col0;
#pragma unroll
                for (int bj = 0; bj < 2; ++bj)
#pragma unroll
                    for (int n = 0; n < 2; ++n) { const f32x4 bs = *(const f32x4*)(base + off + bj * HALF + n * 16); f32x4 o = bs + (acc[ai][bj][m][n] - sr.x) * sr.y;
                        if (bad) o = (f32x4){qnan, qnan, qnan, qnan}; *(f32x4*)(out + off + bj * HALF + n * 16) = o; }
                asm volatile("" ::: "memory"); }
    }
};
struct EpiLnResLn {
    static constexpr bool PERM = false, AFTER_DRAIN = true;
    const float* base; float* out; bf16_t* xn; int ldc; const float* bias; PanelStats st1, st2; unsigned poison;
    __device__ __forceinline__ void refuse(size_t i0, size_t stride, int M, int N) const { const float q = __builtin_nanf(""); for (size_t i = i0; i < (size_t)M * N; i += stride) { const size_t o = (i / N) * ldc + i % N; out[o] = q; xn[o] = (bf16_t)0x7fc0u; }
        if (i0 == 0) { unsigned expect = 0u; __hip_atomic_compare_exchange_strong(st1.tmo + 1, &expect, 0x7f0u, __ATOMIC_RELAXED, __ATOMIC_RELAXED, __HIP_MEMORY_SCOPE_AGENT); __hip_atomic_store(st1.tmo, 1u, __ATOMIC_RELAXED, __HIP_MEMORY_SCOPE_AGENT); } }
    __device__ __forceinline__ void fused(f32x4 (&acc)[2][2][4][2], const Unit& u, int wr, int wc, int fr, int fq, PG8_LAS unsigned char* lds, int wid, int lane) const {
        typedef float f32x2v __attribute__((ext_vector_type(2))); typedef unsigned u32x2v __attribute__((ext_vector_type(2)));
        const PG8_LAS f32x2v* S = (const PG8_LAS f32x2v*)(lds + 8192);
        const int col0 = u.pn * BM + wc * 32 + 4 * fq;
#pragma unroll
        for (int bj = 0; bj < 2; ++bj)
#pragma unroll
            for (int n = 0; n < 2; ++n) { const f32x4 bv = bias ? *(const f32x4*)(bias + col0 + bj * HALF + n * 16) : (f32x4){0.f, 0.f, 0.f, 0.f};
#pragma unroll
                for (int ai = 0; ai < 2; ++ai)
#pragma unroll
                    for (int m = 0; m < 4; ++m) acc[ai][bj][m][n] += bv; }
        bool bad = st1.run(acc, u, wr, wc, fr, fq, lds, wid, lane) || poison != 0u;
        const float qnan = __builtin_nanf("");
#pragma unroll
        for (int ai = 0; ai < 2; ++ai)
#pragma unroll
            for (int m = 0; m < 4; ++m) { const int r = ai * HALF + wr * 64 + m * 16 + fr; const f32x2v sr = S[r]; const size_t off = (size_t)(u.pm * BM + r) * ldc + col0;
#pragma unroll
                for (int bj = 0; bj < 2; ++bj)
#pragma unroll
                    for (int n = 0; n < 2; ++n) { const f32x4 bs = *(const f32x4*)(base + off + bj * HALF + n * 16); acc[ai][bj][m][n] = bs + (acc[ai][bj][m][n] - sr.x) * sr.y; }
                asm volatile("" : "+v"(acc[ai][0][m][0]), "+v"(acc[ai][0][m][1]), "+v"(acc[ai][1][m][0]), "+v"(acc[ai][1][m][1]));
                if (m & 1) asm volatile("" ::: "memory"); }
        const bool bad1 = bad;
        bad = st2.run(acc, u, wr, wc, fr, fq, lds, wid, lane) || bad;
#pragma unroll
        for (int ai = 0; ai < 2; ++ai)
#pragma unroll
            for (int m = 0; m < 4; ++m) { const int r = ai * HALF + wr * 64 + m * 16 + fr; const f32x2v sr = S[r]; const size_t off = (size_t)(u.pm * BM + r) * ldc + col0;
#pragma unroll
                for (int bj = 0; bj < 2; ++bj)
#pragma unroll
                    for (int n = 0; n < 2; ++n) { const f32x4 x1 = acc[ai][bj][m][n]; *(f32x4*)(out + off + bj * HALF + n * 16) = bad1 ? (f32x4){qnan, qnan, qnan, qnan} : x1;
                        const f32x4 o = (x1 - sr.x) * sr.y; u32x2v w; w.x = cvt_pk_bf16(o[0], o[1]); w.y = cvt_pk_bf16(o[2], o[3]);
                        if (bad) { w.x = 0x7fc07fc0u; w.y = 0x7fc07fc0u; } *(u32x2v*)(xn + off + bj * HALF + n * 16) = w; }
                asm volatile("" ::: "memory"); }
    }
};

template <class Epi, class Sched, bool ALIGN_EPI = false, bool SP2 = false>
__device__ __forceinline__ void gemm_phase(PG8_LAS unsigned char* lds, const Gemm g, const Sched& S, const Epi& E) {
    int tid = threadIdx.x; asm volatile("" : "+v"(tid));
    const int wid = __builtin_amdgcn_readfirstlane(tid >> 6), lane = tid & 63, wr = wid >> 2, wc = wid & 3, fr = lane & 15, fq = lane >> 4;
    const int K = g.K, nt = K / BK;
    unsigned voffA[2], voffB[2];
#pragma unroll
    for (int i = 0; i < 2; ++i) { int R, C; stage_rc(tid * 16 + i * 8192, R, C); const int Rb = Epi::PERM ? ((R & ~31) + perm32(R & 31)) : R;
        voffA[i] = (unsigned)(R * K + C) * 2u; voffB[i] = (unsigned)(Rb * K + C) * 2u; }
    const size_t kstep = (size_t)(BK * 2);
    const size_t hstep = (size_t)HALF * K * 2;
    const size_t tstep = 2 * hstep;
    const unsigned ldsw = (unsigned)wid * 1024u;
    const int aoff = lds_byte(wr * 64 + fr, fq * 8), boff = lds_byte(wc * 32 + fr, fq * 8);
#define PG8_SA(b, h) (((b) * 2 + (h)) * HTB)
#define PG8_SB(b, h) ((4 + (b) * 2 + (h)) * HTB)
#define PG8_STAGE(bufoff, gbase, voff) do { _Pragma("unroll") for (int _i = 0; _i < 2; ++_i) \
        __builtin_amdgcn_global_load_lds((const unsigned*)((const char*)(gbase) + (voff)[_i]), (PG8_LAS unsigned*)(lds + (bufoff) + ldsw + _i * 8192), 16, 0, 0); } while (0)
#define PG8_LDA(dst, b, h) do { _Pragma("unroll") for (int m = 0; m < 4; ++m) _Pragma("unroll") for (int k = 0; k < 2; ++k) dst[m][k] = *(const PG8_LAS bf16x8*)(lds + PG8_SA(b, h) + aoff + m * 2048 + k * 1024); } while (0)
#define PG8_LDB(dst, b, h) do { _Pragma("unroll") for (int n = 0; n < 2; ++n) _Pragma("unroll") for (int k = 0; k < 2; ++k) dst[n][k] = *(const PG8_LAS bf16x8*)(lds + PG8_SB(b, h) + boff + n * 2048 + k * 1024); } while (0)
#define PG8_MMA(ai, bj, At, Bt) do { __builtin_amdgcn_s_setprio(1); _Pragma("unroll") for (int m = 0; m < 4; ++m) _Pragma("unroll") for (int n = 0; n < 2; ++n) _Pragma("unroll") for (int k = 0; k < 2; ++k) \
        acc[ai][bj][m][n] = __builtin_amdgcn_mfma_f32_16x16x32_bf16(Bt[n][k], At[m][k], acc[ai][bj][m][n], 0, 0, 0); __builtin_amdgcn_s_setprio(0); } while (0)
#define PG8_WAIT_V(n) asm volatile("s_waitcnt vmcnt(" #n ")" ::: "memory")
#define PG8_WAIT_L(n) asm volatile("s_waitcnt lgkmcnt(" #n ")" ::: "memory")
#define PG8_BAR __builtin_amdgcn_s_barrier()
#define PG8_SCHED __builtin_amdgcn_sched_barrier(0)
    Unit cur, nxt; int ui = 0;
    if (!S.next(0, cur)) return;
    f32x4 acc[2][2][4][2];
#pragma unroll
    for (int a = 0; a < 2; ++a)
#pragma unroll
        for (int b = 0; b < 2; ++b)
#pragma unroll
            for (int m = 0; m < 4; ++m)
#pragma unroll
                for (int n = 0; n < 2; ++n) acc[a][b][m][n] = (f32x4){0.f, 0.f, 0.f, 0.f};
    bf16x8 At[4][2], B0[2][2], B1[2][2];
    const char* cA = (const char*)g.A + (size_t)cur.pm * tstep; const char* cB = (const char*)g.Bt + (size_t)cur.pn * tstep;
    S.a_ready(cur);
    if constexpr (SP2) {
        PG8_STAGE(PG8_SB(0, 0), cB, voffB); PG8_STAGE(PG8_SB(0, 1), cB + hstep, voffB); PG8_STAGE(PG8_SA(0, 0), cA, voffA); PG8_STAGE(PG8_SA(0, 1), cA + hstep, voffA);
        if (wr == 1) PG8_BAR;
        PG8_WAIT_V(2); PG8_BAR;
        PG8_STAGE(PG8_SB(1, 0), cB + kstep, voffB); PG8_STAGE(PG8_SA(1, 0), cA + kstep, voffA); PG8_STAGE(PG8_SB(1, 1), cB + hstep + kstep, voffB);
        PG8_WAIT_V(6); PG8_BAR;
    } else {
        PG8_STAGE(PG8_SB(0, 0), cB, voffB); PG8_STAGE(PG8_SA(0, 0), cA, voffA); PG8_STAGE(PG8_SB(0, 1), cB + hstep, voffB); PG8_STAGE(PG8_SA(0, 1), cA + hstep, voffA);
        if (wr == 1) PG8_BAR;
        PG8_WAIT_V(4); PG8_BAR;
        PG8_STAGE(PG8_SB(1, 0), cB + kstep, voffB); PG8_STAGE(PG8_SA(1, 0), cA + kstep, voffA); PG8_STAGE(PG8_SB(1, 1), cB + hstep + kstep, voffB);
        PG8_WAIT_V(6); PG8_BAR;
    }
    for (;;) {
        const bool has_next = S.next(ui + 1, nxt);
        const char* nA = has_next ? (const char*)g.A + (size_t)nxt.pm * tstep : cA; const char* nB = has_next ? (const char*)g.Bt + (size_t)nxt.pn * tstep : cB;
        for (int t = 0; t < nt; t += 2) {
            const bool last = (t == nt - 2);
            const char* a1 = cA + (size_t)(t + 1) * kstep;
            const char* a2 = last ? nA : cA + (size_t)(t + 2) * kstep; const char* b2 = last ? nB : cB + (size_t)(t + 2) * kstep;
            const char* a3 = a2 + kstep; const char* b3 = b2 + kstep;
            if (last && has_next) S.a_ready(nxt);
            if constexpr (SP2) {
            PG8_LDB(B0, 0, 0); PG8_LDB(B1, 0, 1); PG8_SCHED; PG8_LDA(At, 0, 0); PG8_STAGE(PG8_SA(1, 1), a1 + hstep, voffA);
            PG8_WAIT_V(8); PG8_WAIT_L(0); PG8_BAR; PG8_MMA(0, 0, At, B0); PG8_MMA(0, 1, At, B1); PG8_BAR; PG8_SCHED;
            PG8_LDA(At, 0, 1); PG8_STAGE(PG8_SB(0, 0), b2, voffB); PG8_STAGE(PG8_SB(0, 1), b2 + hstep, voffB); PG8_STAGE(PG8_SA(0, 0), a2, voffA);
            PG8_WAIT_V(8); PG8_WAIT_L(0); PG8_BAR; PG8_MMA(1, 0, At, B0); PG8_MMA(1, 1, At, B1); PG8_BAR; PG8_SCHED;
            PG8_LDB(B0, 1, 0); PG8_LDB(B1, 1, 1); PG8_SCHED; PG8_LDA(At, 1, 0); PG8_STAGE(PG8_SA(0, 1), a2 + hstep, voffA);
            PG8_WAIT_V(8); PG8_WAIT_L(0); PG8_BAR; PG8_MMA(0, 0, At, B0); PG8_MMA(0, 1, At, B1); PG8_BAR; PG8_SCHED;
            PG8_LDA(At, 1, 1); PG8_STAGE(PG8_SB(1, 0), b3, voffB); PG8_STAGE(PG8_SB(1, 1), b3 + hstep, voffB); PG8_STAGE(PG8_SA(1, 0), a3, voffA);
            PG8_WAIT_V(8); PG8_WAIT_L(0); PG8_BAR; PG8_MMA(1, 0, At, B0); PG8_MMA(1, 1, At, B1); PG8_BAR; PG8_SCHED;
            } else {
            PG8_LDB(B0, 0, 0); PG8_SCHED; PG8_LDA(At, 0, 0); PG8_STAGE(PG8_SA(1, 1), a1 + hstep, voffA);
            PG8_WAIT_L(8); PG8_BAR; PG8_WAIT_L(0); PG8_MMA(0, 0, At, B0); PG8_BAR; PG8_SCHED;
            PG8_LDB(B1, 0, 1); PG8_STAGE(PG8_SB(0, 0), b2, voffB);
            PG8_BAR; PG8_WAIT_L(0); PG8_MMA(0, 1, At, B1); PG8_BAR;
            PG8_LDA(At, 0, 1); PG8_STAGE(PG8_SA(0, 0), a2, voffA);
            PG8_BAR; PG8_WAIT_L(0); PG8_MMA(1, 0, At, B0); PG8_BAR; PG8_SCHED;
            PG8_STAGE(PG8_SB(0, 1), b2 + hstep, voffB);
            PG8_WAIT_V(6); PG8_BAR; PG8_MMA(1, 1, At, B1); PG8_BAR;
            PG8_LDB(B0, 1, 0); PG8_SCHED; PG8_LDA(At, 1, 0); PG8_STAGE(PG8_SA(0, 1), a2 + hstep, voffA);
            PG8_WAIT_L(8); PG8_BAR; PG8_WAIT_L(0); PG8_MMA(0, 0, At, B0); PG8_BAR; PG8_SCHED;
            PG8_LDB(B1, 1, 1); PG8_STAGE(PG8_SB(1, 0), b3, voffB);
            PG8_BAR; PG8_WAIT_L(0); PG8_MMA(0, 1, At, B1); PG8_BAR;
            PG8_LDA(At, 1, 1); PG8_STAGE(PG8_SA(1, 0), a3, voffA);
            PG8_BAR; PG8_WAIT_L(0); PG8_MMA(1, 0, At, B0); PG8_BAR; PG8_SCHED;
            PG8_STAGE(PG8_SB(1, 1), b3 + hstep, voffB);
            PG8_WAIT_V(6); PG8_BAR; PG8_MMA(1, 1, At, B1); PG8_BAR;
            }
        }
        if constexpr (ALIGN_EPI) { if (wr == 0) PG8_BAR; }
        if constexpr (!Epi::AFTER_DRAIN) { E(acc, cur, wr, wc, fr, fq); S.done(cur); }
        if (!has_next) break;
#pragma unroll
        for (int a = 0; a < 2; ++a)
#pragma unroll
            for (int b = 0; b < 2; ++b)
#pragma unroll
                for (int m = 0; m < 4; ++m)
#pragma unroll
                    for (int n = 0; n < 2; ++n) acc[a][b][m][n] = (f32x4){0.f, 0.f, 0.f, 0.f};
        cur = nxt; cA = nA; cB = nB; ++ui;
        if constexpr (ALIGN_EPI) { if (wr == 1) PG8_BAR; }
    }
    PG8_WAIT_V(0);
    if constexpr (!ALIGN_EPI) { if (wr == 0) PG8_BAR; }
    PG8_BAR;
    if constexpr (Epi::AFTER_DRAIN) { E.fused(acc, cur, wr, wc, fr, fq, lds, wid, lane); S.done(cur); }
#undef PG8_SA
#undef PG8_SB
#undef PG8_STAGE
#undef PG8_LDA
#undef PG8_LDB
#undef PG8_MMA
#undef PG8_WAIT_V
#undef PG8_WAIT_L
#undef PG8_BAR
#undef PG8_SCHED
}
}
namespace pg8 {
__device__ __forceinline__ float bflo(unsigned w) { return __uint_as_float(w << 16); }
__device__ __forceinline__ float bfhi(unsigned w) { return __uint_as_float(w & 0xffff0000u); }
struct EpiResF32 {
    static constexpr bool PERM = true, AFTER_DRAIN = false;
    float* C; const bf16_t* R; int ldc; float alpha;
    __device__ __forceinline__ void operator()(const f32x4 (&acc)[2][2][4][2], const Unit& u, int wr, int wc, int fr, int fq) const {
        const int row0 = u.pm * BM + wr * 64 + fr, col0 = u.pn * BM + wc * 32 + 8 * fq;
        u32x4 r[2][4][2];
#pragma unroll
        for (int ai = 0; ai < 2; ++ai)
#pragma unroll
            for (int m = 0; m < 4; ++m)
#pragma unroll
                for (int bj = 0; bj < 2; ++bj) r[ai][m][bj] = *(const u32x4*)(R + (size_t)(row0 + ai * HALF + m * 16) * ldc + col0 + bj * HALF);
#pragma unroll
        for (int ai = 0; ai < 2; ++ai)
#pragma unroll
            for (int m = 0; m < 4; ++m) { const size_t off = (size_t)(row0 + ai * HALF + m * 16) * ldc + col0;
#pragma unroll
                for (int bj = 0; bj < 2; ++bj) { const u32x4 rr = r[ai][m][bj];
                    f32x4 v0 = acc[ai][bj][m][0], v1 = acc[ai][bj][m][1];
                    v0[0] += alpha * bflo(rr.x); v0[1] += alpha * bfhi(rr.x); v0[2] += alpha * bflo(rr.y); v0[3] += alpha * bfhi(rr.y);
                    v1[0] += alpha * bflo(rr.z); v1[1] += alpha * bfhi(rr.z); v1[2] += alpha * bflo(rr.w); v1[3] += alpha * bfhi(rr.w);
                    *(f32x4*)(C + off + bj * HALF) = v0; *(f32x4*)(C + off + bj * HALF + 4) = v1; } }
    }
};
struct EpiResBf16 {
    static constexpr bool PERM = true, AFTER_DRAIN = false;
    bf16_t* C; const bf16_t* R; int ldc; float alpha;
    __device__ __forceinline__ void operator()(const f32x4 (&acc)[2][2][4][2], const Unit& u, int wr, int wc, int fr, int fq) const {
        const int row0 = u.pm * BM + wr * 64 + fr, col0 = u.pn * BM + wc * 32 + 8 * fq;
        u32x4 r[2][4][2];
#pragma unroll
        for (int ai = 0; ai < 2; ++ai)
#pragma unroll
            for (int m = 0; m < 4; ++m)
#pragma unroll
                for (int bj = 0; bj < 2; ++bj) r[ai][m][bj] = *(const u32x4*)(R + (size_t)(row0 + ai * HALF + m * 16) * ldc + col0 + bj * HALF);
#pragma unroll
        for (int ai = 0; ai < 2; ++ai)
#pragma unroll
            for (int m = 0; m < 4; ++m) { const size_t off = (size_t)(row0 + ai * HALF + m * 16) * ldc + col0;
#pragma unroll
                for (int bj = 0; bj < 2; ++bj) { const u32x4 rr = r[ai][m][bj];
                    const f32x4 v0 = acc[ai][bj][m][0], v1 = acc[ai][bj][m][1];
                    u32x4 w; w.x = cvt_pk_bf16(v0[0] + alpha * bflo(rr.x), v0[1] + alpha * bfhi(rr.x)); w.y = cvt_pk_bf16(v0[2] + alpha * bflo(rr.y), v0[3] + alpha * bfhi(rr.y));
                    w.z = cvt_pk_bf16(v1[0] + alpha * bflo(rr.z), v1[1] + alpha * bfhi(rr.z)); w.w = cvt_pk_bf16(v1[2] + alpha * bflo(rr.w), v1[3] + alpha * bfhi(rr.w));
                    *(u32x4*)(C + off + bj * HALF) = w; } }
    }
};
struct EpiHc {
    static constexpr bool PERM = false, AFTER_DRAIN = false;
    float* C; int ldc;
    __device__ __forceinline__ void operator()(const f32x4 (&acc)[2][2][4][2], const Unit& u, int wr, int wc, int fr, int fq) const {
        const int row0 = u.pm * BM + wr * 64 + fr, col0 = u.pn * BM + wc * 32 + 4 * fq;
        const float dmin = -3.0701134573253946f, dmax = -15.350567286626973f, dstep = (dmax - dmin) / 1023.0f;
#pragma unroll
        for (int bj = 0; bj < 2; ++bj)
#pragma unroll
            for (int n = 0; n < 2; ++n) {
                f32x4 tl;
#pragma unroll
                for (int e = 0; e < 4; ++e) { const int g = col0 + bj * HALF + n * 16 + e; const bool lp = g < 8192; const int t = lp ? g : g - 8192;
                    tl[e] = -1.4426950408889634f * (float)t * (lp ? (1.0f / 8191.0f) : (1.0f / 4095.0f)); }
#pragma unroll
                for (int ai = 0; ai < 2; ++ai)
#pragma unroll
                    for (int m = 0; m < 4; ++m) { const int j = row0 + ai * HALF + m * 16; const float delta = __builtin_fabsf(dmin + (float)(j & 1023) * dstep);
                        f32x4 o;
#pragma unroll
                        for (int e = 0; e < 4; ++e) o[e] = acc[ai][bj][m][n][e] * __builtin_amdgcn_exp2f(tl[e] * delta);
                        *(f32x4*)(C + (size_t)j * ldc + col0 + bj * HALF + n * 16) = o; }
            }
    }
};
struct EpiSwiGLU {
    static constexpr bool PERM = true, AFTER_DRAIN = false;
    bf16_t* O; int ldc;
    __device__ __forceinline__ static float silu_mul(float g, float u) { return g * u * __builtin_amdgcn_rcpf(1.0f + __builtin_amdgcn_exp2f(-1.4426950408889634f * g)); }
    __device__ __forceinline__ void operator()(const f32x4 (&acc)[2][2][4][2], const Unit& u, int wr, int wc, int fr, int fq) const {
        const int row0 = u.pm * BM + wr * 64 + fr, col0 = u.pn * HALF + wc * 32 + 8 * fq;
#pragma unroll
        for (int ai = 0; ai < 2; ++ai)
#pragma unroll
            for (int m = 0; m < 4; ++m) { bf16_t* rowp = O + (size_t)(row0 + ai * HALF + m * 16) * ldc + col0;
                const f32x4 g0 = acc[ai][0][m][0], g1 = acc[ai][0][m][1], u0 = acc[ai][1][m][0], u1 = acc[ai][1][m][1];
                u32x4 w; w.x = cvt_pk_bf16(silu_mul(g0[0], u0[0]), silu_mul(g0[1], u0[1])); w.y = cvt_pk_bf16(silu_mul(g0[2], u0[2]), silu_mul(g0[3], u0[3]));
                w.z = cvt_pk_bf16(silu_mul(g1[0], u1[0]), silu_mul(g1[1], u1[1])); w.w = cvt_pk_bf16(silu_mul(g1[2], u1[2]), silu_mul(g1[3], u1[3]));
                __builtin_nontemporal_store(w, (u32x4*)rowp); }
    }
};
}
#define XB_TMO      128
#define XB_XCNT(j)  (256  + 64 * (j))
#define XB_XSUB(j)  (1280 + 64 * (j))
#define XB_XGEN(j)  (2304 + 64 * (j))
#define XB_TOP      3328
#define XB_TOPGEN   3392
#define XCD_BAR_WORDS 3456
#define XB_SPIN_CAP (1u << 18)
#define LAS __attribute__((address_space(3)))

__device__ __forceinline__ unsigned xb_ld(unsigned* p)              { return __hip_atomic_load(p, __ATOMIC_RELAXED, __HIP_MEMORY_SCOPE_AGENT); }
__device__ __forceinline__ unsigned xb_add(unsigned* p, unsigned v) { return __hip_atomic_fetch_add(p, v, __ATOMIC_RELAXED, __HIP_MEMORY_SCOPE_AGENT); }
__device__ __forceinline__ unsigned xb_xcc_id() { return (unsigned)__builtin_amdgcn_s_getreg((3 << 11) | 20) & 0xFu; }
#define XB_SPIN(cond, bar) do { unsigned _sp = 0; while (cond) { __builtin_amdgcn_s_sleep(1); \
    if ((++_sp & 255u) == 0u) { if (xb_ld(&(bar)[XB_TMO])) break; if (_sp > XB_SPIN_CAP) { atomicAdd(&(bar)[XB_TMO], 1u); break; } } } } while (0)

struct XcdBarrier {
    unsigned* bar; unsigned x;
    volatile LAS unsigned* st;
};

__device__ __forceinline__ XcdBarrier xcd_barrier_post(unsigned* bar, volatile LAS unsigned* st) {
    XcdBarrier b; b.bar = bar; b.x = xb_xcc_id(); b.st = st;
    if (threadIdx.x == 0) (void)xb_add(&bar[XB_XCNT(b.x)], 1u);
    return b;
}
__device__ __forceinline__ void xcd_barrier_complete(unsigned* bar, unsigned x, unsigned& nloc, unsigned& nx) {
    const unsigned G = gridDim.x * gridDim.y * gridDim.z;
    unsigned sum, cnt, mine, sp = 0u;
    for (;;) {
        sum = 0u; cnt = 0u; mine = 0u;
#pragma unroll
        for (unsigned j = 0; j < 16; ++j) { const unsigned c = xb_ld(&bar[XB_XCNT(j)]); sum += c; cnt += (c > 0u) ? 1u : 0u; mine = (j == x) ? c : mine; }
        if (sum == G) break;
        __builtin_amdgcn_s_sleep(1);
        if ((++sp & 255u) == 0u) { if (xb_ld(&bar[XB_TMO])) break; if (sp > XB_SPIN_CAP) { atomicAdd(&bar[XB_TMO], 1u); break; } }
    }
    nloc = mine > 0u ? mine : 1u; nx = cnt > 0u ? cnt : 1u;
}

__device__ __forceinline__ void xcd_barrier(const XcdBarrier& b) {
    asm volatile("s_waitcnt vmcnt(0)" ::: "memory");
    __syncthreads();
    if (threadIdx.x == 0) {
        unsigned* bar = b.bar;
        __builtin_amdgcn_s_waitcnt(0);
        unsigned nloc = b.st[0], nx = b.st[1];
        if (nloc == 0u) { xcd_barrier_complete(bar, b.x, nloc, nx); b.st[0] = nloc; b.st[1] = nx; }
        const unsigned old = xb_add(&bar[XB_XSUB(b.x)], 1u);
        const unsigned gen = old / nloc;
        if (old + 1u == (gen + 1u) * nloc) {
            __builtin_amdgcn_fence(__ATOMIC_RELEASE, "agent");
            asm volatile("s_waitcnt vmcnt(0)" ::: "memory");
            const unsigned og = xb_add(&bar[XB_TOP], 1u);
            const unsigned tg = og / nx;
            if (og + 1u == (tg + 1u) * nx) xb_add(&bar[XB_TOPGEN], 1u);
            else XB_SPIN(xb_ld(&bar[XB_TOPGEN]) == tg, bar);
            __builtin_amdgcn_fence(__ATOMIC_ACQUIRE, "agent");
            xb_add(&bar[XB_XGEN(b.x)], 1u);
            asm volatile("s_waitcnt vmcnt(0)" ::: "memory");
        } else {
            XB_SPIN(xb_ld(&bar[XB_XGEN(b.x)]) == gen, bar);
            __builtin_amdgcn_fence(__ATOMIC_ACQUIRE, "agent");
            asm volatile("s_waitcnt vmcnt(0)" ::: "memory");
        }
    }
    __syncthreads();
}

#ifndef HOST_TEST
#define FHD __device__ __forceinline__
#define SIN2PI(x) __builtin_amdgcn_sinf(x)
#define COS2PI(x) __builtin_amdgcn_cosf(x)
#define LP LAS
#else
#define FHD inline
#define SIN2PI(x) ((float)sin(6.283185307179586 * (double)(x)))
#define COS2PI(x) ((float)cos(6.283185307179586 * (double)(x)))
#define LP
#endif
typedef float cf __attribute__((ext_vector_type(2)));
FHD cf cmk(float a, float b) { cf r = {a, b}; return r; }
FHD cf cadd(cf a, cf b) { return cmk(a.x + b.x, a.y + b.y); }
FHD cf csub(cf a, cf b) { return cmk(a.x - b.x, a.y - b.y); }
#ifndef HOST_TEST
FHD cf cmul(cf a, cf b) {
    cf t, r;
    asm("v_pk_mul_f32 %0, %1, %2 op_sel:[0,0] op_sel_hi:[0,1]" : "=v"(t) : "v"(a), "v"(b));
    asm("v_pk_fma_f32 %0, %1, %2, %3 op_sel:[1,1,0] op_sel_hi:[1,0,1] neg_lo:[1,0,0]" : "=v"(r) : "v"(a), "v"(b), "v"(t));
    return r;
}
#else
FHD cf cmul(cf a, cf b) { return cmk(a.x * b.x - a.y * b.y, a.x * b.y + a.y * b.x); }
#endif
FHD int PADI(int a) { return a + (a >> 4); }
constexpr int FFT_BUF_CF = 16384 + 1024;

template <bool INV> FHD void dft2(cf& a, cf& b) { const cf s = cadd(a, b), d = csub(a, b); a = s; b = d; }
template <bool INV> FHD void dft4(cf& a, cf& b, cf& c, cf& d) {
    const cf s0 = cadd(a, c), s1 = csub(a, c), s2 = cadd(b, d), s3 = csub(b, d);
    a = cadd(s0, s2); c = csub(s0, s2);
    if (!INV) { b = cmk(s1.x + s3.y, s1.y - s3.x); d = cmk(s1.x - s3.y, s1.y + s3.x); }
    else      { b = cmk(s1.x - s3.y, s1.y + s3.x); d = cmk(s1.x + s3.y, s1.y - s3.x); }
}
#define DR16(r) (4 * ((r) & 3) + ((r) >> 2))
template <bool INV> FHD void dft16(cf (&x)[16]) {
    constexpr float C1 = 0.92387953251128674f, S1 = 0.38268343236508977f, H = 0.70710678118654752f;
#pragma unroll
    for (int k0 = 0; k0 < 4; ++k0) dft4<INV>(x[k0], x[4 + k0], x[8 + k0], x[12 + k0]);
    const float sg = INV ? 1.f : -1.f;
    const cf w1 = cmk(C1, sg * S1), w2 = cmk(H, sg * H), w3 = cmk(S1, sg * C1), w4 = cmk(0.f, sg * 1.f), w6 = cmk(-H, sg * H), w9 = cmk(-C1, -sg * S1);
    x[4 * 1 + 1] = cmul(x[4 * 1 + 1], w1); x[4 * 1 + 2] = cmul(x[4 * 1 + 2], w2); x[4 * 1 + 3] = cmul(x[4 * 1 + 3], w3);
    x[4 * 2 + 1] = cmul(x[4 * 2 + 1], w2); x[4 * 2 + 2] = cmul(x[4 * 2 + 2], w4); x[4 * 2 + 3] = cmul(x[4 * 2 + 3], w6);
    x[4 * 3 + 1] = cmul(x[4 * 3 + 1], w3); x[4 * 3 + 2] = cmul(x[4 * 3 + 2], w6); x[4 * 3 + 3] = cmul(x[4 * 3 + 3], w9);
#pragma unroll
    for (int r0 = 0; r0 < 4; ++r0) dft4<INV>(x[4 * r0], x[4 * r0 + 1], x[4 * r0 + 2], x[4 * r0 + 3]);
}
template <bool INV> FHD void twid16(cf (&w)[16], float frac) {
    float c = COS2PI(frac), s = SIN2PI(frac);
#ifndef HOST_TEST
    asm volatile("s_nop 1" : "+v"(c), "+v"(s));
#endif
    w[1] = cmk(c, INV ? s : -s);
    w[2] = cmul(w[1], w[1]); w[3] = cmul(w[2], w[1]); w[4] = cmul(w[2], w[2]); w[5] = cmul(w[4], w[1]); w[6] = cmul(w[3], w[3]); w[7] = cmul(w[4], w[3]);
    w[8] = cmul(w[4], w[4]); w[9] = cmul(w[8], w[1]); w[10] = cmul(w[5], w[5]); w[11] = cmul(w[8], w[3]); w[12] = cmul(w[6], w[6]); w[13] = cmul(w[8], w[5]);
    w[14] = cmul(w[7], w[7]); w[15] = cmul(w[8], w[7]);
}
#define STG_OFF(k, lgst) (((k) << (lgst)) + ((((k) << (lgst))) >> 4))
template <bool INV, bool NOTW, int LGS> FHD void fft_stage16(LP cf* buf, int id) {
    constexpr int lgst = LGS - 4, st = 1 << lgst; const int blk = id >> lgst, j = id & (st - 1), base = (blk << LGS) + j;
    LP cf* pb = buf + PADI(base);
    cf x[16];
#pragma unroll
    for (int k = 0; k < 16; ++k) x[k] = pb[STG_OFF(k, lgst)];
    if (!INV) {
        dft16<false>(x);
        if (!NOTW) { cf w[16]; twid16<false>(w, (float)j * (1.0f / (float)(1 << LGS)));
#pragma unroll
            for (int r = 1; r < 16; ++r) x[DR16(r)] = cmul(x[DR16(r)], w[r]); }
#pragma unroll
        for (int r = 0; r < 16; ++r) pb[STG_OFF(r, lgst)] = x[DR16(r)];
    } else {
        if (!NOTW) { cf w[16]; twid16<true>(w, (float)j * (1.0f / (float)(1 << LGS)));
#pragma unroll
            for (int r = 1; r < 16; ++r) x[r] = cmul(x[r], w[r]); }
        dft16<true>(x);
#pragma unroll
        for (int r = 0; r < 16; ++r) pb[STG_OFF(r, lgst)] = x[DR16(r)];
    }
}
template <bool INV, int LGS> FHD void fft_stage16_dual(LP cf* bufA, LP cf* bufB, int id) {
    constexpr int lgst = LGS - 4, st = 1 << lgst; const int blk = id >> lgst, j = id & (st - 1), base = (blk << LGS) + j, po = PADI(base);
    LP cf* pa = bufA + po; LP cf* pb = bufB + po;
    cf x[16], y[16];
#pragma unroll
    for (int k = 0; k < 16; ++k) { x[k] = pa[STG_OFF(k, lgst)]; y[k] = pb[STG_OFF(k, lgst)]; }
    cf w[16]; twid16<INV>(w, (float)j * (1.0f / (float)(1 << LGS)));
    if (!INV) {
        dft16<false>(x); dft16<false>(y);
#pragma unroll
        for (int r = 1; r < 16; ++r) { x[DR16(r)] = cmul(x[DR16(r)], w[r]); y[DR16(r)] = cmul(y[DR16(r)], w[r]); }
    } else {
#pragma unroll
        for (int r = 1; r < 16; ++r) { x[r] = cmul(x[r], w[r]); y[r] = cmul(y[r], w[r]); }
        dft16<true>(x); dft16<true>(y);
    }
#pragma unroll
    for (int r = 0; r < 16; ++r) { pa[STG_OFF(r, lgst)] = x[DR16(r)]; pb[STG_OFF(r, lgst)] = y[DR16(r)]; }
}
template <int RL> FHD void fft_mid(LP cf* buf, const cf* K, int id) {
    LP cf* pb = buf + PADI(RL * id);
    cf x[RL];
#pragma unroll
    for (int k = 0; k < RL; ++k) x[k] = pb[k];
    cf kk[RL];
#pragma unroll
    for (int k = 0; k < RL; ++k) kk[k] = K[RL * id + k];
    if constexpr (RL == 4) { dft4<false>(x[0], x[1], x[2], x[3]); } else { dft2<false>(x[0], x[1]); }
#pragma unroll
    for (int k = 0; k < RL; ++k) x[k] = cmul(x[k], kk[k]);
    if constexpr (RL == 4) { dft4<true>(x[0], x[1], x[2], x[3]); } else { dft2<true>(x[0], x[1]); }
#pragma unroll
    for (int k = 0; k < RL; ++k) pb[k] = x[k];
}
template <int RL> FHD void fft_mid_pre(LP cf* buf, const cf (&kk)[RL], int id) {
    LP cf* pb = buf + PADI(RL * id);
    cf x[RL];
#pragma unroll
    for (int k = 0; k < RL; ++k) x[k] = pb[k];
    if constexpr (RL == 4) { dft4<false>(x[0], x[1], x[2], x[3]); } else { dft2<false>(x[0], x[1]); }
#pragma unroll
    for (int k = 0; k < RL; ++k) x[k] = cmul(x[k], kk[k]);
    if constexpr (RL == 4) { dft4<true>(x[0], x[1], x[2], x[3]); } else { dft2<true>(x[0], x[1]); }
#pragma unroll
    for (int k = 0; k < RL; ++k) pb[k] = x[k];
}
FHD int pos_to_freq(int p, int lgN) {
    const int lgRL = lgN - 12;
    const int r1 = p >> (lgN - 4), r2 = (p >> (lgN - 8)) & 15, r3 = (p >> lgRL) & 15, r4 = p & ((1 << lgRL) - 1);
    return r1 + 16 * r2 + 256 * r3 + 4096 * r4;
}
FHD int freq_to_pos(int k, int lgN) {
    const int lgRL = lgN - 12;
    const int r1 = k & 15, r2 = (k >> 4) & 15, r3 = (k >> 8) & 15, r4 = k >> 12;
    return (r1 << (lgN - 4)) + (r2 << (lgN - 8)) + (r3 << lgRL) + r4;
}
constexpr int NT = 512;
typedef unsigned short bf16raw;
FHD float bf2f(bf16raw b) { unsigned u = ((unsigned)b) << 16; float f; __builtin_memcpy(&f, &u, 4); return f; }
FHD bf16raw f2bf(float f) { unsigned u; __builtin_memcpy(&u, &f, 4); u += 0x7fffu + ((u >> 16) & 1u); return (bf16raw)(u >> 16); }
#ifndef HOST_TEST
typedef float f32x2_t __attribute__((ext_vector_type(2)));
typedef __bf16 bf16x2_t __attribute__((ext_vector_type(2)));
__device__ __forceinline__ unsigned PK2(float lo, float hi) { const f32x2_t v = {lo, hi}; return __builtin_bit_cast(unsigned, __builtin_convertvector(v, bf16x2_t)); }
#else
inline unsigned PK2(float lo, float hi) { return (unsigned)f2bf(lo) | ((unsigned)f2bf(hi) << 16); }
#endif

typedef float f32v8 __attribute__((ext_vector_type(8)));
typedef float f32v16 __attribute__((ext_vector_type(16)));
template <int E> struct VecT;
template <> struct VecT<8> { typedef f32v8 type; };
template <> struct VecT<16> { typedef f32v16 type; };
FHD float bflo_(unsigned w) { unsigned u = w << 16; float f; __builtin_memcpy(&f, &u, 4); return f; }
FHD float bfhi_(unsigned w) { unsigned u = w & 0xffff0000u; float f; __builtin_memcpy(&f, &u, 4); return f; }
struct RawRow { uint4 q0, q1; unsigned um, up; };
template <int E> FHD RawRow raw_load(const bf16raw* row, int L, int t0) {
    static_assert(E == 8 || E == 16, "E");
    RawRow r;
    r.q0 = *(const uint4*)(row + t0);
    if constexpr (E == 16) r.q1 = *(const uint4*)(row + t0 + 8); else r.q1 = r.q0;
    r.um = (t0 > 0) ? ((unsigned)row[t0 - 1] << 16) : 0u;
    r.up = (t0 + E < L) ? ((unsigned)row[t0 + E] << 16) : 0u;
    return r;
}
template <int E> FHD void conv_apply(const RawRow& r, float w0, float w1, float w2, float bias, typename VecT<E>::type& out) {
    float um, up; __builtin_memcpy(&um, &r.um, 4); __builtin_memcpy(&up, &r.up, 4);
    const uint4 q0 = r.q0;
    const float x0 = bflo_(q0.x), x1 = bfhi_(q0.x), x2 = bflo_(q0.y), x3 = bfhi_(q0.y), x4 = bflo_(q0.z), x5 = bfhi_(q0.z), x6 = bflo_(q0.w), x7 = bfhi_(q0.w);
    out[0] = w0 * um + w1 * x0 + w2 * x1 + bias; out[1] = w0 * x0 + w1 * x1 + w2 * x2 + bias; out[2] = w0 * x1 + w1 * x2 + w2 * x3 + bias; out[3] = w0 * x2 + w1 * x3 + w2 * x4 + bias;
    out[4] = w0 * x3 + w1 * x4 + w2 * x5 + bias; out[5] = w0 * x4 + w1 * x5 + w2 * x6 + bias; out[6] = w0 * x5 + w1 * x6 + w2 * x7 + bias;
    if constexpr (E == 8) { out[7] = w0 * x6 + w1 * x7 + w2 * up + bias; }
    else {
        const uint4 q1 = r.q1;
        const float y0 = bflo_(q1.x), y1 = bfhi_(q1.x), y2 = bflo_(q1.y), y3 = bfhi_(q1.y), y4 = bflo_(q1.z), y5 = bfhi_(q1.z), y6 = bflo_(q1.w), y7 = bfhi_(q1.w);
        out[7] = w0 * x6 + w1 * x7 + w2 * y0 + bias;
        out[8] = w0 * x7 + w1 * y0 + w2 * y1 + bias; out[9] = w0 * y0 + w1 * y1 + w2 * y2 + bias; out[10] = w0 * y1 + w1 * y2 + w2 * y3 + bias; out[11] = w0 * y2 + w1 * y3 + w2 * y4 + bias;
        out[12] = w0 * y3 + w1 * y4 + w2 * y5 + bias; out[13] = w0 * y4 + w1 * y5 + w2 * y6 + bias; out[14] = w0 * y5 + w1 * y6 + w2 * y7 + bias; out[15] = w0 * y6 + w1 * y7 + w2 * up + bias;
    }
}
template <int E> FHD void load_conv(const bf16raw* row, int L, int t0, float w0, float w1, float w2, float bias, typename VecT<E>::type& out) {
    const RawRow r = raw_load<E>(row, L, t0); conv_apply<E>(r, w0, w1, w2, bias, out);
}
template <int E> FHD void store_bf16_run(bf16raw* dst, const typename VecT<E>::type& v) {
#pragma unroll
    for (int q = 0; q < E / 8; ++q) {
        uint4 o;
        o.x = PK2(v[8 * q + 0], v[8 * q + 1]); o.y = PK2(v[8 * q + 2], v[8 * q + 3]);
        o.z = PK2(v[8 * q + 4], v[8 * q + 5]); o.w = PK2(v[8 * q + 6], v[8 * q + 7]);
        *(uint4*)(dst + 8 * q) = o;
    }
}
#ifndef HOST_TEST
#define UNIT_SYNC() __syncthreads()
#define TID_LOOP
#define TID_DECL const int tid = threadIdx.x
#else
#define UNIT_SYNC()
#endif

template <int E> struct HyState { typename VecT<E>::type a, b; };

struct HyArgs {
    const bf16raw* rowX1A; const bf16raw* rowX2A; const bf16raw* rowVA;
    bf16raw* outA;
    const unsigned* K1; const unsigned* K2;
    float sw[3][3]; float sb[3];
    float skip0, skip1;
};
template <int LOGL> FHD void hy_sec_load_v(LP cf* buf, const HyArgs& A, int tid, HyState<(1 << LOGL) / NT>& st) {
    constexpr int L = 1 << LOGL, E = L / NT; const int t0 = tid * E;
    load_conv<E>(A.rowVA, L, t0, A.sw[2][0], A.sw[2][1], A.sw[2][2], A.sb[2], st.a);
    load_conv<E>(A.rowVA + L, L, t0, A.sw[2][0], A.sw[2][1], A.sw[2][2], A.sb[2], st.b);
    LP cf* pb = buf + PADI(t0);
#pragma unroll
    for (int e = 0; e < E; ++e) { pb[e] = cmk(st.a[e], st.b[e]); pb[PADI(L) + e] = cmk(0.f, 0.f); }
}
struct HyRaw { RawRow x1a, x1b, x2a, x2b; };
template <int LOGL> FHD void hy_raw_load(const HyArgs& A, int tid, HyRaw& R) {
    constexpr int L = 1 << LOGL, E = L / NT; const int t0 = tid * E;
    R.x1a = raw_load<E>(A.rowX1A, L, t0); R.x1b = raw_load<E>(A.rowX1A + L, L, t0); R.x2a = raw_load<E>(A.rowX2A, L, t0); R.x2b = raw_load<E>(A.rowX2A + L, L, t0);
}
template <int LOGL> FHD void hy_sec_gate1_pre(LP cf* buf, const HyArgs& A, int tid, HyState<(1 << LOGL) / NT>& st, const HyRaw& R) {
    constexpr int L = 1 << LOGL, E = L / NT; const int t0 = tid * E;
    typename VecT<E>::type xa, xb;
    conv_apply<E>(R.x1a, A.sw[0][0], A.sw[0][1], A.sw[0][2], A.sb[0], xa); conv_apply<E>(R.x1b, A.sw[0][0], A.sw[0][1], A.sw[0][2], A.sb[0], xb);
    LP cf* pb = buf + PADI(t0);
#pragma unroll
    for (int e = 0; e < E; ++e) { const cf y = pb[e];
        st.a[e] = xa[e] * (y.x + st.a[e] * A.skip0); st.b[e] = xb[e] * (y.y + st.b[e] * A.skip0);
        pb[e] = cmk(st.a[e], st.b[e]); pb[PADI(L) + e] = cmk(0.f, 0.f); }
}
template <int LOGL> FHD void hy_sec_gate2_pre(LP cf* buf, const HyArgs& A, int tid, HyState<(1 << LOGL) / NT>& st, const HyRaw& R) {
    constexpr int L = 1 << LOGL, E = L / NT; const int t0 = tid * E;
    typename VecT<E>::type xa, xb;
    conv_apply<E>(R.x2a, A.sw[1][0], A.sw[1][1], A.sw[1][2], A.sb[1], xa); conv_apply<E>(R.x2b, A.sw[1][0], A.sw[1][1], A.sw[1][2], A.sb[1], xb);
    LP cf* pb = buf + PADI(t0);
#pragma unroll
    for (int e = 0; e < E; ++e) { const cf y = pb[e];
        xa[e] = xa[e] * (y.x + st.a[e] * A.skip1); xb[e] = xb[e] * (y.y + st.b[e] * A.skip1); }
    store_bf16_run<E>(A.outA + t0, xa); store_bf16_run<E>(A.outA + L + t0, xb);
}
template <int LOGL> FHD void hy_sec_gate1(LP cf* buf, const HyArgs& A, int tid, HyState<(1 << LOGL) / NT>& st) {
    constexpr int L = 1 << LOGL, E = L / NT; const int t0 = tid * E;
    typename VecT<E>::type xa, xb;
    load_conv<E>(A.rowX1A, L, t0, A.sw[0][0], A.sw[0][1], A.sw[0][2], A.sb[0], xa);
    load_conv<E>(A.rowX1A + L, L, t0, A.sw[0][0], A.sw[0][1], A.sw[0][2], A.sb[0], xb);
    LP cf* pb = buf + PADI(t0);
#pragma unroll
    for (int e = 0; e < E; ++e) { const cf y = pb[e];
        st.a[e] = xa[e] * (y.x + st.a[e] * A.skip0); st.b[e] = xb[e] * (y.y + st.b[e] * A.skip0);
        pb[e] = cmk(st.a[e], st.b[e]); pb[PADI(L) + e] = cmk(0.f, 0.f); }
}
template <int LOGL> FHD void hy_sec_gate2(LP cf* buf, const HyArgs& A, int tid, HyState<(1 << LOGL) / NT>& st) {
    constexpr int L = 1 << LOGL, E = L / NT; const int t0 = tid * E;
    typename VecT<E>::type xa, xb;
    load_conv<E>(A.rowX2A, L, t0, A.sw[1][0], A.sw[1][1], A.sw[1][2], A.sb[1], xa);
    load_conv<E>(A.rowX2A + L, L, t0, A.sw[1][0], A.sw[1][1], A.sw[1][2], A.sb[1], xb);
    LP cf* pb = buf + PADI(t0);
#pragma unroll
    for (int e = 0; e < E; ++e) { const cf y = pb[e];
        xa[e] = xa[e] * (y.x + st.a[e] * A.skip1); xb[e] = xb[e] * (y.y + st.b[e] * A.skip1); }
    store_bf16_run<E>(A.outA + t0, xa); store_bf16_run<E>(A.outA + L + t0, xb);
}

template <int LOGL> FHD void kf_sec_load(LP cf* buf, const float* hf, const float* hb, int tid) {
    constexpr int L = 1 << LOGL;
    LP cf* pb = buf + PADI(tid);
#pragma unroll
    for (int i = 0; i < L / NT; ++i) { const int n = tid + NT * i;
        pb[544 * i] = cmk(hf[n], 0.f);
        pb[PADI(L) + 544 * i] = cmk(n == 0 ? 0.f : hb[L - n], 0.f);
    }
}
template <int LOGN> FHD void kf_sec_tail(LP cf* buf, unsigned* K, int id) {
    constexpr int RL = 1 << (LOGN - 12); constexpr float sc = 1.0f / (float)(1 << LOGN);
    cf x[RL];
#pragma unroll
    for (int k = 0; k < RL; ++k) x[k] = buf[PADI(RL * id) + k];
    if constexpr (RL == 4) { dft4<false>(x[0], x[1], x[2], x[3]); } else { dft2<false>(x[0], x[1]); }
#pragma unroll
    for (int k = 0; k < RL; ++k) K[RL * id + k] = PK2(x[k].x * sc, x[k].y * sc);
}

template <int LOGL> FHD void kf2_sec_load(LP cf* buf, const float* hf0, const float* hb0, const float* hf1, const float* hb1, int tid) {
    constexpr int L = 1 << LOGL;
    LP cf* pb = buf + PADI(tid);
#pragma unroll
    for (int i = 0; i < L / NT; ++i) { const int n = tid + NT * i;
        pb[544 * i] = cmk(hf0[n], hf1[n]);
        pb[PADI(L) + 544 * i] = n == 0 ? cmk(0.f, 0.f) : cmk(hb0[L - n], hb1[L - n]);
    }
}
template <int LOGN> FHD void kf2_sec_tail(LP cf* buf, int id) {
    constexpr int RL = 1 << (LOGN - 12);
    LP cf* pb = buf + PADI(RL * id);
    cf x[RL];
#pragma unroll
    for (int k = 0; k < RL; ++k) x[k] = pb[k];
    if constexpr (RL == 4) { dft4<false>(x[0], x[1], x[2], x[3]); } else { dft2<false>(x[0], x[1]); }
#pragma unroll
    for (int k = 0; k < RL; ++k) pb[k] = x[k];
}
template <int LOGN> FHD void kf2_sec_split(LP const cf* buf, unsigned* K0, unsigned* K1, int p) {
    constexpr int N = 1 << LOGN; constexpr float sc = 0.5f / (float)N;
    const int f = pos_to_freq(p, LOGN), pp = freq_to_pos((N - f) & (N - 1), LOGN);
    const cf Z = buf[PADI(p)], W = buf[PADI(pp)];
    K0[p] = PK2((Z.x + W.x) * sc, (Z.y - W.y) * sc);
    K1[p] = PK2((Z.y + W.y) * sc, (W.x - Z.x) * sc);
}

template <int LOGN> FHD int PADF(int k) { return LOGN == 13 ? (k + (k >> 8)) : (k + 4 * (k >> 6)); }
template <int LOGN> FHD void fn_sec_load(LP cf* buf, const bf16raw* rowC, const bf16raw* rowS, int tid) {
    constexpr int N = 1 << LOGN, E = N / NT; const int t0 = tid * E;
    LP cf* pb = buf + PADI(t0);
#pragma unroll
    for (int v = 0; v < E / 8; ++v) {
        const uint4 qc = *(const uint4*)(rowC + t0 + 8 * v), qs = *(const uint4*)(rowS + t0 + 8 * v);
        pb[8 * v + 0] = cmk(bflo_(qc.x), bflo_(qs.x)); pb[8 * v + 1] = cmk(bfhi_(qc.x), bfhi_(qs.x));
        pb[8 * v + 2] = cmk(bflo_(qc.y), bflo_(qs.y)); pb[8 * v + 3] = cmk(bfhi_(qc.y), bfhi_(qs.y));
        pb[8 * v + 4] = cmk(bflo_(qc.z), bflo_(qs.z)); pb[8 * v + 5] = cmk(bfhi_(qc.z), bfhi_(qs.z));
        pb[8 * v + 6] = cmk(bflo_(qc.w), bflo_(qs.w)); pb[8 * v + 7] = cmk(bfhi_(qc.w), bfhi_(qs.w));
    }
}
struct FnRaw { uint4 c0, c1, s0, s1; };
template <int LOGN> FHD FnRaw fn_raw_load(const bf16raw* rowC, const bf16raw* rowS, int tid) {
    constexpr int E = (1 << LOGN) / NT; const int t0 = tid * E; FnRaw r;
    r.c0 = *(const uint4*)(rowC + t0); r.s0 = *(const uint4*)(rowS + t0);
    if constexpr (E == 16) { r.c1 = *(const uint4*)(rowC + t0 + 8); r.s1 = *(const uint4*)(rowS + t0 + 8); } else { r.c1 = r.c0; r.s1 = r.s0; }
    return r;
}
template <int LOGN> FHD void fn_sec_put(LP cf* buf, const FnRaw& r, int tid, float sg = 1.f) {
    constexpr int E = (1 << LOGN) / NT; LP cf* pb = buf + PADI(tid * E);
    pb[0] = cmk(bflo_(r.c0.x), sg * bflo_(r.s0.x)); pb[1] = cmk(bfhi_(r.c0.x), sg * bfhi_(r.s0.x)); pb[2] = cmk(bflo_(r.c0.y), sg * bflo_(r.s0.y)); pb[3] = cmk(bfhi_(r.c0.y), sg * bfhi_(r.s0.y));
    pb[4] = cmk(bflo_(r.c0.z), sg * bflo_(r.s0.z)); pb[5] = cmk(bfhi_(r.c0.z), sg * bfhi_(r.s0.z)); pb[6] = cmk(bflo_(r.c0.w), sg * bflo_(r.s0.w)); pb[7] = cmk(bfhi_(r.c0.w), sg * bfhi_(r.s0.w));
    if constexpr (E == 16) {
        pb[8] = cmk(bflo_(r.c1.x), sg * bflo_(r.s1.x)); pb[9] = cmk(bfhi_(r.c1.x), sg * bfhi_(r.s1.x)); pb[10] = cmk(bflo_(r.c1.y), sg * bflo_(r.s1.y)); pb[11] = cmk(bfhi_(r.c1.y), sg * bfhi_(r.s1.y));
        pb[12] = cmk(bflo_(r.c1.z), sg * bflo_(r.s1.z)); pb[13] = cmk(bfhi_(r.c1.z), sg * bfhi_(r.s1.z)); pb[14] = cmk(bflo_(r.c1.w), sg * bflo_(r.s1.w)); pb[15] = cmk(bfhi_(r.c1.w), sg * bfhi_(r.s1.w));
    }
}
template <int LOGN> FHD void fn_sec_tail_read(LP cf* buf, int id, float (&re)[16]) {
    if (LOGN == 13) {
        cf a = buf[PADI(2 * id)], b = buf[PADI(2 * id) + 1]; dft2<false>(a, b); re[0] = a.x; re[1] = b.x;
    } else {
        cf x[16];
#pragma unroll
        for (int k = 0; k < 16; ++k) x[k] = buf[PADI(16 * id) + k];
        dft16<false>(x);
#pragma unroll
        for (int r = 0; r < 16; ++r) re[r] = x[DR16(r)].x;
    }
}
template <int LOGN> FHD void fn_sec_tail_write(LP float* fbuf, int id, const float (&re)[16]) {
    if (LOGN == 13) { fbuf[PADF<LOGN>(pos_to_freq(2 * id, LOGN))] = re[0]; fbuf[PADF<LOGN>(pos_to_freq(2 * id + 1, LOGN))] = re[1]; }
    else {
#pragma unroll
        for (int r = 0; r < 16; ++r) fbuf[PADF<LOGN>(pos_to_freq(16 * id + r, LOGN))] = re[r];
    }
}
template <int LOGN> FHD void fn_sec_store(LP const float* fbuf, bf16raw* out, float scale, int tid, bf16raw* out2 = nullptr) {
    constexpr int N = 1 << LOGN;
    for (int k = tid; k < N; k += NT) out[k] = f2bf(fbuf[PADF<LOGN>(k)] * scale);
    if (out2) for (int k = tid; k < N; k += NT) out2[k] = f2bf(fbuf[PADF<LOGN>((N - k) & (N - 1))] * scale);
}

#ifndef HOST_TEST
#define LAUNDER_TID(t) int t = threadIdx.x; asm volatile("" : "+v"(t))
template <int LOGN, bool INV, int LGS> __device__ __forceinline__ void dev_stage(LAS cf* buf) {
    LAUNDER_TID(tid);
#pragma unroll
    for (int i = 0; i < (1 << (LOGN - 4)) / NT; ++i) fft_stage16<INV, false, LGS>(buf, tid + NT * i);
    if constexpr ((1 << (LOGN - 4)) < NT) { if (tid < (1 << (LOGN - 4))) fft_stage16<INV, false, LGS>(buf, tid); }
    __syncthreads();
}
template <int LOGN, bool INV> __device__ __forceinline__ void dev_stages16(LAS cf* buf) {
    if constexpr (!INV) { dev_stage<LOGN, false, LOGN>(buf); dev_stage<LOGN, false, LOGN - 4>(buf); if constexpr (LOGN - 8 > 4) dev_stage<LOGN, false, LOGN - 8>(buf); }
    else { if constexpr (LOGN - 8 > 4) dev_stage<LOGN, true, LOGN - 8>(buf); dev_stage<LOGN, true, LOGN - 4>(buf); dev_stage<LOGN, true, LOGN>(buf); }
}
template <int LOGN> __device__ __forceinline__ void dev_fftconv(LAS cf* buf, const unsigned* K) {
    constexpr int RL = 1 << (LOGN - 12), NI = (1 << LOGN) / RL / NT;
    unsigned kp[NI][RL];
    { const int tid0 = threadIdx.x;
#pragma unroll
      for (int i = 0; i < NI; ++i) {
          if constexpr (RL == 4) { const uint4 q = *(const uint4*)(K + 4 * (tid0 + NT * i)); kp[i][0] = q.x; kp[i][1] = q.y; kp[i][2] = q.z; kp[i][3] = q.w; }
          else { const uint2 q = *(const uint2*)(K + 2 * (tid0 + NT * i)); kp[i][0] = q.x; kp[i][1] = q.y; } } }
    dev_stages16<LOGN, false>(buf);
    { LAUNDER_TID(tid);
#pragma unroll
      for (int i = 0; i < NI; ++i) { cf kk[RL];
#pragma unroll
          for (int k = 0; k < RL; ++k) kk[k] = cmk(bflo_(kp[i][k]), bfhi_(kp[i][k]));
          fft_mid_pre<RL>(buf, kk, tid + NT * i); } }
    __syncthreads();
    dev_stages16<LOGN, true>(buf);
}
template <int LOGL> __device__ __forceinline__ void dev_hyena_unit(LAS cf* buf, const HyArgs& A) {
    constexpr int L = 1 << LOGL, E = L / NT;
    HyState<E> st; HyRaw R;
    { LAUNDER_TID(tid); const int t0 = tid * E;
      const RawRow va = raw_load<E>(A.rowVA, L, t0), vb = raw_load<E>(A.rowVA + L, L, t0);
      hy_raw_load<LOGL>(A, tid, R);
      conv_apply<E>(va, A.sw[2][0], A.sw[2][1], A.sw[2][2], A.sb[2], st.a); conv_apply<E>(vb, A.sw[2][0], A.sw[2][1], A.sw[2][2], A.sb[2], st.b);
      LAS cf* pb = buf + PADI(t0);
#pragma unroll
      for (int e = 0; e < E; ++e) { pb[e] = cmk(st.a[e], st.b[e]); pb[PADI(L) + e] = cmk(0.f, 0.f); } }
    __syncthreads();
    dev_fftconv<LOGL + 1>(buf, A.K1);
    { LAUNDER_TID(tid); hy_sec_gate1_pre<LOGL>(buf, A, tid, st, R); } __syncthreads();
    dev_fftconv<LOGL + 1>(buf, A.K2);
    { LAUNDER_TID(tid); hy_sec_gate2_pre<LOGL>(buf, A, tid, st, R); } __syncthreads();
}
template <int LOGL> __device__ __forceinline__ void dev_kf_unit(LAS cf* buf, const float* hf, const float* hb, unsigned* K) {
    constexpr int LOGN = LOGL + 1, RL = 1 << (LOGN - 12);
    { LAUNDER_TID(tid); kf_sec_load<LOGL>(buf, hf, hb, tid); } __syncthreads();
    dev_stages16<LOGN, false>(buf);
    { LAUNDER_TID(tid); for (int id = tid; id < (1 << LOGN) / RL; id += NT) kf_sec_tail<LOGN>(buf, K, id); }
    __syncthreads();
}
template <int LOGL> __device__ __forceinline__ void dev_kf2_unit(LAS cf* buf, const float* hf0, const float* hb0, const float* hf1, const float* hb1, unsigned* K0, unsigned* K1) {
    constexpr int LOGN = LOGL + 1, RL = 1 << (LOGN - 12);
    { LAUNDER_TID(tid); kf2_sec_load<LOGL>(buf, hf0, hb0, hf1, hb1, tid); } __syncthreads();
    dev_stages16<LOGN, false>(buf);
    { LAUNDER_TID(tid); for (int id = tid; id < (1 << LOGN) / RL; id += NT) kf2_sec_tail<LOGN>(buf, id); }
    __syncthreads();
    { LAUNDER_TID(tid); for (int p = tid; p < (1 << LOGN); p += NT) kf2_sec_split<LOGN>((LAS const cf*)buf, K0, K1, p); }
    __syncthreads();
}
template <int LOGN> __device__ __forceinline__ void dev_fnet_unit(LAS cf* buf, const bf16raw* rowC, const bf16raw* rowS, float sg, bf16raw* out, bf16raw* out2, float scale) {
    { LAUNDER_TID(tid); const FnRaw raw = fn_raw_load<LOGN>(rowC, rowS, tid); fn_sec_put<LOGN>(buf, raw, tid, sg); } __syncthreads();
    dev_stages16<LOGN, false>(buf);
    LAUNDER_TID(tid);
    if constexpr (LOGN == 13) {
        float re[16];
#pragma unroll
        for (int h = 0; h < 8; ++h) { const int id = tid + NT * h; const cf a = buf[PADI(2 * id)], b = buf[PADI(2 * id) + 1]; re[2 * h] = a.x + b.x; re[2 * h + 1] = a.x - b.x; }
        __syncthreads();
        LAS float* fbuf = (LAS float*)buf;
#pragma unroll
        for (int h = 0; h < 8; ++h) { const int id = tid + NT * h; fbuf[PADF<LOGN>(pos_to_freq(2 * id, LOGN))] = re[2 * h]; fbuf[PADF<LOGN>(pos_to_freq(2 * id + 1, LOGN))] = re[2 * h + 1]; }
    } else {
        float re[16];
        if (tid < 256) fn_sec_tail_read<LOGN>(buf, tid, re);
        __syncthreads();
        if (tid < 256) fn_sec_tail_write<LOGN>((LAS float*)buf, tid, re);
    }
    __syncthreads();
    fn_sec_store<LOGN>((LAS const float*)buf, out, scale, tid, out2); __syncthreads();
}
#endif
constexpr int DM = 4096, NTOK = 32768, TOK_S0 = 16384, LP_ = 8192, LS_ = 4096, DFF = 11008, INW = 7168;
constexpr int LPOS = LP_ + LS_;
constexpr float ALPHA = 1.4142135623730951f;
constexpr float LN_EPS = 1e-5f;
#ifndef GP_SP2
#define GP_SP2 true
#endif
#ifndef GP_ALIGN
#define GP_ALIGN true
#endif
constexpr int NPH = 20;
constexpr size_t MiB = 1u << 20;
constexpr size_t WS_CTL = 0, CTL_ZERO_BYTES = 1 * MiB;
constexpr size_t WS_WIN = 1 * MiB, WS_WFN = 65 * MiB, WS_WOUT = 67 * MiB, WS_WGU = 99 * MiB, WS_WDN = 271 * MiB;
constexpr size_t WS_X = 357 * MiB, WS_UT = 613 * MiB, WS_QK = 965 * MiB, WS_TO = 1125 * MiB, WS_YF = 1253 * MiB, WS_MIX = 1317 * MiB, WS_H3 = 1573 * MiB, WS_END = 1589 * MiB;
constexpr size_t WS_H = WS_UT;
static_assert(WS_H + (size_t)NTOK * DFF * 2 <= WS_MIX, "H overlay");
constexpr size_t WS_W4P = WS_H3 + 12 * MiB;
constexpr size_t WS_HC = WS_MIX;
constexpr size_t OUT_KF0 = 0, OUT_KF1 = 128 * MiB, OUT_HC1 = 256 * MiB;
constexpr int CW_BAR = 4096;
constexpr int LDS_BYTES = 147456, LDS_MISC = 147456 - 256, LDS_AUX = 139264;

typedef short bf16x8 __attribute__((ext_vector_type(8)));
typedef float f32x4 __attribute__((ext_vector_type(4)));
typedef unsigned short bf16;
typedef unsigned u32x4v __attribute__((ext_vector_type(4)));
typedef unsigned u32x2v __attribute__((ext_vector_type(2)));

struct Params { const float* in[27]; float* out; unsigned char* ws; int ph_lo, ph_hi; };
typedef const __attribute__((opencl_constant)) Params* KP;
#define KARGS() ({ auto _k = __builtin_amdgcn_kernarg_segment_ptr(); asm volatile("" : "+s"(_k)); (KP)_k; })

__device__ __forceinline__ float wave_sum(float v) {
#pragma unroll
    for (int o = 1; o < 64; o <<= 1) v += __shfl_xor(v, o);
    return v;
}
__device__ __forceinline__ unsigned pk2(float lo, float hi) { return PK2(lo, hi); }

template <bool OUT_BF16> __device__ __forceinline__ void ln_row(const float* src, const float* g, const float* b, void* dst, int lane) {
    const f32x4* xr = (const f32x4*)src + lane;
    f32x4 v[16]; float s = 0.f;
#pragma unroll
    for (int j = 0; j < 16; ++j) { v[j] = xr[64 * j]; s += (v[j][0] + v[j][1]) + (v[j][2] + v[j][3]); }
    const float mean = wave_sum(s) * (1.f / DM); float s2 = 0.f;
#pragma unroll
    for (int j = 0; j < 16; ++j) { v[j] = v[j] - mean; s2 += (v[j][0] * v[j][0] + v[j][1] * v[j][1]) + (v[j][2] * v[j][2] + v[j][3] * v[j][3]); }
    const float rstd = 1.f / sqrtf(wave_sum(s2) * (1.f / DM) + LN_EPS);
#pragma unroll
    for (int j = 0; j < 16; ++j) {
        const f32x4 gg = ((const f32x4*)g)[lane + 64 * j], bb = ((const f32x4*)b)[lane + 64 * j];
        const f32x4 o = v[j] * rstd * gg + bb;
        if (OUT_BF16) { uint2 w; w.x = pk2(o[0], o[1]); w.y = pk2(o[2], o[3]); ((uint2*)dst)[lane + 64 * j] = w; }
        else ((f32x4*)dst)[lane + 64 * j] = o;
    }
}
template <bool OUT_BF16> __device__ __forceinline__ void ln_row_bf(const bf16* src, const float* g, const float* b, void* dst, int lane) {
    const u32x4v* xr = (const u32x4v*)src + lane;
    float v[64]; float s = 0.f;
#pragma unroll
    for (int j = 0; j < 8; ++j) { const u32x4v q = xr[64 * j];
        v[8 * j + 0] = __uint_as_float(q.x << 16); v[8 * j + 1] = __uint_as_float(q.x & 0xffff0000u); v[8 * j + 2] = __uint_as_float(q.y << 16); v[8 * j + 3] = __uint_as_float(q.y & 0xffff0000u);
        v[8 * j + 4] = __uint_as_float(q.z << 16); v[8 * j + 5] = __uint_as_float(q.z & 0xffff0000u); v[8 * j + 6] = __uint_as_float(q.w << 16); v[8 * j + 7] = __uint_as_float(q.w & 0xffff0000u);
#pragma unroll
        for (int e = 0; e < 8; ++e) s += v[8 * j + e]; }
    const float mean = wave_sum(s) * (1.f / DM); float s2 = 0.f;
#pragma unroll
    for (int i = 0; i < 64; ++i) { v[i] -= mean; s2 += v[i] * v[i]; }
    const float rstd = 1.f / sqrtf(wave_sum(s2) * (1.f / DM) + LN_EPS);
#pragma unroll
    for (int j = 0; j < 8; ++j) {
        const int c0 = 8 * lane + 512 * j;
        const f32x4 g0 = *(const f32x4*)(g + c0), g1 = *(const f32x4*)(g + c0 + 4), b0 = *(const f32x4*)(b + c0), b1 = *(const f32x4*)(b + c0 + 4);
        float o[8];
#pragma unroll
        for (int e = 0; e < 4; ++e) { o[e] = v[8 * j + e] * rstd * g0[e] + b0[e]; o[4 + e] = v[8 * j + 4 + e] * rstd * g1[e] + b1[e]; }
        if (OUT_BF16) { u32x4v w; w.x = pk2(o[0], o[1]); w.y = pk2(o[2], o[3]); w.z = pk2(o[4], o[5]); w.w = pk2(o[6], o[7]); ((u32x4v*)dst)[lane + 64 * j] = w; }
        else { float* d = (float*)dst + c0; *(f32x4*)d = (f32x4){o[0], o[1], o[2], o[3]}; *(f32x4*)(d + 4) = (f32x4){o[4], o[5], o[6], o[7]}; }
    }
}
__device__ __forceinline__ void tr_item(const float* W, int ldn, int k0, int n0, bf16* WT, int ldk, int drow0, LAS float* scr, int lane) {
    f32x4 v[16];
#pragma unroll
    for (int i = 0; i < 16; ++i) v[i] = *(const f32x4*)(W + (size_t)(k0 + 4 * i + (lane >> 4)) * ldn + n0 + 4 * (lane & 15));
#pragma unroll
    for (int i = 0; i < 16; ++i) { LAS float* s = scr + (4 * i + (lane >> 4)) * 65 + 4 * (lane & 15); s[0] = v[i][0]; s[1] = v[i][1]; s[2] = v[i][2]; s[3] = v[i][3]; }
    asm volatile("s_waitcnt lgkmcnt(0)" ::: "memory");
    const int c = lane & 7;
#pragma unroll
    for (int j = 0; j < 8; ++j) { const int n = (lane >> 3) + 8 * j; const LAS float* s = scr + (8 * c) * 65 + n;
        uint4 o; o.x = pk2(s[0 * 65], s[1 * 65]); o.y = pk2(s[2 * 65], s[3 * 65]); o.z = pk2(s[4 * 65], s[5 * 65]); o.w = pk2(s[6 * 65], s[7 * 65]);
        *(uint4*)(WT + (size_t)(drow0 + n) * ldk + k0 + 8 * c) = o; }
    asm volatile("s_waitcnt lgkmcnt(0)" ::: "memory");
}
__device__ __forceinline__ void convert_weights(KP p, int l, LAS unsigned char* lds, int gw, int ngw, int wave, int lane) {
    LAS float* scr = (LAS float*)(lds + wave * 17408);
    unsigned char* ws = p->ws;
    const float* w_in = p->in[4] + (size_t)l * DM * INW; const float* w_fn = p->in[16] + (size_t)l * 1024 * 1024; const float* w_out = p->in[19] + (size_t)l * DM * DM;
    const float* w_g = p->in[22] + (size_t)l * DM * DFF; const float* w_u = p->in[23] + (size_t)l * DM * DFF; const float* w_d = p->in[24] + (size_t)l * DFF * DM;
    constexpr int I_IN = 64 * 112, I_FN = 16 * 16, I_OUT = 64 * 64, I_G = 64 * 172, I_D = 172 * 64;
    constexpr int NITEMS = I_IN + I_FN + I_OUT + 2 * I_G + I_D;
    for (int it = gw; it < NITEMS; it += ngw) {
        int r = it;
        if (r < I_IN) { const int kb = r / 112, nb = r % 112, n0 = 64 * nb; int d0;
            if (n0 < 3072) d0 = n0; else if (n0 < 4096) continue; else if (n0 < 6144) d0 = 4608 + (n0 - 4096); else if (n0 < 6656) d0 = 6656 + (n0 - 6144); else d0 = 4096 + (n0 - 6656);
            tr_item(w_in, INW, 64 * kb, n0, (bf16*)(ws + WS_WIN), DM, d0, scr, lane); continue; }
        r -= I_IN;
        if (r < I_FN) { const int kb = r / 16, nb = r % 16; tr_item(w_fn, 1024, 64 * kb, 64 * nb, (bf16*)(ws + WS_WFN), 1024, 64 * nb, scr, lane); continue; }
        r -= I_FN;
        if (r < I_OUT) { const int kb = r / 64, nb = r % 64; tr_item(w_out, DM, 64 * kb, 64 * nb, (bf16*)(ws + WS_WOUT), DM, 64 * nb, scr, lane); continue; }
        r -= I_OUT;
        if (r < I_G) { const int kb = r / 172, nb = r % 172, n0 = 64 * nb; tr_item(w_g, DFF, 64 * kb, n0, (bf16*)(ws + WS_WGU), DM, 256 * (n0 >> 7) + (n0 & 127), scr, lane); continue; }
        r -= I_G;
        if (r < I_G) { const int kb = r / 172, nb = r % 172, n0 = 64 * nb; tr_item(w_u, DFF, 64 * kb, n0, (bf16*)(ws + WS_WGU), DM, 256 * (n0 >> 7) + 128 + (n0 & 127), scr, lane); continue; }
        r -= I_G;
        { const int kb = r / 64, nb = r % 64; tr_item(w_d, DM, 64 * kb, 64 * nb, (bf16*)(ws + WS_WDN), DFF, 64 * nb, scr, lane); }
    }
}
__device__ __forceinline__ void fold_fnet(KP p, int l, LAS unsigned char* lds, int bid, int nb) {
    LAUNDER_TID(tid); LAS float* wt = (LAS float*)lds;
    LAS float* ct = (LAS float*)(lds + 128 * 129 * 4);
    const float* w_in = p->in[4] + (size_t)l * DM * INW; bf16* WT = (bf16*)(p->ws + WS_WIN);
    if (tid < 128) { ct[tid] = __builtin_amdgcn_cosf((float)tid * (1.0f / 128.f)); ct[128 + tid] = __builtin_amdgcn_sinf((float)tid * (1.0f / 128.f)); }
    for (int it = bid; it < 256; it += nb) {
        const int kb = it >> 3, h = it & 7, k0 = 128 * kb;
        __syncthreads();
        for (int e = tid; e < 128 * 128; e += NT) { const int kk = e >> 7, d = e & 127; wt[kk * 129 + d] = w_in[(size_t)(k0 + kk) * INW + 3072 + h * 128 + d]; }
        __syncthreads();
        const int kg = tid & 15, rgp = (tid >> 4) & 15, kh2 = tid >> 8;
        int toff[8]; float sg[8];
#pragma unroll
        for (int b = 0; b < 8; ++b) { const int r = 8 * rgp + b; const bool is_s = r > 64; toff[b] = is_s ? 128 : 0; sg[b] = is_s ? -1.f : 1.f; }
        float acc[4][8];
#pragma unroll
        for (int a = 0; a < 4; ++a)
#pragma unroll
            for (int b = 0; b < 8; ++b) acc[a][b] = 0.f;
        for (int d = 0; d < 128; ++d) {
            float wv[4], tv[8];
#pragma unroll
            for (int a = 0; a < 4; ++a) wv[a] = wt[(64 * kh2 + 4 * kg + a) * 129 + d];
#pragma unroll
            for (int b = 0; b < 8; ++b) { const int r = 8 * rgp + b, k2 = r > 64 ? r - 64 : r; tv[b] = ct[toff[b] + ((k2 * d) & 127)]; }
#pragma unroll
            for (int a = 0; a < 4; ++a)
#pragma unroll
                for (int b = 0; b < 8; ++b) acc[a][b] += wv[a] * tv[b];
        }
#pragma unroll
        for (int b = 0; b < 8; ++b) {
            uint2 o; o.x = pk2(sg[b] * acc[0][b], sg[b] * acc[1][b]); o.y = pk2(sg[b] * acc[2][b], sg[b] * acc[3][b]);
            *(uint2*)(WT + (size_t)(3072 + h * 128 + 8 * rgp + b) * DM + k0 + 64 * kh2 + 4 * kg) = o; }
    }
    __syncthreads();
}
__device__ __forceinline__ void h3_items(KP p, LAS unsigned char* lds, int bid, int nb) {
    LAUNDER_TID(tid); const int pp = tid >> 6, j = tid & 63;
    LAS float* z = (LAS float*)lds; LAS float* hA = z + 8 * 36; LAS float* hB = hA + 8 * 64;
    bf16* h3p = (bf16*)(p->ws + WS_H3);
    for (int it = bid; it < 2 * (LPOS / 8); it += nb) {
        const int l = it / (LPOS / 8), g = (it % (LPOS / 8)) * 8 + pp; const int Lt = g < LP_ ? LP_ : LS_, t = g < LP_ ? g : g - LP_;
        const float* w1 = p->in[7] + l * 33 * 64; const float* b1 = p->in[8] + l * 64; const float* w2 = p->in[9] + l * 4096; const float* b2 = p->in[10] + l * 64;
        const float* w3 = p->in[11] + l * 4096; const float* b3 = p->in[12] + l * 64; const float* fq = p->in[13] + l * 192;
        __syncthreads();
        if (j < 33) { const float wv = (6.283185307179586f / (float)Lt) * (float)t; float val;
            if (j == 0) val = (float)t / (float)(Lt - 1);
            else if (j <= 16) { const float f = 1e-4f + (float)(j - 1) * ((15.0f - 1e-4f) / 15.0f); val = cosf(f * wv); }
            else { const float f = 1e-4f + (float)(j - 17) * ((15.0f - 1e-4f) / 15.0f); val = -sinf(f * wv); }
            z[pp * 36 + j] = val; }
        __syncthreads();
        float a = b1[j];
        for (int i = 0; i < 33; ++i) a += z[pp * 36 + i] * w1[i * 64 + j];
        hA[pp * 64 + j] = sinf(fq[j] * a);
        __syncthreads();
        a = b2[j];
        for (int m = 0; m < 64; ++m) a += hA[pp * 64 + m] * w2[m * 64 + j];
        hB[pp * 64 + j] = sinf(fq[64 + j] * a);
        __syncthreads();
        a = b3[j];
        for (int m = 0; m < 64; ++m) a += hB[pp * 64 + m] * w3[m * 64 + j];
        { const float v = sinf(fq[128 + j] * a); const bf16 hi = f2bf(v), lo = f2bf(v - bf2f(hi));
          bf16* row = h3p + ((size_t)l * LPOS + g) * 256; row[j] = hi; row[64 + j] = lo; row[128 + j] = hi; row[192 + j] = 0; }
    }
    __syncthreads();
    { bf16* w4p = (bf16*)(p->ws + WS_W4P);
      for (int e = bid * NT + tid; e < 2 * 4096 * 64; e += nb * NT) { const int l = e >> 18, jj = (e >> 6) & 4095, mm = e & 63;
          const float v = p->in[14][((size_t)l * 64 + mm) * 4096 + jj]; const bf16 hi = f2bf(v), lo = f2bf(v - bf2f(hi));
          bf16* row = w4p + ((size_t)l * 4096 + jj) * 256; row[mm] = hi; row[64 + mm] = hi; row[128 + mm] = lo; row[192 + mm] = 0; } }
}
__device__ __forceinline__ void hc_gemm(KP p, int l, LAS unsigned char* lds, int bid, int nb) {
    pg8::Gemm g{(const bf16*)(p->ws + WS_W4P) + (size_t)l * 4096 * 256, (const bf16*)(p->ws + WS_H3) + (size_t)l * LPOS * 256, 4096, LPOS, 256};
    pg8::StaticOrder S; S.init(4096, LPOS, nb, bid);
    pg8::EpiHc E{l == 0 ? (float*)(p->ws + WS_HC) : (float*)((unsigned char*)p->out + OUT_HC1), LPOS};
    pg8::gemm_phase<pg8::EpiHc, pg8::StaticOrder, GP_ALIGN, GP_SP2>(lds, g, S, E);
}
__device__ __forceinline__ void kf_units(KP p, int l, LAS unsigned char* lds, int bid, int nb) {
    const float* Hc = l == 0 ? (const float*)(p->ws + WS_HC) : (const float*)((const unsigned char*)p->out + OUT_HC1); LAS cf* buf = (LAS cf*)lds;
    for (int u = bid; u < 2048; u += nb) {
        const int lt = u >> 10, c = u & 1023; const size_t go = lt ? LP_ : 0;
        const float* hf0 = Hc + (size_t)c * LPOS + go; const float* hb0 = Hc + (size_t)(2048 + c) * LPOS + go;
        const float* hf1 = Hc + (size_t)(1024 + c) * LPOS + go; const float* hb1 = Hc + (size_t)(3072 + c) * LPOS + go;
        if (lt == 0) { unsigned* K = (unsigned*)((unsigned char*)p->out + OUT_KF0); dev_kf2_unit<13>(buf, hf0, hb0, hf1, hb1, K + (size_t)c * 16384, K + (size_t)(1024 + c) * 16384); }
        else { unsigned* K = (unsigned*)((unsigned char*)p->out + OUT_KF1); dev_kf2_unit<12>(buf, hf0, hb0, hf1, hb1, K + (size_t)c * 8192, K + (size_t)(1024 + c) * 8192); }
    }
}
struct AttnUnit { int tok0, nblk, n, h; };
__device__ __forceinline__ AttnUnit attn_decode(int u) {
    const bool pr = u < 2048; const int v = pr ? u : u - 2048, h = v & 15, r = v >> 4; const int nblk = pr ? 64 : 32, sq = r / nblk, n = r % nblk;
    AttnUnit a; a.tok0 = pr ? sq * LP_ : TOK_S0 + sq * LS_; a.nblk = nblk; a.n = n; a.h = h; return a;
}
__device__ __forceinline__ void attn_phase(LAS unsigned char* lds, const bf16* QK, const bf16* UT, bf16* MIX, const float* sink, int bid, int nb) {
    LAUNDER_TID(tid); const int lane = tid & 63, w = __builtin_amdgcn_readfirstlane(tid >> 6), fr = lane & 15, g = lane >> 4;
    const float LOG2E = 1.4426950408889634f, sc = 0.08838834764831845f * LOG2E;
    const int nun = (4096 - bid + nb - 1) / nb;
    int ci = 0, cj = -1;
    { const AttnUnit a = attn_decode(bid); if (a.n + cj < 0) cj = 0; }
    AttnUnit cu = attn_decode(bid + nb * ci);
    u32x4v kv[4], vv[4]; bf16x8 qf[4], qn[4];
    const int lr = tid >> 2, lq = tid & 3;
    auto issue_kv = [&](const AttnUnit& a, int jc) {
        const int kb = a.n + jc, kh = a.h >> 2;
        const bf16* srcK = QK + (size_t)(a.tok0 + 128 * kb + lr) * 2560 + 2048 + 128 * kh + 32 * lq;
        const bf16* srcV = UT + (size_t)(4096 + 128 * kh + lr) * NTOK + a.tok0 + 128 * kb + 32 * lq;
#pragma unroll
        for (int i = 0; i < 4; ++i) { kv[i] = *(const u32x4v*)(srcK + 8 * i); vv[i] = *(const u32x4v*)(srcV + 8 * i); }
    };
    auto issue_q = [&](const AttnUnit& a, bf16x8 (&q)[4]) {
        const bf16* qrow = QK + (size_t)(a.tok0 + 128 * a.n + 16 * w + fr) * 2560 + 128 * a.h;
#pragma unroll
        for (int kk = 0; kk < 4; ++kk) q[kk] = *(const bf16x8*)(qrow + 32 * kk + 8 * g);
    };
    if (nun > 0) { issue_kv(cu, cj); issue_q(cu, qf); }
    float m_run = 0.f, l_run = 1.f; f32x4 o[8]; bool fresh = true; int pb = 0;
    while (ci < nun) {
        LAS bf16* Ks = (LAS bf16*)(lds + pb * 69632); LAS bf16* Vs = Ks + 128 * 136;
#pragma unroll
        for (int i = 0; i < 4; ++i) *(LAS u32x4v*)(Ks + lr * 136 + 32 * lq + 8 * i) = kv[i];
        { u32x4v t0, t1, t2, t3;
          t0.x = vv[0].x; t0.y = vv[0].y; t0.z = vv[2].x; t0.w = vv[2].y;   t1.x = vv[0].z; t1.y = vv[0].w; t1.z = vv[2].z; t1.w = vv[2].w;
          t2.x = vv[1].x; t2.y = vv[1].y; t2.z = vv[3].x; t2.w = vv[3].y;   t3.x = vv[1].z; t3.y = vv[1].w; t3.z = vv[3].z; t3.w = vv[3].w;
          LAS u32x4v* vd = (LAS u32x4v*)(Vs + lr * 136 + 32 * lq); vd[0] = t0; vd[1] = t1; vd[2] = t2; vd[3] = t3; }
        int ni = ci, nj = cj + 1; AttnUnit nu = cu;
        if (nj > 1 || cu.n + nj >= cu.nblk) { ni = ci + 1; nj = -1; if (ni < nun) { nu = attn_decode(bid + nb * ni); if (nu.n + nj < 0) nj = 0; } }
        const bool has_next = ni < nun, new_unit = ni != ci;
        if (has_next) { issue_kv(nu, nj); if (new_unit) issue_q(nu, qn); }
        __syncthreads();
        if (fresh) { m_run = sink[cu.h] * LOG2E; l_run = 1.f;
#pragma unroll
            for (int dt = 0; dt < 8; ++dt) o[dt] = (f32x4){0.f, 0.f, 0.f, 0.f}; }
        const float slope = exp2f(-0.5f * (float)(cu.h + 1)) * LOG2E;
        const float d0 = (float)(16 * w + fr - 4 * g - 128 * cj);
        const int kt_lo = cj < 0 ? w : 0, kt_hi = cj > 0 ? w : 7;
        f32x4 s[8];
#pragma unroll
        for (int kt = 0; kt < 8; ++kt) { f32x4 acc = (f32x4){0.f, 0.f, 0.f, 0.f};
            if (kt >= kt_lo && kt <= kt_hi) {
#pragma unroll
                for (int kk = 0; kk < 4; ++kk) { const bf16x8 a = *(const LAS bf16x8*)(Ks + (16 * kt + fr) * 136 + 32 * kk + 8 * g); acc = __builtin_amdgcn_mfma_f32_16x16x32_bf16(a, qf[kk], acc, 0, 0, 0); } }
            s[kt] = acc; }
        float mx = -3.0e38f;
#pragma unroll
        for (int kt = 0; kt < 8; ++kt) if (kt >= kt_lo && kt <= kt_hi) {
#pragma unroll
            for (int i = 0; i < 4; ++i) { const float ad = fabsf(d0 - (float)(16 * kt + i));
                float v = s[kt][i] * sc - slope * ad; v = (ad <= 128.f) ? v : -__builtin_inff(); s[kt][i] = v; mx = fmaxf(mx, v); } }
        mx = fmaxf(mx, __shfl_xor(mx, 16)); mx = fmaxf(mx, __shfl_xor(mx, 32));
        const float m_new = fmaxf(m_run, mx), alpha = __builtin_amdgcn_exp2f(m_run - m_new);
        float ps = 0.f;
#pragma unroll
        for (int kt = 0; kt < 8; ++kt) if (kt >= kt_lo && kt <= kt_hi) {
#pragma unroll
            for (int i = 0; i < 4; ++i) { const float pv = __builtin_amdgcn_exp2f(s[kt][i] - m_new); ps += pv; s[kt][i] = pv; } }
        ps += __shfl_xor(ps, 16); ps += __shfl_xor(ps, 32);
        l_run = l_run * alpha + ps; m_run = m_new;
#pragma unroll
        for (int dt = 0; dt < 8; ++dt) o[dt] *= alpha;
#pragma unroll
        for (int ks = 0; ks < 4; ++ks) if (2 * ks + 1 >= kt_lo && 2 * ks <= kt_hi) {
            union { bf16x8 v; unsigned u[4]; } pbk;
            pbk.u[0] = pk2(s[2 * ks][0], s[2 * ks][1]); pbk.u[1] = pk2(s[2 * ks][2], s[2 * ks][3]); pbk.u[2] = pk2(s[2 * ks + 1][0], s[2 * ks + 1][1]); pbk.u[3] = pk2(s[2 * ks + 1][2], s[2 * ks + 1][3]);
#pragma unroll
            for (int dt = 0; dt < 8; ++dt) { const bf16x8 a = *(const LAS bf16x8*)(Vs + (16 * dt + fr) * 136 + 32 * ks + 8 * g);
                o[dt] = __builtin_amdgcn_mfma_f32_16x16x32_bf16(a, pbk.v, o[dt], 0, 0, 0); }
        }
        fresh = false;
        if (new_unit) {
            const float inv = 1.0f / l_run;
            bf16* orow = MIX + (size_t)(cu.tok0 + 128 * cu.n + 16 * w + fr) * DM + 2048 + 128 * cu.h + 4 * g;
#pragma unroll
            for (int dt = 0; dt < 8; ++dt) { uint2 wv; wv.x = pk2(o[dt][0] * inv, o[dt][1] * inv); wv.y = pk2(o[dt][2] * inv, o[dt][3] * inv); *(uint2*)(orow + 16 * dt) = wv; }
            fresh = true;
#pragma unroll
            for (int kk = 0; kk < 4; ++kk) qf[kk] = qn[kk];
        }
        ci = ni; cj = nj; cu = nu; pb ^= 1;
    }
    __syncthreads();
}
__device__ __forceinline__ void mixer_phase(KP p, int l, LAS unsigned char* lds, int bid, int nb) {
    const bf16* UT = (const bf16*)(p->ws + WS_UT); bf16* TO = (bf16*)(p->ws + WS_TO); LAS cf* buf = (LAS cf*)lds;
    const unsigned* KF0 = (const unsigned*)((const unsigned char*)p->out + OUT_KF0); const unsigned* KF1 = (const unsigned*)((const unsigned char*)p->out + OUT_KF1);
    const float* sw = p->in[5] + (size_t)l * 3 * 3072; const float* sb = p->in[6] + (size_t)l * 3072; const float* skip = p->in[15] + (size_t)l * 2048;
#ifndef SK_HY
#ifndef MX_REP
#define MX_REP 0
#endif
    for (int mr = 0; mr < 1 + (MX_REP & 1); ++mr)
    for (int ui = 0; bid + nb * (ui < 4 ? ui : 4 + ((ui - 4) >> 1)) < (ui < 4 ? 1024 : 2048); ++ui) {
        const bool pr = ui < 4; const int c = pr ? bid + nb * ui : bid + nb * ((ui - 4) >> 1), tokA = pr ? 0 : TOK_S0 + ((ui - 4) & 1) * 2 * LS_;
        HyArgs A; A.rowX1A = UT + (size_t)c * NTOK + tokA; A.rowX2A = UT + (size_t)(1024 + c) * NTOK + tokA; A.rowVA = UT + (size_t)(2048 + c) * NTOK + tokA; A.outA = TO + (size_t)c * NTOK + tokA;
        A.K1 = pr ? KF0 + (size_t)c * 16384 : KF1 + (size_t)c * 8192; A.K2 = pr ? KF0 + (size_t)(1024 + c) * 16384 : KF1 + (size_t)(1024 + c) * 8192;
#pragma unroll
        for (int i = 0; i < 3; ++i) {
#pragma unroll
            for (int k = 0; k < 3; ++k) A.sw[i][k] = sw[k * 3072 + i * 1024 + c];
            A.sb[i] = sb[i * 1024 + c]; }
        A.skip0 = skip[c]; A.skip1 = skip[1024 + c];
        if (pr) dev_hyena_unit<13>(buf, A); else dev_hyena_unit<12>(buf, A);
    }
#endif
#ifndef SK_FN
    for (int mr = 0; mr < 1 + ((MX_REP >> 1) & 1); ++mr) {
        for (int u = bid; u < 2 * 8 * 65; u += nb) { const int b = u / 520, r = u % 520, h = r / 65, k2 = r % 65; const float sg = (k2 == 0 || k2 == 64) ? 0.f : 1.f;
            const bf16* rc = UT + (size_t)(3072 + h * 128 + k2) * NTOK + b * LP_; const bf16* rs = (sg == 0.f) ? rc : UT + (size_t)(3072 + h * 128 + 64 + k2) * NTOK + b * LP_;
            bf16* o1 = TO + (size_t)(1024 + h * 128 + k2) * NTOK + b * LP_; bf16* o2 = (sg == 0.f) ? nullptr : TO + (size_t)(1024 + h * 128 + 128 - k2) * NTOK + b * LP_;
            dev_fnet_unit<13>(buf, rc, rs, sg, o1, o2, 9.765625e-4f  ); }
        for (int v = bid; v < 4 * 8 * 65; v += nb) { const int b = v / 520, r = v % 520, h = r / 65, k2 = r % 65; const float sg = (k2 == 0 || k2 == 64) ? 0.f : 1.f;
            const bf16* rc = UT + (size_t)(3072 + h * 128 + k2) * NTOK + TOK_S0 + b * LS_; const bf16* rs = (sg == 0.f) ? rc : UT + (size_t)(3072 + h * 128 + 64 + k2) * NTOK + TOK_S0 + b * LS_;
            bf16* o1 = TO + (size_t)(1024 + h * 128 + k2) * NTOK + TOK_S0 + b * LS_; bf16* o2 = (sg == 0.f) ? nullptr : TO + (size_t)(1024 + h * 128 + 128 - k2) * NTOK + TOK_S0 + b * LS_;
            dev_fnet_unit<12>(buf, rc, rs, sg, o1, o2, 1.3810679320049757e-3f  ); }
    }
#endif
#ifndef SK_AT
    const bf16* QK = (const bf16*)(p->ws + WS_QK); bf16* MIX = (bf16*)(p->ws + WS_MIX); const float* sink = p->in[18] + l * 16;
    for (int mr = 0; mr < 1 + ((MX_REP >> 2) & 1); ++mr) attn_phase(lds, QK, UT, MIX, sink, bid, nb);
#endif
    __syncthreads();
}
__device__ __forceinline__ void transpose_out(KP p, int gw, int ngw, int lane) {
    const bf16* TO = (const bf16*)(p->ws + WS_TO); bf16* MIX = (bf16*)(p->ws + WS_MIX); bf16* YF = (bf16*)(p->ws + WS_YF);
    for (int it = gw; it < 64 * 256; it += ngw) {
        const int cb = it & 63, tb = it >> 6, ch0 = 32 * cb, tok = 128 * tb + 2 * lane;
        unsigned w[32];
#pragma unroll
        for (int i = 0; i < 32; ++i) w[i] = *(const unsigned*)(TO + (size_t)(ch0 + i) * NTOK + tok);
#pragma unroll
        for (int t = 0; t < 2; ++t) {
            bf16* dst = ch0 < 1024 ? MIX + (size_t)(tok + t) * DM + ch0 : YF + (size_t)(tok + t) * 1024 + (ch0 - 1024);
#pragma unroll
            for (int q = 0; q < 4; ++q) { uint4 o;
                if (t == 0) { o.x = (w[8 * q] & 0xffffu) | (w[8 * q + 1] << 16); o.y = (w[8 * q + 2] & 0xffffu) | (w[8 * q + 3] << 16); o.z = (w[8 * q + 4] & 0xffffu) | (w[8 * q + 5] << 16); o.w = (w[8 * q + 6] & 0xffffu) | (w[8 * q + 7] << 16); }
                else { o.x = (w[8 * q] >> 16) | (w[8 * q + 1] & 0xffff0000u); o.y = (w[8 * q + 2] >> 16) | (w[8 * q + 3] & 0xffff0000u); o.z = (w[8 * q + 4] >> 16) | (w[8 * q + 5] & 0xffff0000u); o.w = (w[8 * q + 6] >> 16) | (w[8 * q + 7] & 0xffff0000u); }
                *(uint4*)(dst + 8 * q) = o; } }
    }
}

__global__ void __launch_bounds__(512, 2) mega_fwd(Params p) {
    extern __shared__ __attribute__((aligned(16))) unsigned char lds_raw[];
    LAS unsigned char* lds = (LAS unsigned char*)lds_raw;
    const int tid = threadIdx.x;
    const int bid0 = blockIdx.x, nb0 = gridDim.x;
#define PH_IDS LAUNDER_TID(tid_); const int lane = tid_ & 63, wave = __builtin_amdgcn_readfirstlane(tid_ >> 6), gw = bid * 8 + wave, ngw = nb * 8; (void)lane; (void)gw; (void)ngw
    volatile LAS unsigned* misc = (volatile LAS unsigned*)(lds + LDS_MISC);
    if (tid < 64) misc[tid] = 0u;
    __syncthreads();
#ifdef CLK_PROBE
    const unsigned long long ck_c0 = __builtin_readcyclecounter(), ck_r0 = __builtin_amdgcn_s_memrealtime();
#endif
    const int lo = p.ph_lo, hi = p.ph_hi;
    const bool multi = (hi - lo) > 1;
    XcdBarrier bar; bar.bar = (unsigned*)(p.ws + WS_CTL) + CW_BAR; bar.x = 0; bar.st = nullptr;
    if (multi) bar = xcd_barrier_post((unsigned*)(p.ws + WS_CTL) + CW_BAR, misc + 8);
#ifndef PH_EN
#define PH_EN 0x7FF
#endif
#define IN(k) (((PH_EN >> ((k) < 2 ? (k) : 2 + ((k) - 2) % 9)) & 1) && lo <= (k) && (k) < hi)
#ifndef REP_MASK
#define REP_MASK 0
#endif
#define REPS(t) (1 + ((REP_MASK >> (t)) & 1))
#ifndef TM_MASK
#define TM_MASK 0
#endif
    unsigned long long tm_acc = 0ull, tm_t0 = TM_MASK ? __builtin_amdgcn_s_memrealtime() : 0ull; (void)tm_acc; (void)tm_t0;
#define TM_T(k) ((k) < 2 ? (k) : 2 + ((k) - 2) % 9)
#define SEAM(k) do { if (IN(k) && IN((k) + 1)) xcd_barrier(bar); \
    if (TM_MASK) { const unsigned long long _t = __builtin_amdgcn_s_memrealtime(); if ((TM_MASK >> TM_T(k)) & 1) tm_acc += _t - tm_t0; tm_t0 = _t; } } while (0)
#define PH_ARGS int bid = bid0, nb = nb0; asm volatile("" : "+s"(bid), "+s"(nb)); KP kp = KARGS(); unsigned char* ws = kp->ws; bf16* X = (bf16*)(ws + WS_X); bf16* MIX = (bf16*)(ws + WS_MIX); (void)X; (void)MIX

    if (IN(0)) for (int rep = 0; rep < REPS(0); ++rep) { PH_ARGS; PH_IDS;
        h3_items(kp, lds, bid, nb);
        convert_weights(kp, 0, lds, gw, ngw, wave, lane);
        __syncthreads();
        fold_fnet(kp, 0, lds, bid, nb);
        for (int m = gw; m < NTOK; m += ngw) ln_row<true>(m < TOK_S0 ? kp->in[0] + (size_t)m * DM : kp->in[1] + (size_t)(m - TOK_S0) * DM, kp->in[2], kp->in[3], X + (size_t)m * DM, lane);
    }
    SEAM(0);
    if (IN(1)) for (int rep = 0; rep < REPS(1); ++rep) { PH_ARGS; for (int hl = 0; hl < 2; ++hl) hc_gemm(kp, hl, lds, bid, nb); }
    SEAM(1);
    for (int l = 0; l < 2; ++l) {
        const int pb = 2 + 9 * l;
        if (IN(pb + 0)) for (int rep = 0; rep < REPS(2); ++rep) { PH_ARGS;
#ifndef SK_GA
            for (int gi = 0; gi < 2; ++gi) {
                const bf16* Wt = (const bf16*)(ws + WS_WIN);
                pg8::Gemm g{gi == 0 ? Wt : X, gi == 0 ? X : Wt + (size_t)4608 * DM, gi == 0 ? 4608 : NTOK, gi == 0 ? NTOK : 2560, DM};
                pg8::StaticOrder S; S.init(g.M, g.N, nb, bid);
                pg8::EpiBf16<0> E{gi == 0 ? (bf16*)(ws + WS_UT) : (bf16*)(ws + WS_QK), gi == 0 ? NTOK : 2560, nullptr, 0, 0};
                pg8::gemm_phase<pg8::EpiBf16<0>, pg8::StaticOrder, GP_ALIGN, GP_SP2>(lds, g, S, E);
            }
#endif
#ifndef SK_KF
            kf_units(kp, l, lds, bid, nb);
#endif
        }
        SEAM(pb + 0);
        if (IN(pb + 1)) for (int rep = 0; rep < REPS(3); ++rep) { PH_ARGS; mixer_phase(kp, l, lds, bid, nb); }
        SEAM(pb + 1);
        if (IN(pb + 2)) for (int rep = 0; rep < REPS(4); ++rep) { PH_ARGS; PH_IDS; transpose_out(kp, gw, ngw, lane); }
        SEAM(pb + 2);
        if (IN(pb + 3)) for (int rep = 0; rep < REPS(5); ++rep) { PH_ARGS;
            pg8::Gemm g{(const bf16*)(ws + WS_YF), (const bf16*)(ws + WS_WFN), NTOK, 1024, 1024}; pg8::StaticOrder S; S.init(NTOK, 1024, nb, bid);
            pg8::EpiBf16<0> E{MIX + 1024, DM, kp->in[17] + l * 1024, 0, 0};
            pg8::gemm_phase<pg8::EpiBf16<0>, pg8::StaticOrder, GP_ALIGN, GP_SP2>(lds, g, S, E);
        }
        SEAM(pb + 3);
        if (IN(pb + 4)) for (int rep = 0; rep < REPS(6); ++rep) { PH_ARGS;
            pg8::Gemm g{MIX, (const bf16*)(ws + WS_WOUT), NTOK, DM, DM}; pg8::StaticOrder S; S.init(NTOK, DM, nb, bid, 2);
            pg8::EpiResBf16 E{(bf16*)(ws + WS_UT), X, DM, ALPHA};
            pg8::gemm_phase<pg8::EpiResBf16, pg8::StaticOrder, GP_ALIGN, GP_SP2>(lds, g, S, E);
        }
        SEAM(pb + 4);
        if (IN(pb + 5)) for (int rep = 0; rep < REPS(7); ++rep) { PH_ARGS; PH_IDS; for (int m = gw; m < NTOK; m += ngw) ln_row_bf<true>((const bf16*)(ws + WS_UT) + (size_t)m * DM, kp->in[20] + l * DM, kp->in[21] + l * DM, MIX + (size_t)m * DM, lane); }
        SEAM(pb + 5);
        if (IN(pb + 6)) for (int rep = 0; rep < REPS(8); ++rep) { PH_ARGS;
            pg8::Gemm g{MIX, (const bf16*)(ws + WS_WGU), NTOK, 2 * DFF, DM}; pg8::StaticOrder S; S.init(NTOK, 2 * DFF, nb, bid);
            pg8::EpiSwiGLU E{(bf16*)(ws + WS_H), DFF};
            pg8::gemm_phase<pg8::EpiSwiGLU, pg8::StaticOrder, GP_ALIGN, GP_SP2>(lds, g, S, E);
        }
        SEAM(pb + 6);
        if (IN(pb + 7)) for (int rep = 0; rep < REPS(9); ++rep) { PH_ARGS;
            pg8::Gemm g{(const bf16*)(ws + WS_H), (const bf16*)(ws + WS_WDN), NTOK, DM, DFF}; pg8::StaticOrder S; S.init(NTOK, DM, nb, bid, 2);
            pg8::EpiResBf16 E{X, MIX, DM, ALPHA};
            pg8::gemm_phase<pg8::EpiResBf16, pg8::StaticOrder, GP_ALIGN, GP_SP2>(lds, g, S, E);
        }
        SEAM(pb + 7);
        if (IN(pb + 8)) for (int rep = 0; rep < (l == 0 ? REPS(10) : 1); ++rep) { PH_ARGS; PH_IDS;
            if (l == 0) {
                for (int m = gw; m < NTOK; m += ngw) ln_row_bf<true>(X + (size_t)m * DM, kp->in[25] + l * DM, kp->in[26] + l * DM, X + (size_t)m * DM, lane);
                __syncthreads();
                convert_weights(kp, 1, lds, gw, ngw, wave, lane);
                __syncthreads();
                fold_fnet(kp, 1, lds, bid, nb);
            } else {
                for (int m = gw; m < NTOK; m += ngw) ln_row_bf<false>(X + (size_t)m * DM, kp->in[25] + l * DM, kp->in[26] + l * DM, kp->out + (size_t)m * DM, lane);
            }
        }
        if (l == 0) SEAM(pb + 8);
    }
    if (TM_MASK) { const unsigned long long _t = __builtin_amdgcn_s_memrealtime(); if ((TM_MASK >> 10) & 1) tm_acc += _t - tm_t0;
        while (__builtin_amdgcn_s_memrealtime() - _t < tm_acc) __builtin_amdgcn_s_sleep(8); }
#ifdef BAR_PROBE
    if (multi) { for (int i = 0; i < BAR_PROBE; ++i) xcd_barrier(bar); }
#endif
#ifdef CLK_PROBE
    { const unsigned long long c1 = __builtin_readcyclecounter(), r1 = __builtin_amdgcn_s_memrealtime();
      const unsigned long long ticks = (c1 - ck_c0) * 10000ull / (r1 - ck_r0); while (__builtin_amdgcn_s_memrealtime() - r1 < ticks) __builtin_amdgcn_s_sleep(8); }
#endif
#undef IN
#undef SEAM
}

extern "C" void kernel_launch(void* const* d_in, const int* in_sizes, int n_in, void* d_out, int out_size, void* d_ws, size_t ws_size, hipStream_t stream) {
    static int grid = 0;
    if (grid == 0) {
        if (n_in != 27 || out_size != 2 * TOK_S0 * DM || ws_size < WS_END) { fprintf(stderr, "kernel_launch: unexpected shapes (n_in %d, out %d, ws %zu)\n", n_in, out_size, ws_size); grid = -1; return; }
        int dev = 0, cus = 0, per_cu = 0;
        if (hipGetDevice(&dev) != hipSuccess || hipDeviceGetAttribute(&cus, hipDeviceAttributeMultiprocessorCount, dev) != hipSuccess) { grid = -1; return; }
        if (hipFuncSetAttribute((const void*)mega_fwd, hipFuncAttributeMaxDynamicSharedMemorySize, LDS_BYTES) != hipSuccess) { fprintf(stderr, "kernel_launch: hipFuncSetAttribute failed\n"); grid = -1; return; }
        if (hipOccupancyMaxActiveBlocksPerMultiprocessor(&per_cu, (const void*)mega_fwd, 512, LDS_BYTES) != hipSuccess || per_cu < 1) fprintf(stderr, "kernel_launch: occupancy query reports %d\n", per_cu);
        (void)hipGetLastError();
        grid = cus;
    }
    if (grid < 0) return;
    (void)in_sizes;
    if (hipMemsetAsync((char*)d_ws + WS_CTL, 0, CTL_ZERO_BYTES, stream) != hipSuccess) return;
    Params p{};
    for (int i = 0; i < 27; ++i) p.in[i] = (const float*)d_in[i];
    p.out = (float*)d_out; p.ws = (unsigned char*)d_ws;
#if MK_MULTI
    for (int k = 0; k < NPH; ++k) { p.ph_lo = k; p.ph_hi = k + 1; hipLaunchKernelGGL(mega_fwd, dim3(grid), dim3(512), LDS_BYTES, stream, p); }
#else
    p.ph_lo = 0; p.ph_hi = NPH;
    hipLaunchKernelGGL(mega_fwd, dim3(grid), dim3(512), LDS_BYTES, stream, p);
#endif
}
```
